# Optimizing an MI355X kernel written in HIP

```python
import math
import jax, jax.numpy as jnp
from jax import lax
import numpy as np

D_MODEL = 1024
BATCH = 32
SEQ = 2048
DEPTH = 2

RET_HEADS = 4
RET_DK = 256
RET_DV = 512
RET_CHUNK = 128
ROPE_BASE = 10000.0
GN_EPS = 1e-5
NSA_HEADS = 16
NSA_KV_GROUPS = 2
NSA_HD = 64
CMP_LEN = 32
CMP_STRIDE = 16
CMP_HIDDEN = 256
SEL_BLOCK = 64
SEL_TOPK = 8
WINDOW = 512
NSA_Q_BLOCK = 64
FORCED_SCORE = 1e4
REL_BUCKETS = 32
REL_MAX_DIST = 128
FFN_HIDDEN = -(-8 * D_MODEL // (3 * 256)) * 256
EPS = 1e-6
NEG_INF = -1e30
SPLIT_SIZES = (RET_HEADS * RET_DK, RET_HEADS * RET_DK, RET_HEADS * RET_DV, RET_HEADS * RET_DV,
               NSA_HEADS * NSA_HD, 6 * NSA_KV_GROUPS * NSA_HD, 3 * NSA_HEADS, D_MODEL, D_MODEL)
C_IN = sum(SPLIT_SIZES)

kernel_name = "hybrid_retnet_nsa_gated_block"


def rms_norm(x, g):
    xf = x.astype(jnp.float32)
    y = xf * lax.rsqrt(jnp.mean(xf * xf, -1, keepdims=True) + EPS)
    return (y * g.astype(jnp.float32)).astype(x.dtype)


def masked_softmax(logits, mask):
    z = jnp.where(mask, logits.astype(jnp.float32), NEG_INF)
    z = z - jnp.max(z, -1, keepdims=True)
    e = jnp.exp(z) * mask
    return e / jnp.maximum(jnp.sum(e, -1, keepdims=True), 1e-30)


def t5_bucket(dist):
    dist = jnp.maximum(dist, 0)
    max_exact = REL_BUCKETS // 2
    large = max_exact + (jnp.log(jnp.maximum(dist, 1).astype(jnp.float32) / max_exact)
                         / math.log(REL_MAX_DIST / max_exact) * (REL_BUCKETS - max_exact)).astype(jnp.int32)
    large = jnp.minimum(large, REL_BUCKETS - 1)
    return jnp.where(dist < max_exact, dist, large)


def rotary(x, pos):
    half = x.shape[-1] // 2
    freqs = ROPE_BASE ** (-jnp.arange(half, dtype=jnp.float32) / half)
    ang = pos.astype(jnp.float32)[:, None] * freqs
    cos = jnp.cos(ang)[None, :, None, :]
    sin = jnp.sin(ang)[None, :, None, :]
    x1, x2 = x[..., :half], x[..., half:]
    return jnp.concatenate([x1 * cos - x2 * sin, x1 * sin + x2 * cos], -1)


def retention(q, k, v):
    B, T, H, dk = q.shape
    dv = v.shape[-1]
    nc = T // RET_CHUNK
    lg = jnp.log(1.0 - 2.0 ** (-5.0 - jnp.arange(H, dtype=jnp.float32)))
    n = jnp.arange(RET_CHUNK, dtype=jnp.float32)
    diff = n[:, None] - n[None, :]
    dmask = jnp.where(diff >= 0, jnp.exp(jnp.maximum(diff, 0.0)[None] * lg[:, None, None]), 0.0)
    xi = jnp.exp((n + 1.0)[None] * lg[:, None])
    zeta = jnp.exp((RET_CHUNK - 1.0 - n)[None] * lg[:, None])
    g_chunk = jnp.exp(RET_CHUNK * lg)

    def to_chunks(t):
        return t.reshape(B, nc, RET_CHUNK, H, t.shape[-1]).transpose(1, 0, 3, 2, 4)

    def step(R, qkv):
        qc, kc, vc = qkv
        s = jnp.einsum('bhnd,bhmd->bhnm', qc, kc) * dmask
        o = (jnp.einsum('bhnm,bhme->bhne', s, vc)
             + jnp.einsum('bhnd,bhde->bhne', qc, R) * xi[:, :, None])
        R = g_chunk[:, None, None] * R + jnp.einsum('bhmd,bhme->bhde', kc * zeta[:, :, None], vc)
        return R, o

    R0 = jnp.zeros((B, H, dk, dv), jnp.float32)
    _, o = lax.scan(step, R0, (to_chunks(q), to_chunks(k), to_chunks(v)))
    return o.transpose(1, 0, 3, 2, 4).reshape(B, T, H, dv)


def compress(kv, pos_emb, w1, w2):
    T = kv.shape[2]
    n_cmp = (T - CMP_LEN) // CMP_STRIDE + 1
    idx = jnp.arange(n_cmp)[:, None] * CMP_STRIDE + jnp.arange(CMP_LEN)[None]
    blocks = kv[:, :, idx, :] + pos_emb
    flat = blocks.reshape(blocks.shape[0], blocks.shape[1], n_cmp, CMP_LEN * NSA_HD)
    return jax.nn.gelu(flat @ w1) @ w2


def nsa(q, k_c, v_c, k_s, v_s, k_w, v_w, gates, pos_k, pos_v, w1_k, w2_k, w1_v, w2_v, rel_bias):
    B, T, H, hd = q.shape
    G = NSA_KV_GROUPS
    HG = H // G
    QB = NSA_Q_BLOCK
    scale = hd ** -0.5
    grp = lambda t: t.transpose(0, 2, 1, 3)
    kc = compress(grp(k_c), pos_k, w1_k, w2_k)
    vc = compress(grp(v_c), pos_v, w1_v, w2_v)
    n_cmp = kc.shape[2]
    cmp_end = jnp.arange(n_cmp) * CMP_STRIDE + CMP_LEN - 1
    n_sel = T // SEL_BLOCK
    sel_k = min(SEL_TOPK, n_sel)
    sel_start = jnp.arange(n_sel) * SEL_BLOCK
    overlap = ((cmp_end[:, None] - CMP_LEN + 1 < sel_start[None] + SEL_BLOCK)
               & (cmp_end[:, None] >= sel_start[None])).astype(jnp.float32)
    ks_blocks = grp(k_s).reshape(B, G, n_sel, SEL_BLOCK, hd)
    vs_blocks = grp(v_s).reshape(B, G, n_sel, SEL_BLOCK, hd)
    kw_pad = jnp.pad(grp(k_w), ((0, 0), (0, 0), (WINDOW, 0), (0, 0)))
    vw_pad = jnp.pad(grp(v_w), ((0, 0), (0, 0), (WINDOW, 0), (0, 0)))
    table = rel_bias.reshape(REL_BUCKETS, G, HG).astype(jnp.float32)
    nq = T // QB
    qb = q.reshape(B, nq, QB, G, HG, hd).transpose(1, 0, 3, 4, 2, 5)
    gb = gates.reshape(B, nq, QB, G, HG, 3).transpose(1, 0, 3, 4, 2, 5)
    starts = jnp.arange(nq, dtype=jnp.int32) * QB
    bidx = jnp.arange(B)[:, None, None, None]
    gidx = jnp.arange(G)[None, :, None, None]
    jj = jnp.arange(n_sel)

    def head_bias(dist):
        return jnp.moveaxis(table[t5_bucket(dist)], (-2, -1), (0, 1))

    def sel_bias(dist):
        b = jax.vmap(lambda tb, bk: tb[bk], in_axes=(1, 1), out_axes=1)(table, t5_bucket(dist))
        return jnp.moveaxis(b, -1, 2)

    def block(args):
        qx, gx, s = args
        pos = s + jnp.arange(QB, dtype=jnp.int32)
        dc = pos[:, None] - cmp_end[None]
        lc = jnp.einsum('bghqd,bgnd->bghqn', qx, kc) * scale + head_bias(dc)
        pc = masked_softmax(lc, dc >= 0)
        oc = jnp.einsum('bghqn,bgnd->bghqd', pc.astype(vc.dtype), vc)
        imp = jnp.einsum('bghqn,nj->bgqj', pc, overlap)
        cur = pos // SEL_BLOCK
        forced = (jj[None] == 0) | (jj[None] == cur[:, None]) | (jj[None] == cur[:, None] - 1)
        imp = jnp.where(forced, FORCED_SCORE, imp)
        imp = jnp.where(sel_start[None] <= pos[:, None], imp, NEG_INF)
        _, sel = lax.top_k(imp, sel_k)
        ksel = ks_blocks[bidx, gidx, sel]
        vsel = vs_blocks[bidx, gidx, sel]
        kpos = sel[..., None] * SEL_BLOCK + jnp.arange(SEL_BLOCK)
        ds = pos[:, None, None] - kpos
        ls = jnp.einsum('bghqd,bgqkld->bghqkl', qx, ksel) * scale + sel_bias(ds)
        bsz, g_, hg_, qn, kk, bs = ls.shape
        ps = masked_softmax(ls.reshape(bsz, g_, hg_, qn, kk * bs),
                            (ds >= 0)[:, :, None].reshape(bsz, g_, 1, qn, kk * bs))
        os_ = jnp.einsum('bghqm,bgqmd->bghqd', ps.astype(vsel.dtype),
                         vsel.reshape(bsz, g_, qn, kk * bs, hd))
        kw = lax.dynamic_slice_in_dim(kw_pad, s, WINDOW + QB, axis=2)
        vw = lax.dynamic_slice_in_dim(vw_pad, s, WINDOW + QB, axis=2)
        wpos = s - WINDOW + jnp.arange(WINDOW + QB, dtype=jnp.int32)
        dw = pos[:, None] - wpos[None]
        lw = jnp.einsum('bghqd,bgld->bghql', qx, kw) * scale + head_bias(dw)
        pw = masked_softmax(lw, (dw >= 0) & (dw < WINDOW) & (wpos[None] >= 0))
        ow = jnp.einsum('bghql,bgld->bghqd', pw.astype(vw.dtype), vw)
        return gx[..., 0:1] * oc + gx[..., 1:2] * os_ + gx[..., 2:3] * ow

    out = lax.map(block, (qb, gb, starts))
    return out.transpose(1, 0, 4, 2, 3, 5).reshape(B, T, H * hd)


def setup_inputs(seed: int = 0) -> dict:
    key = jax.random.key(seed)
    ks = jax.random.split(key, 20)
    nrm = lambda k, shape, fan: jax.random.normal(k, shape, jnp.float32) * (fan ** -0.5)
    gain = lambda k, shape: 1.0 + 0.01 * jax.random.normal(k, shape, jnp.float32)
    L = DEPTH
    return {
        "x": jax.random.normal(ks[0], (BATCH, SEQ, D_MODEL), jnp.float32),
        "norm_mix_g": gain(ks[1], (L, D_MODEL)),
        "w_in": nrm(ks[2], (L, D_MODEL, C_IN), D_MODEL),
        "cmp_pos_k": 0.02 * jax.random.normal(ks[3], (L, CMP_LEN, NSA_HD), jnp.float32),
        "cmp_pos_v": 0.02 * jax.random.normal(ks[4], (L, CMP_LEN, NSA_HD), jnp.float32),
        "cmp_w1_k": nrm(ks[5], (L, CMP_LEN * NSA_HD, CMP_HIDDEN), CMP_LEN * NSA_HD),
        "cmp_w2_k": nrm(ks[6], (L, CMP_HIDDEN, NSA_HD), CMP_HIDDEN),
        "cmp_w1_v": nrm(ks[7], (L, CMP_LEN * NSA_HD, CMP_HIDDEN), CMP_LEN * NSA_HD),
        "cmp_w2_v": nrm(ks[8], (L, CMP_HIDDEN, NSA_HD), CMP_HIDDEN),
        "w_o_ret": nrm(ks[9], (L, RET_HEADS * RET_DV, D_MODEL), RET_HEADS * RET_DV),
        "w_o_nsa": nrm(ks[10], (L, NSA_HEADS * NSA_HD, D_MODEL), NSA_HEADS * NSA_HD),
        "w_out": nrm(ks[11], (L, D_MODEL, D_MODEL), D_MODEL),
        "norm_ffn_g": gain(ks[12], (L, D_MODEL)),
        "w_ffn_in": nrm(ks[13], (L, D_MODEL, 2 * FFN_HIDDEN), D_MODEL),
        "w_ffn_out": nrm(ks[14], (L, FFN_HIDDEN, D_MODEL), FFN_HIDDEN),
        "rel_bias": 0.2 * jax.random.normal(ks[15], (REL_BUCKETS, NSA_HEADS), jnp.float32),
        "norm_final_g": gain(ks[16], (D_MODEL,)),
    }


def reference(x, norm_mix_g, w_in, cmp_pos_k, cmp_pos_v, cmp_w1_k, cmp_w2_k, cmp_w1_v, cmp_w2_v,
              w_o_ret, w_o_nsa, w_out, norm_ffn_g, w_ffn_in, w_ffn_out, rel_bias, norm_final_g):
    B, T, _ = x.shape
    pos = jnp.arange(T, dtype=jnp.int32)
    cuts = [int(c) for c in np.cumsum(SPLIT_SIZES)[:-1]]
    for i in range(DEPTH):
        h = rms_norm(x, norm_mix_g[i])
        proj = h @ w_in[i]
        q_r, k_r, v_r, g_r, q_n, kv_n, gate_n, m_a, m_b = jnp.split(proj, cuts, axis=-1)
        qr = rotary(q_r.reshape(B, T, RET_HEADS, RET_DK).astype(jnp.float32), pos)
        kr = rotary(k_r.reshape(B, T, RET_HEADS, RET_DK).astype(jnp.float32), pos) * (RET_DK ** -0.5)
        vr = v_r.reshape(B, T, RET_HEADS, RET_DV).astype(jnp.float32)
        o_r = retention(qr, kr, vr)
        mu = jnp.mean(o_r, -1, keepdims=True)
        var = jnp.mean(jnp.square(o_r - mu), -1, keepdims=True)
        o_r = ((o_r - mu) * lax.rsqrt(var + GN_EPS)).reshape(B, T, RET_HEADS * RET_DV).astype(x.dtype)
        y_ret = (jax.nn.silu(g_r) * o_r) @ w_o_ret[i]
        kv = kv_n.reshape(B, T, 6, NSA_KV_GROUPS, NSA_HD)
        o_n = nsa(q_n.reshape(B, T, NSA_HEADS, NSA_HD),
                  kv[:, :, 0], kv[:, :, 1], kv[:, :, 2], kv[:, :, 3], kv[:, :, 4], kv[:, :, 5],
                  jax.nn.sigmoid(gate_n).reshape(B, T, NSA_HEADS, 3),
                  cmp_pos_k[i], cmp_pos_v[i], cmp_w1_k[i], cmp_w2_k[i], cmp_w1_v[i], cmp_w2_v[i],
                  rel_bias)
        y_nsa = o_n.astype(x.dtype) @ w_o_nsa[i]
        mixed = (jax.nn.sigmoid(m_a) * y_ret + jax.nn.sigmoid(m_b) * y_nsa) @ w_out[i]
        x = x + mixed.astype(x.dtype)
        h = rms_norm(x, norm_ffn_g[i])
        a, b = jnp.split(h @ w_ffn_in[i], 2, axis=-1)
        x = x + ((jax.nn.silu(a) * b) @ w_ffn_out[i]).astype(x.dtype)
    return rms_norm(x, norm_final_g)
```

```cpp
#include <hip/hip_runtime.h>
#include <cstdio>
#include <cstdint>
namespace pg8 {
#define PG8_LAS __attribute__((address_space(3)))
typedef unsigned short bf16_t;
typedef short bf16x8 __attribute__((ext_vector_type(8)));
typedef float f32x4 __attribute__((ext_vector_type(4)));
typedef unsigned u32x4 __attribute__((ext_vector_type(4)));
constexpr int BM = 256, BK = 64, HALF = 128, HTB = HALF * BK * 2  , STAGE_BYTES = 8 * HTB, NXCD = 8, WGM = 8;

__host__ __device__ __forceinline__ int lds_byte(int r, int c) { const int st = (r >> 4) * 2 + (c >> 5), rr = r & 15, cc = c & 31, ob = rr * 64 + cc * 2; return st * 1024 + (ob ^ (((ob >> 9) & 1) << 5)); }
__host__ __device__ __forceinline__ void stage_rc(int b, int& R, int& C) { const int st = b / 1024, sb = b % 1024, swz = sb ^ (((sb >> 9) & 1) << 5); R = (st >> 1) * 16 + swz / 64; C = (st & 1) * 32 + (swz % 64) / 2; }
__host__ __device__ __forceinline__ int perm32(int rho) { const int n = rho >> 4, i = rho & 15; return 8 * (i >> 2) + 4 * n + (i & 3); }

struct Unit { int pm, pn; };
struct Gemm { const bf16_t* A; const bf16_t* Bt; int M, N, K; };

struct StaticOrder {
    int nM, nN, nwg, G, c;
    __host__ __device__ void init(int M, int N, int G_, int c_) { nM = M / BM; nN = N / BM; nwg = nM * nN; G = G_; c = c_; }
    __host__ __device__ bool next(int i, Unit& u) const {
        const long L = (long)i * G + c; if (L >= nwg) return false;
        int wgid = (int)L; { const int q = nwg / NXCD, r = nwg % NXCD, xcd = wgid % NXCD, off = wgid / NXCD; wgid = (xcd < r ? xcd * (q + 1) : r * (q + 1) + (xcd - r) * q) + off; }
        const int nig = WGM * nN, gid = wgid / nig, fm = gid * WGM, gsz = (nM - fm) < WGM ? (nM - fm) : WGM;
        u.pm = fm + ((wgid % nig) % gsz); u.pn = (wgid % nig) / gsz; return true;
    }
    __device__ __forceinline__ void a_ready(const Unit&) const {}
    __device__ __forceinline__ void done(const Unit&) const {}
};

template <class Epi, class Sched, bool ALIGN_EPI = false, bool SP2 = false>
__device__ __forceinline__ void gemm_phase(PG8_LAS unsigned char* lds, const Gemm g, const Sched& S, const Epi& E) {
    int tid_ = threadIdx.x; asm volatile("" : "+v"(tid_));
    const int tid = tid_, wid = __builtin_amdgcn_readfirstlane(tid >> 6), lane = tid & 63, wr = wid >> 2, wc = wid & 3, fr = lane & 15, fq = lane >> 4;
    const int K = g.K, nt = K / BK;
    unsigned voffA[2], voffB[2];
#pragma unroll
    for (int i = 0; i < 2; ++i) { int R, C; stage_rc(tid * 16 + i * 8192, R, C); const int Rb = Epi::PERM ? ((R & ~31) + perm32(R & 31)) : R;
        voffA[i] = (unsigned)(R * K + C) * 2u; voffB[i] = (unsigned)(Rb * K + C) * 2u; }
    const size_t kstep = (size_t)(BK * 2);
    const size_t hstep = (size_t)HALF * K * 2;
    const size_t tstep = 2 * hstep;
    const unsigned ldsw = (unsigned)wid * 1024u;
    const int aoff = lds_byte(wr * 64 + fr, fq * 8), boff = lds_byte(wc * 32 + fr, fq * 8);
#define PG8_SA(b, h) (((b) * 2 + (h)) * HTB)
#define PG8_SB(b, h) ((4 + (b) * 2 + (h)) * HTB)
#define PG8_STAGE(bufoff, gbase, voff) do { _Pragma("unroll") for (int _i = 0; _i < 2; ++_i) \
        __builtin_amdgcn_global_load_lds((const unsigned*)((const char*)(gbase) + (voff)[_i]), (PG8_LAS unsigned*)(lds + (bufoff) + ldsw + _i * 8192), 16, 0, 0); } while (0)
#define PG8_LDA(dst, b, h) do { _Pragma("unroll") for (int m = 0; m < 4; ++m) _Pragma("unroll") for (int k = 0; k < 2; ++k) dst[m][k] = *(const PG8_LAS bf16x8*)(lds + PG8_SA(b, h) + aoff + m * 2048 + k * 1024); } while (0)
#define PG8_LDB(dst, b, h) do { _Pragma("unroll") for (int n = 0; n < 2; ++n) _Pragma("unroll") for (int k = 0; k < 2; ++k) dst[n][k] = *(const PG8_LAS bf16x8*)(lds + PG8_SB(b, h) + boff + n * 2048 + k * 1024); } while (0)
#define PG8_MMA(ai, bj, At, Bt) do { __builtin_amdgcn_s_setprio(1); _Pragma("unroll") for (int m = 0; m < 4; ++m) _Pragma("unroll") for (int n = 0; n < 2; ++n) _Pragma("unroll") for (int k = 0; k < 2; ++k) \
        acc[ai][bj][m][n] = __builtin_amdgcn_mfma_f32_16x16x32_bf16(Bt[n][k], At[m][k], acc[ai][bj][m][n], 0, 0, 0); __builtin_amdgcn_s_setprio(0); } while (0)
#define PG8_WAIT_V(n) asm volatile("s_waitcnt vmcnt(" #n ")" ::: "memory")
#define PG8_WAIT_L(n) asm volatile("s_waitcnt lgkmcnt(" #n ")" ::: "memory")
#define PG8_BAR __builtin_amdgcn_s_barrier()
#define PG8_SCHED __builtin_amdgcn_sched_barrier(0)
    Unit cur, nxt; int ui = 0;
    if (!S.next(0, cur)) return;
    f32x4 acc[2][2][4][2];
#pragma unroll
    for (int a = 0; a < 2; ++a)
#pragma unroll
        for (int b = 0; b < 2; ++b)
#pragma unroll
            for (int m = 0; m < 4; ++m)
#pragma unroll
                for (int n = 0; n < 2; ++n) acc[a][b][m][n] = (f32x4){0.f, 0.f, 0.f, 0.f};
    bf16x8 At[4][2], B0[2][2], B1[2][2];
    const char* cA = (const char*)g.A + (size_t)cur.pm * tstep; const char* cB = (const char*)g.Bt + (size_t)cur.pn * tstep;
    S.a_ready(cur);
    if constexpr (SP2) {
        PG8_STAGE(PG8_SB(0, 0), cB, voffB); PG8_STAGE(PG8_SB(0, 1), cB + hstep, voffB); PG8_STAGE(PG8_SA(0, 0), cA, voffA); PG8_STAGE(PG8_SA(0, 1), cA + hstep, voffA);
        if (wr == 1) PG8_BAR;
        PG8_WAIT_V(2); PG8_BAR;
        PG8_STAGE(PG8_SB(1, 0), cB + kstep, voffB); PG8_STAGE(PG8_SA(1, 0), cA + kstep, voffA); PG8_STAGE(PG8_SB(1, 1), cB + hstep + kstep, voffB);
        PG8_WAIT_V(6); PG8_BAR;
    } else {
        PG8_STAGE(PG8_SB(0, 0), cB, voffB); PG8_STAGE(PG8_SA(0, 0), cA, voffA); PG8_STAGE(PG8_SB(0, 1), cB + hstep, voffB); PG8_STAGE(PG8_SA(0, 1), cA + hstep, voffA);
        if (wr == 1) PG8_BAR;
        PG8_WAIT_V(4); PG8_BAR;
        PG8_STAGE(PG8_SB(1, 0), cB + kstep, voffB); PG8_STAGE(PG8_SA(1, 0), cA + kstep, voffA); PG8_STAGE(PG8_SB(1, 1), cB + hstep + kstep, voffB);
        PG8_WAIT_V(6); PG8_BAR;
    }
    for (;;) {
        const bool has_next = S.next(ui + 1, nxt);
        const char* nA = has_next ? (const char*)g.A + (size_t)nxt.pm * tstep : cA; const char* nB = has_next ? (const char*)g.Bt + (size_t)nxt.pn * tstep : cB;
        for (int t = 0; t < nt; t += 2) {
            const bool last = (t == nt - 2);
            const char* a1 = cA + (size_t)(t + 1) * kstep;
            const char* a2 = last ? nA : cA + (size_t)(t + 2) * kstep; const char* b2 = last ? nB : cB + (size_t)(t + 2) * kstep;
            const char* a3 = a2 + kstep; const char* b3 = b2 + kstep;
            if (last && has_next) S.a_ready(nxt);
            if constexpr (SP2) {
            PG8_LDB(B0, 0, 0); PG8_LDB(B1, 0, 1); PG8_SCHED; PG8_LDA(At, 0, 0); PG8_STAGE(PG8_SA(1, 1), a1 + hstep, voffA);
            PG8_WAIT_V(8); PG8_WAIT_L(0); PG8_BAR; PG8_MMA(0, 0, At, B0); PG8_MMA(0, 1, At, B1); PG8_BAR; PG8_SCHED;
            PG8_LDA(At, 0, 1); PG8_STAGE(PG8_SB(0, 0), b2, voffB); PG8_STAGE(PG8_SB(0, 1), b2 + hstep, voffB); PG8_STAGE(PG8_SA(0, 0), a2, voffA);
            PG8_WAIT_V(8); PG8_WAIT_L(0); PG8_BAR; PG8_MMA(1, 0, At, B0); PG8_MMA(1, 1, At, B1); PG8_BAR; PG8_SCHED;
            PG8_LDB(B0, 1, 0); PG8_LDB(B1, 1, 1); PG8_SCHED; PG8_LDA(At, 1, 0); PG8_STAGE(PG8_SA(0, 1), a2 + hstep, voffA);
            PG8_WAIT_V(8); PG8_WAIT_L(0); PG8_BAR; PG8_MMA(0, 0, At, B0); PG8_MMA(0, 1, At, B1); PG8_BAR; PG8_SCHED;
            PG8_LDA(At, 1, 1); PG8_STAGE(PG8_SB(1, 0), b3, voffB); PG8_STAGE(PG8_SB(1, 1), b3 + hstep, voffB); PG8_STAGE(PG8_SA(1, 0), a3, voffA);
            PG8_WAIT_V(8); PG8_WAIT_L(0); PG8_BAR; PG8_MMA(1, 0, At, B0); PG8_MMA(1, 1, At, B1); PG8_BAR; PG8_SCHED;
            } else {
            PG8_LDB(B0, 0, 0); PG8_SCHED; PG8_LDA(At, 0, 0); PG8_STAGE(PG8_SA(1, 1), a1 + hstep, voffA);
            PG8_WAIT_L(8); PG8_BAR; PG8_WAIT_L(0); PG8_MMA(0, 0, At, B0); PG8_BAR; PG8_SCHED;
            PG8_LDB(B1, 0, 1); PG8_STAGE(PG8_SB(0, 0), b2, voffB);
            PG8_BAR; PG8_WAIT_L(0); PG8_MMA(0, 1, At, B1); PG8_BAR;
            PG8_LDA(At, 0, 1); PG8_STAGE(PG8_SA(0, 0), a2, voffA);
            PG8_BAR; PG8_WAIT_L(0); PG8_MMA(1, 0, At, B0); PG8_BAR; PG8_SCHED;
            PG8_STAGE(PG8_SB(0, 1), b2 + hstep, voffB);
            PG8_WAIT_V(6); PG8_BAR; PG8_MMA(1, 1, At, B1); PG8_BAR;
            PG8_LDB(B0, 1, 0); PG8_SCHED; PG8_LDA(At, 1, 0); PG8_STAGE(PG8_SA(0, 1), a2 + hstep, voffA);
            PG8_WAIT_L(8); PG8_BAR; PG8_WAIT_L(0); PG8_MMA(0, 0, At, B0); PG8_BAR; PG8_SCHED;
            PG8_LDB(B1, 1, 1); PG8_STAGE(PG8_SB(1, 0), b3, voffB);
            PG8_BAR; PG8_WAIT_L(0); PG8_MMA(0, 1, At, B1); PG8_BAR;
            PG8_LDA(At, 1, 1); PG8_STAGE(PG8_SA(1, 0), a3, voffA);
            PG8_BAR; PG8_WAIT_L(0); PG8_MMA(1, 0, At, B0); PG8_BAR; PG8_SCHED;
            PG8_STAGE(PG8_SB(1, 1), b3 + hstep, voffB);
            PG8_WAIT_V(6); PG8_BAR; PG8_MMA(1, 1, At, B1); PG8_BAR;
            }
        }
        if constexpr (ALIGN_EPI) { if (wr == 0) PG8_BAR; }
        if constexpr (!Epi::AFTER_DRAIN) { E(acc, cur, wr, wc, fr, fq); S.done(cur); }
        if (!has_next) break;
#pragma unroll
        for (int a = 0; a < 2; ++a)
#pragma unroll
            for (int b = 0; b < 2; ++b)
#pragma unroll
                for (int m = 0; m < 4; ++m)
#pragma unroll
                    for (int n = 0; n < 2; ++n) acc[a][b][m][n] = (f32x4){0.f, 0.f, 0.f, 0.f};
        cur = nxt; cA = nA; cB = nB; ++ui;
        if constexpr (ALIGN_EPI) { if (wr == 1) PG8_BAR; }
    }
    PG8_WAIT_V(0);
    if constexpr (!ALIGN_EPI) { if (wr == 0) PG8_BAR; }
    PG8_BAR;
    if constexpr (Epi::AFTER_DRAIN) { E.fused(acc, cur, wr, wc, fr, fq, lds, wid, lane); S.done(cur); }
#undef PG8_SA
#undef PG8_SB
#undef PG8_STAGE
#undef PG8_LDA
#undef PG8_LDB
#undef PG8_MMA
#undef PG8_WAIT_V
#undef PG8_WAIT_L
#undef PG8_BAR
#undef PG8_SCHED
}
}

constexpr int NB = 32, T_ = 2048, DM = 1024, NTOK = NB * T_;
constexpr int NLAYER = 2;
constexpr int CIN = 10032, CPAD = 10240;
constexpr int FFH_ = 2816;
constexpr int NBC = 8, MC = NBC * T_, NCHUNK = NB / NBC;
constexpr int PC_QR = 0, PC_KR = 1024, PC_VR = 2048, PC_GR = 4096, PC_QN = 6144, PC_KV = 7168, PC_MA = 7936, PC_MB = 8960, PC_GATE = 9984;
constexpr int NCMP = 127, NCMP_PAD = 128;
constexpr float LOG2E = 1.4426950408889634f;
constexpr float QSCALE = 0.125f * LOG2E;

constexpr size_t MiB = 1u << 20;
constexpr size_t WS_CTL = 0, CTL_ZERO_BYTES = 1 * MiB;
constexpr size_t WS_ROT = 1 * MiB;
constexpr size_t WS_T5 = 3 * MiB;
constexpr size_t WS_CB = 3 * MiB + 64 * 1024;
constexpr size_t WS_WIN = 4 * MiB;
constexpr size_t WS_WORET = 44 * MiB;
constexpr size_t WS_WONSA = 52 * MiB;
constexpr size_t WS_WOUT = 56 * MiB;
constexpr size_t WS_WFFI = 60 * MiB;
constexpr size_t WS_WFFO = 82 * MiB;
constexpr size_t WS_WC1 = 93 * MiB;
constexpr size_t WS_WC2 = 97 * MiB;
constexpr size_t WS_H = 100 * MiB;
constexpr size_t WS_BIG = 228 * MiB;
constexpr size_t WS_ORET = 580 * MiB;
constexpr size_t WS_ON = 644 * MiB;
constexpr size_t WS_TMP = 676 * MiB;
constexpr size_t WS_MERGED = 708 * MiB;
constexpr size_t WS_KC = 740 * MiB;
constexpr size_t WS_GNS = 741 * MiB;
constexpr size_t WS_END = 744 * MiB;
constexpr int CW_TMO = 0, CW_BAR = 4096, CW_Q = 16384;

constexpr int NWAVES = 8;
constexpr int RING_BYTES = 131072, LDSCTL_OFF = RING_BYTES, MISC_OFF = LDSCTL_OFF + 320, LDS_BYTES = 147456;

typedef pg8::bf16_t bf16;
typedef float f32x4 __attribute__((ext_vector_type(4)));
typedef float f32x2 __attribute__((ext_vector_type(2)));
typedef unsigned u32x4 __attribute__((ext_vector_type(4)));
typedef unsigned u32x2 __attribute__((ext_vector_type(2)));
#define LAS __attribute__((address_space(3)))
#define GAS __attribute__((address_space(1)))
#define RLX_AGENT __ATOMIC_RELAXED, __HIP_MEMORY_SCOPE_AGENT
#define LDS_WAIT() asm volatile("s_waitcnt lgkmcnt(0)" ::: "memory")
#define VM_WAIT() asm volatile("s_waitcnt vmcnt(0)" ::: "memory")
typedef GAS unsigned gu32;

__device__ __forceinline__ unsigned f2bf(float f) { unsigned u = __builtin_bit_cast(unsigned, f); return (u + 0x7fffu + ((u >> 16) & 1u)) >> 16; }
__device__ __forceinline__ unsigned pk2(float lo, float hi) { return f2bf(lo) | (f2bf(hi) << 16); }
__device__ __forceinline__ float bf2f(unsigned short h) { return __builtin_bit_cast(float, (unsigned)h << 16); }
__device__ __forceinline__ float bflo(unsigned w) { return __builtin_bit_cast(float, w << 16); }
__device__ __forceinline__ float bfhi(unsigned w) { return __builtin_bit_cast(float, w & 0xffff0000u); }
__device__ __forceinline__ float sigm(float x) { return 1.f / (1.f + __expf(-x)); }
__device__ __forceinline__ float silu(float x) { return x / (1.f + __expf(-x)); }
__device__ __forceinline__ float wave_sum(float v) {
#pragma unroll
    for (int o = 1; o < 64; o <<= 1) v += __shfl_xor(v, o);
    return v;
}
__device__ __forceinline__ float wave_max(float v) {
#pragma unroll
    for (int o = 1; o < 64; o <<= 1) v = fmaxf(v, __shfl_xor(v, o));
    return v;
}

namespace epi {
using pg8::Unit;
__device__ __forceinline__ u32x4 pack8(const f32x4 a, const f32x4 b) { u32x4 w; w.x = pk2(a[0], a[1]); w.y = pk2(a[2], a[3]); w.z = pk2(b[0], b[1]); w.w = pk2(b[2], b[3]); return w; }
__device__ __forceinline__ void unpack8(const u32x4 w, f32x4& a, f32x4& b) { a = (f32x4){bflo(w.x), bfhi(w.x), bflo(w.y), bfhi(w.y)}; b = (f32x4){bflo(w.z), bfhi(w.z), bflo(w.w), bfhi(w.w)}; }

struct EpiInProj {
    static constexpr bool PERM = true, AFTER_DRAIN = false;
    bf16* O; const float* rot;
    __device__ __forceinline__ void operator()(const f32x4 (&acc)[2][2][4][2], const Unit& u, int wr, int wc, int fr, int fq) const {
        const int pn = u.pn, row0 = u.pm * 256 + wr * 64 + fr, colw = wc * 32 + 8 * fq;
        bf16* base = O + (size_t)row0 * CPAD + pn * 256 + colw;
        if (pn < 8) {
            const float sc = pn >= 4 ? 0.0625f : 1.f;
#pragma unroll
            for (int ai = 0; ai < 2; ++ai)
#pragma unroll
                for (int m = 0; m < 4; ++m) {
                    const int row = row0 + ai * 128 + m * 16, pos = row & (T_ - 1);
                    const float* cp = rot + (size_t)pos * 128 + colw; const float* sp = cp + T_ * 128;
                    f32x4 y1[2], y2[2];
#pragma unroll
                    for (int n = 0; n < 2; ++n) { const f32x4 c = *(const f32x4*)(cp + 4 * n), s = *(const f32x4*)(sp + 4 * n); const f32x4 x1 = acc[ai][0][m][n], x2 = acc[ai][1][m][n];
                        y1[n] = (x1 * c - x2 * s) * sc; y2[n] = (x1 * s + x2 * c) * sc; }
                    bf16* rp = base + (size_t)(ai * 128 + m * 16) * CPAD;
                    *(u32x4*)(rp) = pack8(y1[0], y1[1]); *(u32x4*)(rp + 128) = pack8(y2[0], y2[1]);
                }
        } else {
            const int mode = (pn >= 16 && pn < 24) ? 1 : (pn >= 24 && pn < 28) ? 2 : (pn >= 31) ? 3 : 0;
#pragma unroll
            for (int ai = 0; ai < 2; ++ai)
#pragma unroll
                for (int m = 0; m < 4; ++m) { bf16* rp = base + (size_t)(ai * 128 + m * 16) * CPAD;
#pragma unroll
                    for (int bj = 0; bj < 2; ++bj) { f32x4 v0 = acc[ai][bj][m][0], v1 = acc[ai][bj][m][1];
                        if (mode == 1) {
#pragma unroll
                            for (int i = 0; i < 4; ++i) { v0[i] = silu(v0[i]); v1[i] = silu(v1[i]); } }
                        else if (mode == 2) { v0 = v0 * QSCALE; v1 = v1 * QSCALE; }
                        else if (mode == 3) {
#pragma unroll
                            for (int i = 0; i < 4; ++i) { v0[i] = sigm(v0[i]); v1[i] = sigm(v1[i]); } }
                        *(u32x4*)(rp + bj * 128) = pack8(v0, v1); } }
        }
    }
};
template <bool ADD> struct EpiGate {
    static constexpr bool PERM = true, AFTER_DRAIN = false;
    bf16* O; const bf16* P; const bf16* G; int ldo, ldg;
    __device__ __forceinline__ void operator()(const f32x4 (&acc)[2][2][4][2], const Unit& u, int wr, int wc, int fr, int fq) const {
        const int row0 = u.pm * 256 + wr * 64 + fr, col0 = u.pn * 256 + wc * 32 + 8 * fq;
#pragma unroll
        for (int ai = 0; ai < 2; ++ai)
#pragma unroll
            for (int m = 0; m < 4; ++m) { const size_t r = (size_t)(row0 + ai * 128 + m * 16);
#pragma unroll
                for (int bj = 0; bj < 2; ++bj) { const int c = col0 + bj * 128;
                    f32x4 g0, g1; unpack8(*(const u32x4*)(G + r * ldg + c), g0, g1);
                    f32x4 v0 = acc[ai][bj][m][0] * g0, v1 = acc[ai][bj][m][1] * g1;
                    if (ADD) { f32x4 p0, p1; unpack8(*(const u32x4*)(P + r * ldo + c), p0, p1); v0 += p0; v1 += p1; }
                    *(u32x4*)(O + r * ldo + c) = pack8(v0, v1); } }
    }
};
struct EpiResid {
    static constexpr bool PERM = false, AFTER_DRAIN = false;
    const float* src; float* out;
    __device__ __forceinline__ void operator()(const f32x4 (&acc)[2][2][4][2], const Unit& u, int wr, int wc, int fr, int fq) const {
        const int row0 = u.pm * 256 + wr * 64 + fr, col0 = u.pn * 256 + wc * 32 + 4 * fq;
#pragma unroll
        for (int ai = 0; ai < 2; ++ai)
#pragma unroll
            for (int m = 0; m < 4; ++m) { const size_t off = (size_t)(row0 + ai * 128 + m * 16) * DM + col0;
#pragma unroll
                for (int bj = 0; bj < 2; ++bj)
#pragma unroll
                    for (int n = 0; n < 2; ++n) { const f32x4 s = *(const f32x4*)(src + off + bj * 128 + n * 16); *(f32x4*)(out + off + bj * 128 + n * 16) = s + acc[ai][bj][m][n]; } }
    }
};
struct EpiSwiGlu {
    static constexpr bool PERM = true, AFTER_DRAIN = false;
    bf16* O;
    __device__ __forceinline__ void operator()(const f32x4 (&acc)[2][2][4][2], const Unit& u, int wr, int wc, int fr, int fq) const {
        const int row0 = u.pm * 256 + wr * 64 + fr, col0 = u.pn * 128 + wc * 32 + 8 * fq;
#pragma unroll
        for (int ai = 0; ai < 2; ++ai)
#pragma unroll
            for (int m = 0; m < 4; ++m) { f32x4 v[2];
#pragma unroll
                for (int n = 0; n < 2; ++n) { const f32x4 a = acc[ai][0][m][n], b = acc[ai][1][m][n];
#pragma unroll
                    for (int i = 0; i < 4; ++i) v[n][i] = silu(a[i]) * b[i]; }
                *(u32x4*)(O + (size_t)(row0 + ai * 128 + m * 16) * FFH_ + col0) = pack8(v[0], v[1]); }
    }
};
}
#define XB_TMO      128
#define XB_XCNT(j)  (256  + 64 * (j))
#define XB_XSUB(j)  (1280 + 64 * (j))
#define XB_XGEN(j)  (2304 + 64 * (j))
#define XB_TOP      3328
#define XB_TOPGEN   3392
#define XCD_BAR_WORDS 3456
#define XB_SPIN_CAP (1u << 18)

__device__ __forceinline__ unsigned xb_ld(unsigned* p)              { return __hip_atomic_load(p, __ATOMIC_RELAXED, __HIP_MEMORY_SCOPE_AGENT); }
__device__ __forceinline__ unsigned xb_add(unsigned* p, unsigned v) { return __hip_atomic_fetch_add(p, v, __ATOMIC_RELAXED, __HIP_MEMORY_SCOPE_AGENT); }
__device__ __forceinline__ unsigned xb_xcc_id() { return (unsigned)__builtin_amdgcn_s_getreg((3 << 11) | 20) & 0xFu; }
#define XB_SPIN(cond, bar) do { unsigned _sp = 0; while (cond) { __builtin_amdgcn_s_sleep(1); \
    if ((++_sp & 255u) == 0u) { if (xb_ld(&(bar)[XB_TMO])) break; if (_sp > XB_SPIN_CAP) { atomicAdd(&(bar)[XB_TMO], 1u); break; } } } } while (0)

struct XcdBarrier {
    unsigned* bar; unsigned x;
    volatile LAS unsigned* st;
};

__device__ __forceinline__ XcdBarrier xcd_barrier_post(unsigned* bar, volatile LAS unsigned* st) {
    XcdBarrier b; b.bar = bar; b.x = xb_xcc_id(); b.st = st;
    if (threadIdx.x == 0) (void)xb_add(&bar[XB_XCNT(b.x)], 1u);
    return b;
}
__device__ __forceinline__ void xcd_barrier_complete(unsigned* bar, unsigned x, unsigned& nloc, unsigned& nx) {
    const unsigned G = gridDim.x * gridDim.y * gridDim.z;
    unsigned sum, cnt, mine, sp = 0u;
    for (;;) {
        sum = 0u; cnt = 0u; mine = 0u;
#pragma unroll
        for (unsigned j = 0; j < 16; ++j) { const unsigned c = xb_ld(&bar[XB_XCNT(j)]); sum += c; cnt += (c > 0u) ? 1u : 0u; mine = (j == x) ? c : mine; }
        if (sum == G) break;
        __builtin_amdgcn_s_sleep(1);
        if ((++sp & 255u) == 0u) { if (xb_ld(&bar[XB_TMO])) break; if (sp > XB_SPIN_CAP) { atomicAdd(&bar[XB_TMO], 1u); break; } }
    }
    nloc = mine > 0u ? mine : 1u; nx = cnt > 0u ? cnt : 1u;
}

__device__ __forceinline__ void xcd_barrier(const XcdBarrier& b) {
    asm volatile("s_waitcnt vmcnt(0)" ::: "memory");
    __syncthreads();
    if (threadIdx.x == 0) {
        unsigned* bar = b.bar;
        __builtin_amdgcn_s_waitcnt(0);
        unsigned nloc = b.st[0], nx = b.st[1];
        if (nloc == 0u) { xcd_barrier_complete(bar, b.x, nloc, nx); b.st[0] = nloc; b.st[1] = nx; }
        const unsigned old = xb_add(&bar[XB_XSUB(b.x)], 1u);
        const unsigned gen = old / nloc;
        if (old + 1u == (gen + 1u) * nloc) {
            __builtin_amdgcn_fence(__ATOMIC_RELEASE, "agent");
            asm volatile("s_waitcnt vmcnt(0)" ::: "memory");
            const unsigned og = xb_add(&bar[XB_TOP], 1u);
            const unsigned tg = og / nx;
            if (og + 1u == (tg + 1u) * nx) xb_add(&bar[XB_TOPGEN], 1u);
            else XB_SPIN(xb_ld(&bar[XB_TOPGEN]) == tg, bar);
            __builtin_amdgcn_fence(__ATOMIC_ACQUIRE, "agent");
            xb_add(&bar[XB_XGEN(b.x)], 1u);
            asm volatile("s_waitcnt vmcnt(0)" ::: "memory");
        } else {
            XB_SPIN(xb_ld(&bar[XB_XGEN(b.x)]) == gen, bar);
            __builtin_amdgcn_fence(__ATOMIC_ACQUIRE, "agent");
            asm volatile("s_waitcnt vmcnt(0)" ::: "memory");
        }
    }
    __syncthreads();
}

struct Args { const float* in[17]; float* out; unsigned char* ws; int it_lo, it_hi, ph_lo, ph_hi, flags, pad; };

struct Ctx { LAS unsigned char* lds; int tid, lane, wave, G, bid; };

template <class Map>
__device__ __forceinline__ void p0_transpose_item(const float* W, int K, int Nsrc, bf16* WT, int ngrp, LAS float* scr, int item, int lane, const Map& map) {
    const int kb = item / ngrp, nb = item % ngrp, k0 = 64 * kb, n0 = 32 * nb;
    const int sc = map(n0 + (lane & 31));
#pragma unroll 8
    for (int i = 0; i < 32; ++i) { const int kk = 2 * i + (lane >> 5); scr[kk * 33 + (lane & 31)] = sc >= 0 ? W[(size_t)(k0 + kk) * Nsrc + sc] : 0.f; }
    LDS_WAIT(); asm volatile("" ::: "memory");
    const int c = lane & 7;
#pragma unroll
    for (int j = 0; j < 4; ++j) { const int n = (lane >> 3) + 8 * j; const LAS float* s = scr + (8 * c) * 33 + n;
        u32x4 o; o.x = pk2(s[0 * 33], s[1 * 33]); o.y = pk2(s[2 * 33], s[3 * 33]); o.z = pk2(s[4 * 33], s[5 * 33]); o.w = pk2(s[6 * 33], s[7 * 33]);
        *(u32x4*)(WT + (size_t)(n0 + n) * K + k0 + 8 * c) = o; }
    LDS_WAIT(); asm volatile("" ::: "memory");
}
struct MapId { __device__ __forceinline__ int operator()(int n) const { return n; } };
struct MapWin { __device__ __forceinline__ int operator()(int n) const { return n < 7936 ? n : (n < 9984 ? n + 48 : (n < 10032 ? n - 2048 : -1)); } };
struct MapFfi { __device__ __forceinline__ int operator()(int n) const { const int pn = n >> 8, j = n & 255; return j < 128 ? 128 * pn + j : FFH_ + 128 * pn + (j - 128); } };

__device__ __forceinline__ void p0_prologue(const Ctx& C, const Args& a) {
    unsigned char* ws = a.ws;
    LAS float* scr = (LAS float*)(C.lds + C.wave * 16384);
    const int gw = C.bid * NWAVES + C.wave, NGW = C.G * NWAVES;
    constexpr int I_IN = 16 * 320, I_OR = 32 * 32, I_ON = 16 * 32, I_OUT = 16 * 32, I_FI = 16 * 176, I_FO = 44 * 32, I_C1 = 32 * 8, I_L = I_IN + I_OR + I_ON + I_OUT + I_FI + I_FO + 2 * I_C1;
    for (int it = gw; it < NLAYER * I_L; it += NGW) {
        const int L = it / I_L; int r = it % I_L;
        if (r < I_IN) { p0_transpose_item(a.in[2] + (size_t)L * DM * CIN, DM, CIN, (bf16*)(ws + WS_WIN) + (size_t)L * CPAD * DM, 320, scr, r, C.lane, MapWin()); continue; } r -= I_IN;
        if (r < I_OR) { p0_transpose_item(a.in[9] + (size_t)L * 2048 * DM, 2048, DM, (bf16*)(ws + WS_WORET) + (size_t)L * DM * 2048, 32, scr, r, C.lane, MapId()); continue; } r -= I_OR;
        if (r < I_ON) { p0_transpose_item(a.in[10] + (size_t)L * DM * DM, DM, DM, (bf16*)(ws + WS_WONSA) + (size_t)L * DM * DM, 32, scr, r, C.lane, MapId()); continue; } r -= I_ON;
        if (r < I_OUT) { p0_transpose_item(a.in[11] + (size_t)L * DM * DM, DM, DM, (bf16*)(ws + WS_WOUT) + (size_t)L * DM * DM, 32, scr, r, C.lane, MapId()); continue; } r -= I_OUT;
        if (r < I_FI) { p0_transpose_item(a.in[13] + (size_t)L * DM * 2 * FFH_, DM, 2 * FFH_, (bf16*)(ws + WS_WFFI) + (size_t)L * 2 * FFH_ * DM, 176, scr, r, C.lane, MapFfi()); continue; } r -= I_FI;
        if (r < I_FO) { p0_transpose_item(a.in[14] + (size_t)L * FFH_ * DM, FFH_, DM, (bf16*)(ws + WS_WFFO) + (size_t)L * DM * FFH_, 32, scr, r, C.lane, MapId()); continue; } r -= I_FO;
        if (r < I_C1) { p0_transpose_item(a.in[5] + (size_t)L * 2048 * 256, 2048, 256, (bf16*)(ws + WS_WC1) + (size_t)(L * 2 + 0) * 256 * 2048, 8, scr, r, C.lane, MapId()); continue; } r -= I_C1;
        p0_transpose_item(a.in[7] + (size_t)L * 2048 * 256, 2048, 256, (bf16*)(ws + WS_WC1) + (size_t)(L * 2 + 1) * 256 * 2048, 8, scr, r, C.lane, MapId());
    }
    const int gt = C.bid * 512 + C.tid, NGT = C.G * 512;
    float* rot = (float*)(ws + WS_ROT);
    for (int i = gt; i < T_ * 128; i += NGT) { const int pos = i >> 7, d = i & 127; const double f = pow(10000.0, -(double)d / 128.0), ang = (double)pos * f; rot[i] = (float)cos(ang); rot[T_ * 128 + i] = (float)sin(ang); }
    float* t5 = (float*)(ws + WS_T5);
    for (int i = gt; i < 16 * 128; i += NGT) { const int hd = i >> 7, dist = i & 127; int bk = dist;
        if (dist >= 16) { bk = 16 + (int)(log((double)dist / 16.0) / log(8.0) * 16.0); if (bk > 31) bk = 31; }
        t5[i] = a.in[15][bk * 16 + hd] * LOG2E; }
}

__device__ __forceinline__ void rms_row_to_bf16(const float* xrow, const float* g, bf16* orow, int lane) {
    const f32x4* xr = (const f32x4*)xrow + lane; const f32x4* gr = (const f32x4*)g + lane;
    f32x4 v[4]; float s = 0.f;
#pragma unroll
    for (int j = 0; j < 4; ++j) { v[j] = xr[64 * j]; s += (v[j].x * v[j].x + v[j].y * v[j].y) + (v[j].z * v[j].z + v[j].w * v[j].w); }
    const float r = 1.f / sqrtf(wave_sum(s) * (1.f / DM) + 1e-6f);
    u32x2* o8 = (u32x2*)orow + lane;
#pragma unroll
    for (int j = 0; j < 4; ++j) { const f32x4 gg = gr[64 * j]; u32x2 w; w.x = pk2(v[j].x * r * gg.x, v[j].y * r * gg.y); w.y = pk2(v[j].z * r * gg.z, v[j].w * r * gg.w); o8[64 * j] = w; }
}
__device__ __forceinline__ void rms_row_f32(float* xrow, const float* g, int lane) {
    f32x4* xr = (f32x4*)xrow + lane; const f32x4* gr = (const f32x4*)g + lane;
    f32x4 v[4]; float s = 0.f;
#pragma unroll
    for (int j = 0; j < 4; ++j) { v[j] = xr[64 * j]; s += (v[j].x * v[j].x + v[j].y * v[j].y) + (v[j].z * v[j].z + v[j].w * v[j].w); }
    const float r = 1.f / sqrtf(wave_sum(s) * (1.f / DM) + 1e-6f);
#pragma unroll
    for (int j = 0; j < 4; ++j) xr[64 * j] = v[j] * r * gr[64 * j];
}

__device__ __forceinline__ float dot8(const u32x4 w, const LAS float* q) {
    return bflo(w.x) * q[0] + bfhi(w.x) * q[1] + bflo(w.y) * q[2] + bfhi(w.y) * q[3] + bflo(w.z) * q[4] + bfhi(w.z) * q[5] + bflo(w.w) * q[6] + bfhi(w.w) * q[7];
}
__device__ __forceinline__ float gelu_tanh(float x) { const float u = 0.7978845608028654f * (x + 0.044715f * x * x * x); return 0.5f * x * (1.f + tanhf(u)); }

__device__ __forceinline__ void compress_naive_unit(const Ctx& C, int u, const bf16* PROJ, const float* pos, const float* w1, const float* w2, bf16* KCV) {
    const int n = u % NCMP, g = (u / NCMP) & 1, b = (u / (2 * NCMP)) % NBC, kv = u / (2 * NCMP * NBC);
    LAS float* xin = (LAS float*)C.lds; LAS float* part = xin + 2048; LAS float* hid = part + 512;
    const float* pe = pos;
    for (int i = C.tid; i < 2048; i += 512) { const int l = i >> 6, d = i & 63;
        xin[i] = bf2f(PROJ[(size_t)(b * T_ + n * 16 + l) * CPAD + PC_KV + kv * 128 + g * 64 + d]) + pe[i]; }
    __syncthreads();
    { const int j = C.tid & 255, half = C.tid >> 8; float s = 0.f; const float* wp = w1 + (size_t)(half * 1024) * 256 + j; const LAS float* xp = xin + half * 1024;
      for (int i = 0; i < 1024; ++i) s += xp[i] * wp[(size_t)i * 256];
      part[half * 256 + j] = s; }
    __syncthreads();
    if (C.tid < 256) hid[C.tid] = gelu_tanh(part[C.tid] + part[256 + C.tid]);
    __syncthreads();
    if (C.tid < 64) { float s = 0.f; for (int j = 0; j < 256; ++j) s += hid[j] * w2[j * 64 + C.tid];
        bf16* o = KCV + ((size_t)((kv * NBC + b) * 2 + g) * NCMP_PAD) * 64;
        o[n * 64 + C.tid] = (bf16)f2bf(s); if (n == 0) o[127 * 64 + C.tid] = 0; }
    __syncthreads();
}

__device__ __forceinline__ void ret_naive_unit(const Ctx& C, int u, const bf16* PROJ, bf16* ORET) {
    const int tq = u & 255, h = (u >> 8) & 3, b = u >> 10, t = tq * 8 + C.wave, lane = C.lane;
    const size_t tok0 = (size_t)b * T_;
    LAS float* qs = (LAS float*)C.lds + C.wave * 256; LAS float* sc = (LAS float*)(C.lds + 8192) + C.wave * 2048;
    const bf16* qrow = PROJ + (tok0 + t) * CPAD + PC_QR + h * 256;
    for (int d = lane; d < 256; d += 64) qs[d] = bf2f(qrow[d]);
    __syncthreads();
    const float l2g = log2f(1.f - exp2f(-5.f - (float)h));
    for (int m0 = 0; m0 <= t; m0 += 64) { const int m = m0 + lane;
        if (m <= t) { const bf16* krow = PROJ + (tok0 + m) * CPAD + PC_KR + h * 256; float s = 0.f;
            for (int c = 0; c < 32; ++c) s += dot8(*(const u32x4*)(krow + 8 * c), qs + 8 * c);
            sc[m] = s * exp2f((float)(t - m) * l2g); } }
    __syncthreads();
    float acc[8];
#pragma unroll
    for (int i = 0; i < 8; ++i) acc[i] = 0.f;
    const bf16* vb = PROJ + tok0 * CPAD + PC_VR + h * 512 + lane * 8;
    for (int m = 0; m <= t; ++m) { const float p = sc[m]; const u32x4 w = *(const u32x4*)(vb + (size_t)m * CPAD);
        acc[0] += p * bflo(w.x); acc[1] += p * bfhi(w.x); acc[2] += p * bflo(w.y); acc[3] += p * bfhi(w.y); acc[4] += p * bflo(w.z); acc[5] += p * bfhi(w.z); acc[6] += p * bflo(w.w); acc[7] += p * bfhi(w.w); }
    float s = 0.f;
#pragma unroll
    for (int i = 0; i < 8; ++i) s += acc[i];
    const float mean = wave_sum(s) * (1.f / 512.f); float q = 0.f;
#pragma unroll
    for (int i = 0; i < 8; ++i) { acc[i] -= mean; q += acc[i] * acc[i]; }
    const float rstd = 1.f / sqrtf(wave_sum(q) * (1.f / 512.f) + 1e-5f);
    const u32x4 gw = *(const u32x4*)(PROJ + (tok0 + t) * CPAD + PC_GR + h * 512 + lane * 8);
    u32x4 o; o.x = pk2(acc[0] * rstd * bflo(gw.x), acc[1] * rstd * bfhi(gw.x)); o.y = pk2(acc[2] * rstd * bflo(gw.y), acc[3] * rstd * bfhi(gw.y));
    o.z = pk2(acc[4] * rstd * bflo(gw.z), acc[5] * rstd * bfhi(gw.z)); o.w = pk2(acc[6] * rstd * bflo(gw.w), acc[7] * rstd * bfhi(gw.w));
    *(u32x4*)(ORET + (tok0 + t) * 2048 + h * 512 + lane * 8) = o;
    __syncthreads();
}

__device__ __forceinline__ float nsa_dot64(const bf16* krow, const LAS float* q) {
    float s = 0.f;
#pragma unroll
    for (int c = 0; c < 8; ++c) s += dot8(*(const u32x4*)(krow + 8 * c), q + 8 * c);
    return s;
}
__device__ __forceinline__ void nsa_naive_unit(const Ctx& C, int u, const bf16* PROJ, const bf16* KCV, const float* t5, bf16* ON) {
    const int t = u & (T_ - 1), g = (u >> 11) & 1, b = u >> 12, h = C.wave, head = g * 8 + h, lane = C.lane;
    const size_t tok0 = (size_t)b * T_, tok = tok0 + t;
    LAS float* qs = (LAS float*)C.lds + h * 64; LAS float* pcs = (LAS float*)(C.lds + 2048); LAS float* lg = (LAS float*)(C.lds + 8192) + h * 512;
    LAS float* imp = (LAS float*)(C.lds + 24576); LAS int* sel = (LAS int*)(C.lds + 24576 + 128);
    const float* tb = t5 + head * 128;
    qs[lane] = bf2f(PROJ[tok * CPAD + PC_QN + head * 64 + lane]);
    __syncthreads();
    const bf16* kc = KCV + ((size_t)((0 * NBC + b) * 2 + g) * NCMP_PAD) * 64; const bf16* vc = KCV + ((size_t)((1 * NBC + b) * 2 + g) * NCMP_PAD) * 64;
    float l[2]; bool ok[2];
#pragma unroll
    for (int r = 0; r < 2; ++r) { const int n = lane + 64 * r; ok[r] = (n < NCMP) && (16 * n + 31 <= t);
        l[r] = -1e30f; if (ok[r]) { int dist = t - 16 * n - 31; dist = dist > 127 ? 127 : dist; l[r] = nsa_dot64(kc + n * 64, qs) + tb[dist]; } }
    { const float mx = wave_max(fmaxf(l[0], l[1])); const float e0 = ok[0] ? exp2f(l[0] - mx) : 0.f, e1 = ok[1] ? exp2f(l[1] - mx) : 0.f;
      const float inv = 1.f / fmaxf(wave_sum(e0 + e1), 1e-30f); pcs[h * 128 + lane] = e0 * inv; pcs[h * 128 + 64 + lane] = e1 * inv; }
    __syncthreads();
    float oc = 0.f;
    for (int n = 0; n < NCMP; ++n) oc += pcs[h * 128 + n] * bf2f(vc[n * 64 + lane]);
    const int cur = t >> 6;
    if (C.tid < 32) { const int j = C.tid; float v = 0.f; const int n0 = 4 * j - 1 < 0 ? 0 : 4 * j - 1, n1 = 4 * j + 3 > NCMP - 1 ? NCMP - 1 : 4 * j + 3;
        for (int hh = 0; hh < 8; ++hh) for (int n = n0; n <= n1; ++n) v += pcs[hh * 128 + n];
        if (j == 0 || j == cur || j == cur - 1) v = 1e4f; if (j > cur) v = -1e30f; imp[j] = v; }
    __syncthreads();
    if (C.tid == 0) { unsigned used = 0u; int ns = 0;
        for (int k = 0; k < 8; ++k) { int best = -1; float bv = -1e29f;
            for (int j = 0; j < 32; ++j) if (!((used >> j) & 1u) && imp[j] > bv) { bv = imp[j]; best = j; }
            if (best < 0) break; used |= 1u << best; sel[ns++] = best; }
        sel[8] = ns; }
    __syncthreads();
    const int ns = sel[8];
    float os = 0.f;
    { float mx = -1e30f;
      for (int i = 0; i < ns; ++i) { const int key = 64 * sel[i] + lane; float v = -1e30f;
          if (key <= t) { int dist = t - key; dist = dist > 127 ? 127 : dist; v = nsa_dot64(PROJ + (tok0 + key) * CPAD + PC_KV + 2 * 128 + g * 64, qs) + tb[dist]; }
          lg[i * 64 + lane] = v; mx = fmaxf(mx, v); }
      mx = wave_max(mx); float s = 0.f;
      for (int i = 0; i < ns; ++i) { const int key = 64 * sel[i] + lane; const float e = key <= t ? exp2f(lg[i * 64 + lane] - mx) : 0.f; lg[i * 64 + lane] = e; s += e; }
      const float inv = 1.f / fmaxf(wave_sum(s), 1e-30f);
      __syncthreads();
      for (int i = 0; i < ns; ++i) { const bf16* vb = PROJ + (tok0 + 64 * sel[i]) * CPAD + PC_KV + 3 * 128 + g * 64 + lane;
          for (int kk = 0; kk < 64; ++kk) os += lg[i * 64 + kk] * bf2f(vb[(size_t)kk * CPAD]); }
      os *= inv; }
    __syncthreads();
    float ow = 0.f;
    { float mx = -1e30f;
      for (int i = 0; i < 8; ++i) { const int key = t - 511 + 64 * i + lane; float v = -1e30f;
          if (key >= 0) { int dist = t - key; dist = dist > 127 ? 127 : dist; v = nsa_dot64(PROJ + (tok0 + key) * CPAD + PC_KV + 4 * 128 + g * 64, qs) + tb[dist]; }
          lg[i * 64 + lane] = v; mx = fmaxf(mx, v); }
      mx = wave_max(mx); float s = 0.f;
      for (int i = 0; i < 8; ++i) { const int key = t - 511 + 64 * i + lane; const float e = key >= 0 ? exp2f(lg[i * 64 + lane] - mx) : 0.f; lg[i * 64 + lane] = e; s += e; }
      const float inv = 1.f / fmaxf(wave_sum(s), 1e-30f);
      __syncthreads();
      for (int i = 0; i < 8; ++i) for (int kk = 0; kk < 64; ++kk) { const int key = t - 511 + 64 * i + kk; if (key >= 0) ow += lg[i * 64 + kk] * bf2f(PROJ[(tok0 + key) * CPAD + PC_KV + 5 * 128 + g * 64 + lane]); }
      ow *= inv; }
    const bf16* gp = PROJ + tok * CPAD + PC_GATE + head * 3;
    const float r = bf2f(gp[0]) * oc + bf2f(gp[1]) * os + bf2f(gp[2]) * ow;
    ON[tok * DM + head * 64 + lane] = (bf16)f2bf(r);
    __syncthreads();
}

__global__ void __launch_bounds__(NWAVES * 64, 2) fwd(Args a) {
    extern __shared__ __attribute__((aligned(16))) unsigned char lds_raw[];
    Ctx C; C.lds = (LAS unsigned char*)lds_raw; C.tid = threadIdx.x; C.lane = C.tid & 63; C.wave = __builtin_amdgcn_readfirstlane(C.tid >> 6); C.G = gridDim.x; C.bid = blockIdx.x;
    unsigned char* ws = a.ws;
    gu32* ctl = (gu32*)(ws + WS_CTL);
    volatile LAS unsigned* MISC = (volatile LAS unsigned*)(C.lds + MISC_OFF);
    for (int u = C.tid; u < (LDS_BYTES - LDSCTL_OFF) / 4; u += NWAVES * 64) ((LAS unsigned*)(C.lds + LDSCTL_OFF))[u] = 0u;
    __syncthreads();
    const bool one = (a.flags & 1) != 0;
    XcdBarrier bar; bar.bar = (unsigned*)(ctl + CW_BAR); bar.x = 0; bar.st = nullptr;
    if (one) bar = xcd_barrier_post((unsigned*)(ctl + CW_BAR), MISC + 8);
#define SEAM() do { if (one) xcd_barrier(bar); } while (0)
#define PH(k) (a.ph_lo <= (k) && (k) < a.ph_hi)
#define RELOAD() do { int t_ = threadIdx.x; asm volatile("" : "+v"(t_)); C.tid = t_; C.lane = t_ & 63; C.wave = __builtin_amdgcn_readfirstlane(t_ >> 6); gw = C.bid * NWAVES + C.wave; } while (0)
    int gw = C.bid * NWAVES + C.wave; const int NGW = C.G * NWAVES;
    bf16* const H = (bf16*)(ws + WS_H); bf16* const PROJ = (bf16*)(ws + WS_BIG); bf16* const FFH = (bf16*)(ws + WS_BIG);
    bf16* const ORET = (bf16*)(ws + WS_ORET); bf16* const ON = (bf16*)(ws + WS_ON); bf16* const TMP = (bf16*)(ws + WS_TMP); bf16* const MERGED = (bf16*)(ws + WS_MERGED);
    bf16* const KCV = (bf16*)(ws + WS_KC);
    const float* rot = (const float*)(ws + WS_ROT); const float* t5 = (const float*)(ws + WS_T5);

    if (a.it_lo < 0) { RELOAD(); p0_prologue(C, a); SEAM(); }
    const int it0 = a.it_lo < 0 ? 0 : a.it_lo, it1 = a.it_hi > 10 ? 10 : a.it_hi;
    for (int it = it0; it < it1; ++it) {
        int itv = it; asm volatile("" : "+s"(itv)); const int L = itv / 5, sub = itv % 5;
        if (sub < 4) {
            const size_t row0 = (size_t)sub * MC;
            const float* xsrc = (L == 0 ? a.in[0] : (const float*)a.out) + row0 * DM;
            float* xdst = a.out + row0 * DM;
            if (PH(0)) { RELOAD(); const float* g = a.in[1] + L * DM; for (int m = gw; m < MC; m += NGW) rms_row_to_bf16(xsrc + (size_t)m * DM, g, H + (size_t)m * DM, C.lane); SEAM(); }
            if (PH(1)) { pg8::Gemm g{H, (const bf16*)(ws + WS_WIN) + (size_t)L * CPAD * DM, MC, CPAD, DM}; pg8::StaticOrder S; S.init(MC, CPAD, C.G, C.bid);
                epi::EpiInProj E{PROJ, rot}; pg8::gemm_phase<epi::EpiInProj, pg8::StaticOrder, true, true>(C.lds, g, S, E); SEAM(); }
            if (PH(2)) { RELOAD(); for (int u = C.bid; u < 2 * NBC * 2 * NCMP; u += C.G) { const int kv = u / (2 * NCMP * NBC);
                    compress_naive_unit(C, u, PROJ, (kv ? a.in[4] : a.in[3]) + L * 2048, (kv ? a.in[7] : a.in[5]) + (size_t)L * 2048 * 256, (kv ? a.in[8] : a.in[6]) + (size_t)L * 256 * 64, KCV); }
                SEAM(); }
            if (PH(3)) { RELOAD(); for (int u = C.bid; u < NBC * 4 * 256; u += C.G) ret_naive_unit(C, u, PROJ, ORET);
                RELOAD(); for (int u = C.bid; u < NBC * 2 * T_; u += C.G) nsa_naive_unit(C, u, PROJ, KCV, t5, ON);
                SEAM(); }
            if (PH(4)) { pg8::Gemm g{ORET, (const bf16*)(ws + WS_WORET) + (size_t)L * DM * 2048, MC, DM, 2048}; pg8::StaticOrder S; S.init(MC, DM, C.G, C.bid);
                epi::EpiGate<false> E{TMP, nullptr, PROJ + PC_MA, DM, CPAD}; pg8::gemm_phase<epi::EpiGate<false>, pg8::StaticOrder, true, true>(C.lds, g, S, E); SEAM(); }
            if (PH(5)) { pg8::Gemm g{ON, (const bf16*)(ws + WS_WONSA) + (size_t)L * DM * DM, MC, DM, DM}; pg8::StaticOrder S; S.init(MC, DM, C.G, C.bid);
                epi::EpiGate<true> E{MERGED, TMP, PROJ + PC_MB, DM, CPAD}; pg8::gemm_phase<epi::EpiGate<true>, pg8::StaticOrder, true, true>(C.lds, g, S, E); SEAM(); }
            if (PH(6)) { pg8::Gemm g{MERGED, (const bf16*)(ws + WS_WOUT) + (size_t)L * DM * DM, MC, DM, DM}; pg8::StaticOrder S; S.init(MC, DM, C.G, C.bid);
                epi::EpiResid E{xsrc, xdst}; pg8::gemm_phase<epi::EpiResid, pg8::StaticOrder, true, true>(C.lds, g, S, E); SEAM(); }
        } else {
            if (PH(0)) { RELOAD(); const float* g = a.in[12] + L * DM; for (int m = gw; m < NTOK; m += NGW) rms_row_to_bf16(a.out + (size_t)m * DM, g, H + (size_t)m * DM, C.lane); SEAM(); }
            if (PH(1)) { pg8::Gemm g{H, (const bf16*)(ws + WS_WFFI) + (size_t)L * 2 * FFH_ * DM, NTOK, 2 * FFH_, DM}; pg8::StaticOrder S; S.init(NTOK, 2 * FFH_, C.G, C.bid);
                epi::EpiSwiGlu E{FFH}; pg8::gemm_phase<epi::EpiSwiGlu, pg8::StaticOrder, true, true>(C.lds, g, S, E); SEAM(); }
            if (PH(2)) { pg8::Gemm g{FFH, (const bf16*)(ws + WS_WFFO) + (size_t)L * DM * FFH_, NTOK, DM, FFH_}; pg8::StaticOrder S; S.init(NTOK, DM, C.G, C.bid);
                epi::EpiResid E{a.out, a.out}; pg8::gemm_phase<epi::EpiResid, pg8::StaticOrder, true, true>(C.lds, g, S, E); SEAM(); }
        }
    }
    if (a.it_hi > 10) { RELOAD(); const float* g = a.in[16]; for (int m = gw; m < NTOK; m += NGW) rms_row_f32(a.out + (size_t)m * DM, g, C.lane); }
#undef SEAM
#undef PH
}

#ifndef ONE_LAUNCH
#define ONE_LAUNCH 1
#endif
extern "C" void kernel_launch(void* const* d_in, const int* in_sizes, int n_in, void* d_out, int out_size, void* d_ws, size_t ws_size, hipStream_t stream) {
    static int grid = 0;
    if (grid == 0) {
        if (n_in != 17 || in_sizes[0] != NTOK * DM || out_size != NTOK * DM || ws_size < WS_END) { fprintf(stderr, "kernel_launch: unexpected shapes (n_in %d, in0 %d, out %d, ws %zu); nothing launched\n", n_in, n_in > 0 ? in_sizes[0] : -1, out_size, ws_size); grid = -1; return; }
        int dev = 0, cus = 0, per_cu = 0;
        if (hipGetDevice(&dev) != hipSuccess || hipDeviceGetAttribute(&cus, hipDeviceAttributeMultiprocessorCount, dev) != hipSuccess) { grid = -1; return; }
        if (hipFuncSetAttribute((const void*)fwd, hipFuncAttributeMaxDynamicSharedMemorySize, LDS_BYTES) != hipSuccess) { fprintf(stderr, "kernel_launch: hipFuncSetAttribute failed\n"); grid = -1; return; }
        if (hipOccupancyMaxActiveBlocksPerMultiprocessor(&per_cu, (const void*)fwd, NWAVES * 64, LDS_BYTES) != hipSuccess || per_cu < 1) { fprintf(stderr, "kernel_launch: occupancy query says %d\n", per_cu); }
        (void)hipGetLastError();
        grid = cus;
    }
    if (grid < 0) return;
    (void)hipMemsetAsync((char*)d_ws + WS_CTL, 0, CTL_ZERO_BYTES, stream);
    Args a{};
    for (int i = 0; i < 17; ++i) a.in[i] = (const float*)d_in[i];
    a.out = (float*)d_out; a.ws = (unsigned char*)d_ws;
#if ONE_LAUNCH
    a.it_lo = -1; a.it_hi = 11; a.ph_lo = 0; a.ph_hi = 99; a.flags = 1;
    hipLaunchKernelGGL(fwd, dim3(grid), dim3(NWAVES * 64), LDS_BYTES, stream, a);
#else
    a.flags = 0;
    a.it_lo = -1; a.it_hi = 0; a.ph_lo = 0; a.ph_hi = 0; hipLaunchKernelGGL(fwd, dim3(grid), dim3(NWAVES * 64), LDS_BYTES, stream, a);
    for (int it = 0; it < 10; ++it) { const int nph = (it % 5 < 4) ? 7 : 3;
        for (int ph = 0; ph < nph; ++ph) { a.it_lo = it; a.it_hi = it + 1; a.ph_lo = ph; a.ph_hi = ph + 1; hipLaunchKernelGGL(fwd, dim3(grid), dim3(NWAVES * 64), LDS_BYTES, stream, a); } }
    a.it_lo = 10; a.it_hi = 11; a.ph_lo = 0; a.ph_hi = 0; hipLaunchKernelGGL(fwd, dim3(grid), dim3(NWAVES * 64), LDS_BYTES, stream, a);
#endif
}
```

```cpp
#include <hip/hip_runtime.h>
#include <cstdio>
#include <cstdint>
#ifndef DBG_NSA
#define DBG_NSA 0
#endif
#ifndef DBG_BR
#define DBG_BR -1
#endif
namespace pg8 {
#define PG8_LAS __attribute__((address_space(3)))
typedef unsigned short bf16_t;
typedef short bf16x8 __attribute__((ext_vector_type(8)));
typedef float f32x4 __attribute__((ext_vector_type(4)));
typedef unsigned u32x4 __attribute__((ext_vector_type(4)));
constexpr int BM = 256, BK = 64, HALF = 128, HTB = HALF * BK * 2  , STAGE_BYTES = 8 * HTB, NXCD = 8, WGM = 8;

__host__ __device__ __forceinline__ int lds_byte(int r, int c) { const int st = (r >> 4) * 2 + (c >> 5), rr = r & 15, cc = c & 31, ob = rr * 64 + cc * 2; return st * 1024 + (ob ^ (((ob >> 9) & 1) << 5)); }
__host__ __device__ __forceinline__ void stage_rc(int b, int& R, int& C) { const int st = b / 1024, sb = b % 1024, swz = sb ^ (((sb >> 9) & 1) << 5); R = (st >> 1) * 16 + swz / 64; C = (st & 1) * 32 + (swz % 64) / 2; }
__host__ __device__ __forceinline__ int perm32(int rho) { const int n = rho >> 4, i = rho & 15; return 8 * (i >> 2) + 4 * n + (i & 3); }

struct Unit { int pm, pn; };
struct Gemm { const bf16_t* A; const bf16_t* Bt; int M, N, K; };

struct StaticOrder {
    int nM, nN, nwg, G, c;
    __host__ __device__ void init(int M, int N, int G_, int c_) { nM = M / BM; nN = N / BM; nwg = nM * nN; G = G_; c = c_; }
    __host__ __device__ bool next(int i, Unit& u) const {
        const long L = (long)i * G + c; if (L >= nwg) return false;
        int wgid = (int)L; { const int q = nwg / NXCD, r = nwg % NXCD, xcd = wgid % NXCD, off = wgid / NXCD; wgid = (xcd < r ? xcd * (q + 1) : r * (q + 1) + (xcd - r) * q) + off; }
        const int nig = WGM * nN, gid = wgid / nig, fm = gid * WGM, gsz = (nM - fm) < WGM ? (nM - fm) : WGM;
        u.pm = fm + ((wgid % nig) % gsz); u.pn = (wgid % nig) / gsz; return true;
    }
    __device__ __forceinline__ void a_ready(const Unit&) const {}
    __device__ __forceinline__ void done(const Unit&) const {}
};

template <class Epi, class Sched, bool ALIGN_EPI = false, bool SP2 = false>
__device__ __forceinline__ void gemm_phase(PG8_LAS unsigned char* lds, const Gemm g, const Sched& S, const Epi& E) {
    int tid_ = threadIdx.x; asm volatile("" : "+v"(tid_));
    const int tid = tid_, wid = __builtin_amdgcn_readfirstlane(tid >> 6), lane = tid & 63, wr = wid >> 2, wc = wid & 3, fr = lane & 15, fq = lane >> 4;
    const int K = g.K, nt = K / BK;
    unsigned voffA[2], voffB[2];
#pragma unroll
    for (int i = 0; i < 2; ++i) { int R, C; stage_rc(tid * 16 + i * 8192, R, C); const int Rb = Epi::PERM ? ((R & ~31) + perm32(R & 31)) : R;
        voffA[i] = (unsigned)(R * K + C) * 2u; voffB[i] = (unsigned)(Rb * K + C) * 2u; }
    const size_t kstep = (size_t)(BK * 2);
    const size_t hstep = (size_t)HALF * K * 2;
    const size_t tstep = 2 * hstep;
    const unsigned ldsw = (unsigned)wid * 1024u;
    const int aoff = lds_byte(wr * 64 + fr, fq * 8), boff = lds_byte(wc * 32 + fr, fq * 8);
#define PG8_SA(b, h) (((b) * 2 + (h)) * HTB)
#define PG8_SB(b, h) ((4 + (b) * 2 + (h)) * HTB)
#define PG8_STAGE(bufoff, gbase, voff) do { _Pragma("unroll") for (int _i = 0; _i < 2; ++_i) \
        __builtin_amdgcn_global_load_lds((const unsigned*)((const char*)(gbase) + (voff)[_i]), (PG8_LAS unsigned*)(lds + (bufoff) + ldsw + _i * 8192), 16, 0, 0); } while (0)
#define PG8_LDA(dst, b, h) do { _Pragma("unroll") for (int m = 0; m < 4; ++m) _Pragma("unroll") for (int k = 0; k < 2; ++k) dst[m][k] = *(const PG8_LAS bf16x8*)(lds + PG8_SA(b, h) + aoff + m * 2048 + k * 1024); } while (0)
#define PG8_LDB(dst, b, h) do { _Pragma("unroll") for (int n = 0; n < 2; ++n) _Pragma("unroll") for (int k = 0; k < 2; ++k) dst[n][k] = *(const PG8_LAS bf16x8*)(lds + PG8_SB(b, h) + boff + n * 2048 + k * 1024); } while (0)
#define PG8_MMA(ai, bj, At, Bt) do { __builtin_amdgcn_s_setprio(1); _Pragma("unroll") for (int m = 0; m < 4; ++m) _Pragma("unroll") for (int n = 0; n < 2; ++n) _Pragma("unroll") for (int k = 0; k < 2; ++k) \
        acc[ai][bj][m][n] = __builtin_amdgcn_mfma_f32_16x16x32_bf16(Bt[n][k], At[m][k], acc[ai][bj][m][n], 0, 0, 0); __builtin_amdgcn_s_setprio(0); } while (0)
#define PG8_WAIT_V(n) asm volatile("s_waitcnt vmcnt(" #n ")" ::: "memory")
#define PG8_WAIT_L(n) asm volatile("s_waitcnt lgkmcnt(" #n ")" ::: "memory")
#define PG8_BAR __builtin_amdgcn_s_barrier()
#define PG8_SCHED __builtin_amdgcn_sched_barrier(0)
    Unit cur, nxt; int ui = 0;
    if (!S.next(0, cur)) return;
    f32x4 acc[2][2][4][2];
#pragma unroll
    for (int a = 0; a < 2; ++a)
#pragma unroll
        for (int b = 0; b < 2; ++b)
#pragma unroll
            for (int m = 0; m < 4; ++m)
#pragma unroll
                for (int n = 0; n < 2; ++n) acc[a][b][m][n] = (f32x4){0.f, 0.f, 0.f, 0.f};
    bf16x8 At[4][2], B0[2][2], B1[2][2];
    const char* cA = (const char*)g.A + (size_t)cur.pm * tstep; const char* cB = (const char*)g.Bt + (size_t)cur.pn * tstep;
    S.a_ready(cur);
    if constexpr (SP2) {
        PG8_STAGE(PG8_SB(0, 0), cB, voffB); PG8_STAGE(PG8_SB(0, 1), cB + hstep, voffB); PG8_STAGE(PG8_SA(0, 0), cA, voffA); PG8_STAGE(PG8_SA(0, 1), cA + hstep, voffA);
        if (wr == 1) PG8_BAR;
        PG8_WAIT_V(2); PG8_BAR;
        PG8_STAGE(PG8_SB(1, 0), cB + kstep, voffB); PG8_STAGE(PG8_SA(1, 0), cA + kstep, voffA); PG8_STAGE(PG8_SB(1, 1), cB + hstep + kstep, voffB);
        PG8_WAIT_V(6); PG8_BAR;
    } else {
        PG8_STAGE(PG8_SB(0, 0), cB, voffB); PG8_STAGE(PG8_SA(0, 0), cA, voffA); PG8_STAGE(PG8_SB(0, 1), cB + hstep, voffB); PG8_STAGE(PG8_SA(0, 1), cA + hstep, voffA);
        if (wr == 1) PG8_BAR;
        PG8_WAIT_V(4); PG8_BAR;
        PG8_STAGE(PG8_SB(1, 0), cB + kstep, voffB); PG8_STAGE(PG8_SA(1, 0), cA + kstep, voffA); PG8_STAGE(PG8_SB(1, 1), cB + hstep + kstep, voffB);
        PG8_WAIT_V(6); PG8_BAR;
    }
    for (;;) {
        const bool has_next = S.next(ui + 1, nxt);
        const char* nA = has_next ? (const char*)g.A + (size_t)nxt.pm * tstep : cA; const char* nB = has_next ? (const char*)g.Bt + (size_t)nxt.pn * tstep : cB;
        for (int t = 0; t < nt; t += 2) {
            const bool last = (t == nt - 2);
            const char* a1 = cA + (size_t)(t + 1) * kstep;
            const char* a2 = last ? nA : cA + (size_t)(t + 2) * kstep; const char* b2 = last ? nB : cB + (size_t)(t + 2) * kstep;
            const char* a3 = a2 + kstep; const char* b3 = b2 + kstep;
            if (last && has_next) S.a_ready(nxt);
            if constexpr (SP2) {
            PG8_LDB(B0, 0, 0); PG8_LDB(B1, 0, 1); PG8_SCHED; PG8_LDA(At, 0, 0); PG8_STAGE(PG8_SA(1, 1), a1 + hstep, voffA);
            PG8_WAIT_V(8); PG8_WAIT_L(0); PG8_BAR; PG8_MMA(0, 0, At, B0); PG8_MMA(0, 1, At, B1); PG8_BAR; PG8_SCHED;
            PG8_LDA(At, 0, 1); PG8_STAGE(PG8_SB(0, 0), b2, voffB); PG8_STAGE(PG8_SB(0, 1), b2 + hstep, voffB); PG8_STAGE(PG8_SA(0, 0), a2, voffA);
            PG8_WAIT_V(8); PG8_WAIT_L(0); PG8_BAR; PG8_MMA(1, 0, At, B0); PG8_MMA(1, 1, At, B1); PG8_BAR; PG8_SCHED;
            PG8_LDB(B0, 1, 0); PG8_LDB(B1, 1, 1); PG8_SCHED; PG8_LDA(At, 1, 0); PG8_STAGE(PG8_SA(0, 1), a2 + hstep, voffA);
            PG8_WAIT_V(8); PG8_WAIT_L(0); PG8_BAR; PG8_MMA(0, 0, At, B0); PG8_MMA(0, 1, At, B1); PG8_BAR; PG8_SCHED;
            PG8_LDA(At, 1, 1); PG8_STAGE(PG8_SB(1, 0), b3, voffB); PG8_STAGE(PG8_SB(1, 1), b3 + hstep, voffB); PG8_STAGE(PG8_SA(1, 0), a3, voffA);
            PG8_WAIT_V(8); PG8_WAIT_L(0); PG8_BAR; PG8_MMA(1, 0, At, B0); PG8_MMA(1, 1, At, B1); PG8_BAR; PG8_SCHED;
            } else {
            PG8_LDB(B0, 0, 0); PG8_SCHED; PG8_LDA(At, 0, 0); PG8_STAGE(PG8_SA(1, 1), a1 + hstep, voffA);
            PG8_WAIT_L(8); PG8_BAR; PG8_WAIT_L(0); PG8_MMA(0, 0, At, B0); PG8_BAR; PG8_SCHED;
            PG8_LDB(B1, 0, 1); PG8_STAGE(PG8_SB(0, 0), b2, voffB);
            PG8_BAR; PG8_WAIT_L(0); PG8_MMA(0, 1, At, B1); PG8_BAR;
            PG8_LDA(At, 0, 1); PG8_STAGE(PG8_SA(0, 0), a2, voffA);
            PG8_BAR; PG8_WAIT_L(0); PG8_MMA(1, 0, At, B0); PG8_BAR; PG8_SCHED;
            PG8_STAGE(PG8_SB(0, 1), b2 + hstep, voffB);
            PG8_WAIT_V(6); PG8_BAR; PG8_MMA(1, 1, At, B1); PG8_BAR;
            PG8_LDB(B0, 1, 0); PG8_SCHED; PG8_LDA(At, 1, 0); PG8_STAGE(PG8_SA(0, 1), a2 + hstep, voffA);
            PG8_WAIT_L(8); PG8_BAR; PG8_WAIT_L(0); PG8_MMA(0, 0, At, B0); PG8_BAR; PG8_SCHED;
            PG8_LDB(B1, 1, 1); PG8_STAGE(PG8_SB(1, 0), b3, voffB);
            PG8_BAR; PG8_WAIT_L(0); PG8_MMA(0, 1, At, B1); PG8_BAR;
            PG8_LDA(At, 1, 1); PG8_STAGE(PG8_SA(1, 0), a3, voffA);
            PG8_BAR; PG8_WAIT_L(0); PG8_MMA(1, 0, At, B0); PG8_BAR; PG8_SCHED;
            PG8_STAGE(PG8_SB(1, 1), b3 + hstep, voffB);
            PG8_WAIT_V(6); PG8_BAR; PG8_MMA(1, 1, At, B1); PG8_BAR;
            }
        }
        if constexpr (ALIGN_EPI) { if (wr == 0) PG8_BAR; }
        if constexpr (!Epi::AFTER_DRAIN) { E(acc, cur, wr, wc, fr, fq); S.done(cur); }
        if (!has_next) break;
#pragma unroll
        for (int a = 0; a < 2; ++a)
#pragma unroll
            for (int b = 0; b < 2; ++b)
#pragma unroll
                for (int m = 0; m < 4; ++m)
#pragma unroll
                    for (int n = 0; n < 2; ++n) acc[a][b][m][n] = (f32x4){0.f, 0.f, 0.f, 0.f};
        cur = nxt; cA = nA; cB = nB; ++ui;
        if constexpr (ALIGN_EPI) { if (wr == 1) PG8_BAR; }
    }
    PG8_WAIT_V(0);
    if constexpr (!ALIGN_EPI) { if (wr == 0) PG8_BAR; }
    PG8_BAR;
    if constexpr (Epi::AFTER_DRAIN) { E.fused(acc, cur, wr, wc, fr, fq, lds, wid, lane); S.done(cur); }
#undef PG8_SA
#undef PG8_SB
#undef PG8_STAGE
#undef PG8_LDA
#undef PG8_LDB
#undef PG8_MMA
#undef PG8_WAIT_V
#undef PG8_WAIT_L
#undef PG8_BAR
#undef PG8_SCHED
}
}

constexpr int NB = 32, T_ = 2048, DM = 1024, NTOK = NB * T_;
constexpr int NLAYER = 2;
constexpr int CIN = 10032, CPAD = 10240;
constexpr int FFH_ = 2816;
constexpr int NBC = 8, MC = NBC * T_, NCHUNK = NB / NBC;
constexpr int PC_QR = 0, PC_KR = 1024, PC_VR = 2048, PC_GR = 4096, PC_QN = 6144, PC_KV = 7168, PC_MA = 7936, PC_MB = 8960, PC_GATE = 9984;
constexpr int NCMP = 127, NCMP_PAD = 128;
constexpr float LOG2E = 1.4426950408889634f;
constexpr float QSCALE = 0.125f * LOG2E;

constexpr size_t MiB = 1u << 20;
constexpr size_t WS_CTL = 0, CTL_ZERO_BYTES = 1 * MiB;
constexpr size_t WS_ROT = 1 * MiB;
constexpr size_t WS_T5 = 3 * MiB;
constexpr size_t WS_CB = 3 * MiB + 64 * 1024;
constexpr size_t WS_WIN = 4 * MiB;
constexpr size_t WS_WORET = 44 * MiB;
constexpr size_t WS_WONSA = 52 * MiB;
constexpr size_t WS_WOUT = 56 * MiB;
constexpr size_t WS_WFFI = 60 * MiB;
constexpr size_t WS_WFFO = 82 * MiB;
constexpr size_t WS_WC1 = 93 * MiB;
constexpr size_t WS_WC2 = 97 * MiB;
constexpr size_t WS_H = 100 * MiB;
constexpr size_t WS_BIG = 228 * MiB;
constexpr size_t WS_ORET = 580 * MiB;
constexpr size_t WS_ON = 644 * MiB;
constexpr size_t WS_TMP = 676 * MiB;
constexpr size_t WS_MERGED = 708 * MiB;
constexpr size_t WS_KC = 740 * MiB;
constexpr size_t WS_GNS = 741 * MiB;
constexpr size_t WS_ONF = 746 * MiB;
constexpr size_t WS_END = 810 * MiB;
constexpr int CW_TMO = 0, CW_BAR = 4096, CW_Q = 16384;

constexpr int NWAVES = 8;
constexpr int RING_BYTES = 131072, LDSCTL_OFF = RING_BYTES, MISC_OFF = LDSCTL_OFF + 320, LDS_BYTES = 147456;

typedef pg8::bf16_t bf16;
typedef float f32x4 __attribute__((ext_vector_type(4)));
typedef float f32x2 __attribute__((ext_vector_type(2)));
typedef unsigned u32x4 __attribute__((ext_vector_type(4)));
typedef unsigned u32x2 __attribute__((ext_vector_type(2)));
#define LAS __attribute__((address_space(3)))
#define GAS __attribute__((address_space(1)))
#define RLX_AGENT __ATOMIC_RELAXED, __HIP_MEMORY_SCOPE_AGENT
#define LDS_WAIT() asm volatile("s_waitcnt lgkmcnt(0)" ::: "memory")
#define VM_WAIT() asm volatile("s_waitcnt vmcnt(0)" ::: "memory")
typedef GAS unsigned gu32;

__device__ __forceinline__ unsigned f2bf(float f) { unsigned u = __builtin_bit_cast(unsigned, f); return (u + 0x7fffu + ((u >> 16) & 1u)) >> 16; }
__device__ __forceinline__ unsigned pk2(float lo, float hi) { return f2bf(lo) | (f2bf(hi) << 16); }
__device__ __forceinline__ float bf2f(unsigned short h) { return __builtin_bit_cast(float, (unsigned)h << 16); }
__device__ __forceinline__ float bflo(unsigned w) { return __builtin_bit_cast(float, w << 16); }
__device__ __forceinline__ float bfhi(unsigned w) { return __builtin_bit_cast(float, w & 0xffff0000u); }
__device__ __forceinline__ float sigm(float x) { return 1.f / (1.f + __expf(-x)); }
__device__ __forceinline__ float silu(float x) { return x / (1.f + __expf(-x)); }
__device__ __forceinline__ float shx(float v, int m, int lane) { return __builtin_bit_cast(float, __builtin_amdgcn_ds_bpermute((lane ^ m) << 2, __builtin_bit_cast(int, v))); }
__device__ __forceinline__ float wave_sum(float v, int lane) {
#pragma unroll
    for (int o = 1; o < 64; o <<= 1) v += shx(v, o, lane);
    return v;
}
__device__ __forceinline__ float wave_max(float v, int lane) {
#pragma unroll
    for (int o = 1; o < 64; o <<= 1) v = fmaxf(v, shx(v, o, lane));
    return v;
}

namespace epi {
using pg8::Unit;
__device__ __forceinline__ u32x4 pack8(const f32x4 a, const f32x4 b) { u32x4 w; w.x = pk2(a[0], a[1]); w.y = pk2(a[2], a[3]); w.z = pk2(b[0], b[1]); w.w = pk2(b[2], b[3]); return w; }
__device__ __forceinline__ void unpack8(const u32x4 w, f32x4& a, f32x4& b) { a = (f32x4){bflo(w.x), bfhi(w.x), bflo(w.y), bfhi(w.y)}; b = (f32x4){bflo(w.z), bfhi(w.z), bflo(w.w), bfhi(w.w)}; }

struct EpiInProj {
    static constexpr bool PERM = true, AFTER_DRAIN = false;
    bf16* O; const float* rot;
    __device__ __forceinline__ void operator()(const f32x4 (&acc)[2][2][4][2], const Unit& u, int wr, int wc, int fr, int fq) const {
        const int pn = u.pn, row0 = u.pm * 256 + wr * 64 + fr, colw = wc * 32 + 8 * fq;
        bf16* base = O + (size_t)row0 * CPAD + pn * 256 + colw;
        if (pn < 8) {
            const float sc = pn >= 4 ? 0.0625f : 1.f;
#pragma unroll
            for (int ai = 0; ai < 2; ++ai)
#pragma unroll
                for (int m = 0; m < 4; ++m) {
                    const int row = row0 + ai * 128 + m * 16, pos = row & (T_ - 1);
                    const float* cp = rot + (size_t)pos * 128 + colw; const float* sp = cp + T_ * 128;
                    f32x4 y1[2], y2[2];
#pragma unroll
                    for (int n = 0; n < 2; ++n) { const f32x4 c = *(const f32x4*)(cp + 4 * n), s = *(const f32x4*)(sp + 4 * n); const f32x4 x1 = acc[ai][0][m][n], x2 = acc[ai][1][m][n];
                        y1[n] = (x1 * c - x2 * s) * sc; y2[n] = (x1 * s + x2 * c) * sc; }
                    bf16* rp = base + (size_t)(ai * 128 + m * 16) * CPAD;
                    *(u32x4*)(rp) = pack8(y1[0], y1[1]); *(u32x4*)(rp + 128) = pack8(y2[0], y2[1]);
                }
        } else {
            const int mode = (pn >= 16 && pn < 24) ? 1 : (pn >= 24 && pn < 28) ? 2 : (pn >= 31) ? 3 : 0;
#pragma unroll
            for (int ai = 0; ai < 2; ++ai)
#pragma unroll
                for (int m = 0; m < 4; ++m) { bf16* rp = base + (size_t)(ai * 128 + m * 16) * CPAD;
#pragma unroll
                    for (int bj = 0; bj < 2; ++bj) { f32x4 v0 = acc[ai][bj][m][0], v1 = acc[ai][bj][m][1];
                        if (mode == 1) {
#pragma unroll
                            for (int i = 0; i < 4; ++i) { v0[i] = silu(v0[i]); v1[i] = silu(v1[i]); } }
                        else if (mode == 2) { v0 = v0 * QSCALE; v1 = v1 * QSCALE; }
                        else if (mode == 3) {
#pragma unroll
                            for (int i = 0; i < 4; ++i) { v0[i] = sigm(v0[i]); v1[i] = sigm(v1[i]); } }
                        *(u32x4*)(rp + bj * 128) = pack8(v0, v1); } }
        }
    }
};
template <bool ADD> struct EpiGate {
    static constexpr bool PERM = true, AFTER_DRAIN = false;
    bf16* O; const bf16* P; const bf16* G; int ldo, ldg;
    __device__ __forceinline__ void operator()(const f32x4 (&acc)[2][2][4][2], const Unit& u, int wr, int wc, int fr, int fq) const {
        const int row0 = u.pm * 256 + wr * 64 + fr, col0 = u.pn * 256 + wc * 32 + 8 * fq;
#pragma unroll
        for (int ai = 0; ai < 2; ++ai)
#pragma unroll
            for (int m = 0; m < 4; ++m) { const size_t r = (size_t)(row0 + ai * 128 + m * 16);
#pragma unroll
                for (int bj = 0; bj < 2; ++bj) { const int c = col0 + bj * 128;
                    f32x4 g0, g1; unpack8(*(const u32x4*)(G + r * ldg + c), g0, g1);
                    f32x4 v0 = acc[ai][bj][m][0] * g0, v1 = acc[ai][bj][m][1] * g1;
                    if (ADD) { f32x4 p0, p1; unpack8(*(const u32x4*)(P + r * ldo + c), p0, p1); v0 += p0; v1 += p1; }
                    *(u32x4*)(O + r * ldo + c) = pack8(v0, v1); } }
    }
};
struct EpiResid {
    static constexpr bool PERM = false, AFTER_DRAIN = false;
    const float* src; float* out;
    __device__ __forceinline__ void operator()(const f32x4 (&acc)[2][2][4][2], const Unit& u, int wr, int wc, int fr, int fq) const {
        const int row0 = u.pm * 256 + wr * 64 + fr, col0 = u.pn * 256 + wc * 32 + 4 * fq;
#pragma unroll
        for (int ai = 0; ai < 2; ++ai)
#pragma unroll
            for (int m = 0; m < 4; ++m) { const size_t off = (size_t)(row0 + ai * 128 + m * 16) * DM + col0;
#pragma unroll
                for (int bj = 0; bj < 2; ++bj)
#pragma unroll
                    for (int n = 0; n < 2; ++n) { const f32x4 s = *(const f32x4*)(src + off + bj * 128 + n * 16); *(f32x4*)(out + off + bj * 128 + n * 16) = s + acc[ai][bj][m][n]; } }
    }
};
struct EpiSwiGlu {
    static constexpr bool PERM = true, AFTER_DRAIN = false;
    bf16* O;
    __device__ __forceinline__ void operator()(const f32x4 (&acc)[2][2][4][2], const Unit& u, int wr, int wc, int fr, int fq) const {
        const int row0 = u.pm * 256 + wr * 64 + fr, col0 = u.pn * 128 + wc * 32 + 8 * fq;
#pragma unroll
        for (int ai = 0; ai < 2; ++ai)
#pragma unroll
            for (int m = 0; m < 4; ++m) { f32x4 v[2];
#pragma unroll
                for (int n = 0; n < 2; ++n) { const f32x4 a = acc[ai][0][m][n], b = acc[ai][1][m][n];
#pragma unroll
                    for (int i = 0; i < 4; ++i) v[n][i] = silu(a[i]) * b[i]; }
                *(u32x4*)(O + (size_t)(row0 + ai * 128 + m * 16) * FFH_ + col0) = pack8(v[0], v[1]); }
    }
};
}
#define XB_TMO      128
#define XB_XCNT(j)  (256  + 64 * (j))
#define XB_XSUB(j)  (1280 + 64 * (j))
#define XB_XGEN(j)  (2304 + 64 * (j))
#define XB_TOP      3328
#define XB_TOPGEN   3392
#define XCD_BAR_WORDS 3456
#define XB_SPIN_CAP (1u << 18)

__device__ __forceinline__ unsigned xb_ld(unsigned* p)              { return __hip_atomic_load(p, __ATOMIC_RELAXED, __HIP_MEMORY_SCOPE_AGENT); }
__device__ __forceinline__ unsigned xb_add(unsigned* p, unsigned v) { return __hip_atomic_fetch_add(p, v, __ATOMIC_RELAXED, __HIP_MEMORY_SCOPE_AGENT); }
__device__ __forceinline__ unsigned xb_xcc_id() { return (unsigned)__builtin_amdgcn_s_getreg((3 << 11) | 20) & 0xFu; }
#define XB_SPIN(cond, bar) do { unsigned _sp = 0; while (cond) { __builtin_amdgcn_s_sleep(1); \
    if ((++_sp & 255u) == 0u) { if (xb_ld(&(bar)[XB_TMO])) break; if (_sp > XB_SPIN_CAP) { atomicAdd(&(bar)[XB_TMO], 1u); break; } } } } while (0)

struct XcdBarrier {
    unsigned* bar; unsigned x;
    volatile LAS unsigned* st;
};

__device__ __forceinline__ XcdBarrier xcd_barrier_post(unsigned* bar, volatile LAS unsigned* st) {
    XcdBarrier b; b.bar = bar; b.x = xb_xcc_id(); b.st = st;
    if (threadIdx.x == 0) (void)xb_add(&bar[XB_XCNT(b.x)], 1u);
    return b;
}
__device__ __forceinline__ void xcd_barrier_complete(unsigned* bar, unsigned x, unsigned& nloc, unsigned& nx) {
    const unsigned G = gridDim.x * gridDim.y * gridDim.z;
    unsigned sum, cnt, mine, sp = 0u;
    for (;;) {
        sum = 0u; cnt = 0u; mine = 0u;
#pragma unroll
        for (unsigned j = 0; j < 16; ++j) { const unsigned c = xb_ld(&bar[XB_XCNT(j)]); sum += c; cnt += (c > 0u) ? 1u : 0u; mine = (j == x) ? c : mine; }
        if (sum == G) break;
        __builtin_amdgcn_s_sleep(1);
        if ((++sp & 255u) == 0u) { if (xb_ld(&bar[XB_TMO])) break; if (sp > XB_SPIN_CAP) { atomicAdd(&bar[XB_TMO], 1u); break; } }
    }
    nloc = mine > 0u ? mine : 1u; nx = cnt > 0u ? cnt : 1u;
}

__device__ __forceinline__ void xcd_barrier(const XcdBarrier& b) {
    asm volatile("s_waitcnt vmcnt(0)" ::: "memory");
    __syncthreads();
    if (threadIdx.x == 0) {
        unsigned* bar = b.bar;
        __builtin_amdgcn_s_waitcnt(0);
        unsigned nloc = b.st[0], nx = b.st[1];
        if (nloc == 0u) { xcd_barrier_complete(bar, b.x, nloc, nx); b.st[0] = nloc; b.st[1] = nx; }
        const unsigned old = xb_add(&bar[XB_XSUB(b.x)], 1u);
        const unsigned gen = old / nloc;
        if (old + 1u == (gen + 1u) * nloc) {
            __builtin_amdgcn_fence(__ATOMIC_RELEASE, "agent");
            asm volatile("s_waitcnt vmcnt(0)" ::: "memory");
            const unsigned og = xb_add(&bar[XB_TOP], 1u);
            const unsigned tg = og / nx;
            if (og + 1u == (tg + 1u) * nx) xb_add(&bar[XB_TOPGEN], 1u);
            else XB_SPIN(xb_ld(&bar[XB_TOPGEN]) == tg, bar);
            __builtin_amdgcn_fence(__ATOMIC_ACQUIRE, "agent");
            xb_add(&bar[XB_XGEN(b.x)], 1u);
            asm volatile("s_waitcnt vmcnt(0)" ::: "memory");
        } else {
            XB_SPIN(xb_ld(&bar[XB_XGEN(b.x)]) == gen, bar);
            __builtin_amdgcn_fence(__ATOMIC_ACQUIRE, "agent");
            asm volatile("s_waitcnt vmcnt(0)" ::: "memory");
        }
    }
    __syncthreads();
}

struct Args { const float* in[17]; float* out; unsigned char* ws; int it_lo, it_hi, ph_lo, ph_hi, flags, pad; };

struct Ctx { LAS unsigned char* lds; int tid, lane, wave, G, bid; };

template <class Map>
__device__ __forceinline__ void p0_transpose_item(const float* W, int K, int Nsrc, bf16* WT, int ngrp, LAS float* scr, int item, int lane, const Map& map) {
    const int kb = item / ngrp, nb = item % ngrp, k0 = 64 * kb, n0 = 32 * nb;
    const int sc = map(n0 + (lane & 31));
#pragma unroll 8
    for (int i = 0; i < 32; ++i) { const int kk = 2 * i + (lane >> 5); scr[kk * 33 + (lane & 31)] = sc >= 0 ? W[(size_t)(k0 + kk) * Nsrc + sc] : 0.f; }
    LDS_WAIT(); asm volatile("" ::: "memory");
    const int c = lane & 7;
#pragma unroll
    for (int j = 0; j < 4; ++j) { const int n = (lane >> 3) + 8 * j; const LAS float* s = scr + (8 * c) * 33 + n;
        u32x4 o; o.x = pk2(s[0 * 33], s[1 * 33]); o.y = pk2(s[2 * 33], s[3 * 33]); o.z = pk2(s[4 * 33], s[5 * 33]); o.w = pk2(s[6 * 33], s[7 * 33]);
        *(u32x4*)(WT + (size_t)(n0 + n) * K + k0 + 8 * c) = o; }
    LDS_WAIT(); asm volatile("" ::: "memory");
}
struct MapId { __device__ __forceinline__ int operator()(int n) const { return n; } };
struct MapWin { __device__ __forceinline__ int operator()(int n) const { return n < 7936 ? n : (n < 9984 ? n + 48 : (n < 10032 ? n - 2048 : -1)); } };
struct MapFfi { __device__ __forceinline__ int operator()(int n) const { const int pn = n >> 8, j = n & 255; return j < 128 ? 128 * pn + j : FFH_ + 128 * pn + (j - 128); } };

__device__ __forceinline__ void p0_prologue(const Ctx& C, const Args& a) {
    unsigned char* ws = a.ws;
    LAS float* scr = (LAS float*)(C.lds + C.wave * 16384);
    const int gw = C.bid * NWAVES + C.wave, NGW = C.G * NWAVES;
    constexpr int I_IN = 16 * 320, I_OR = 32 * 32, I_ON = 16 * 32, I_OUT = 16 * 32, I_FI = 16 * 176, I_FO = 44 * 32, I_C1 = 32 * 8, I_L = I_IN + I_OR + I_ON + I_OUT + I_FI + I_FO + 2 * I_C1;
    for (int it = gw; it < NLAYER * I_L; it += NGW) {
        const int L = it / I_L; int r = it % I_L;
        if (r < I_IN) { p0_transpose_item(a.in[2] + (size_t)L * DM * CIN, DM, CIN, (bf16*)(ws + WS_WIN) + (size_t)L * CPAD * DM, 320, scr, r, C.lane, MapWin()); continue; } r -= I_IN;
        if (r < I_OR) { p0_transpose_item(a.in[9] + (size_t)L * 2048 * DM, 2048, DM, (bf16*)(ws + WS_WORET) + (size_t)L * DM * 2048, 32, scr, r, C.lane, MapId()); continue; } r -= I_OR;
        if (r < I_ON) { p0_transpose_item(a.in[10] + (size_t)L * DM * DM, DM, DM, (bf16*)(ws + WS_WONSA) + (size_t)L * DM * DM, 32, scr, r, C.lane, MapId()); continue; } r -= I_ON;
        if (r < I_OUT) { p0_transpose_item(a.in[11] + (size_t)L * DM * DM, DM, DM, (bf16*)(ws + WS_WOUT) + (size_t)L * DM * DM, 32, scr, r, C.lane, MapId()); continue; } r -= I_OUT;
        if (r < I_FI) { p0_transpose_item(a.in[13] + (size_t)L * DM * 2 * FFH_, DM, 2 * FFH_, (bf16*)(ws + WS_WFFI) + (size_t)L * 2 * FFH_ * DM, 176, scr, r, C.lane, MapFfi()); continue; } r -= I_FI;
        if (r < I_FO) { p0_transpose_item(a.in[14] + (size_t)L * FFH_ * DM, FFH_, DM, (bf16*)(ws + WS_WFFO) + (size_t)L * DM * FFH_, 32, scr, r, C.lane, MapId()); continue; } r -= I_FO;
        if (r < I_C1) { p0_transpose_item(a.in[5] + (size_t)L * 2048 * 256, 2048, 256, (bf16*)(ws + WS_WC1) + (size_t)(L * 2 + 0) * 256 * 2048, 8, scr, r, C.lane, MapId()); continue; } r -= I_C1;
        p0_transpose_item(a.in[7] + (size_t)L * 2048 * 256, 2048, 256, (bf16*)(ws + WS_WC1) + (size_t)(L * 2 + 1) * 256 * 2048, 8, scr, r, C.lane, MapId());
    }
    const int gt = C.bid * 512 + C.tid, NGT = C.G * 512;
    float* rot = (float*)(ws + WS_ROT);
    for (int i = gt; i < T_ * 128; i += NGT) { const int pos = i >> 7, d = i & 127; const double f = pow(10000.0, -(double)d / 128.0), ang = (double)pos * f; rot[i] = (float)cos(ang); rot[T_ * 128 + i] = (float)sin(ang); }
    float* t5 = (float*)(ws + WS_T5);
    for (int i = gt; i < 16 * 128; i += NGT) { const int hd = i >> 7, dist = i & 127; int bk = dist;
        if (dist >= 16) { bk = 16 + (int)(log((double)dist / 16.0) / log(8.0) * 16.0); if (bk > 31) bk = 31; }
        t5[i] = a.in[15][bk * 16 + hd] * LOG2E; }
}

__device__ __forceinline__ void rms_row_to_bf16(const float* xrow, const float* g, bf16* orow, int lane) {
    const f32x4* xr = (const f32x4*)xrow + lane; const f32x4* gr = (const f32x4*)g + lane;
    f32x4 v[4]; float s = 0.f;
#pragma unroll
    for (int j = 0; j < 4; ++j) { v[j] = xr[64 * j]; s += (v[j].x * v[j].x + v[j].y * v[j].y) + (v[j].z * v[j].z + v[j].w * v[j].w); }
    const float r = 1.f / sqrtf(wave_sum(s, lane) * (1.f / DM) + 1e-6f);
    u32x2* o8 = (u32x2*)orow + lane;
#pragma unroll
    for (int j = 0; j < 4; ++j) { const f32x4 gg = gr[64 * j]; u32x2 w; w.x = pk2(v[j].x * r * gg.x, v[j].y * r * gg.y); w.y = pk2(v[j].z * r * gg.z, v[j].w * r * gg.w); o8[64 * j] = w; }
}
__device__ __forceinline__ void rms_row_f32(float* xrow, const float* g, int lane) {
    f32x4* xr = (f32x4*)xrow + lane; const f32x4* gr = (const f32x4*)g + lane;
    f32x4 v[4]; float s = 0.f;
#pragma unroll
    for (int j = 0; j < 4; ++j) { v[j] = xr[64 * j]; s += (v[j].x * v[j].x + v[j].y * v[j].y) + (v[j].z * v[j].z + v[j].w * v[j].w); }
    const float r = 1.f / sqrtf(wave_sum(s, lane) * (1.f / DM) + 1e-6f);
#pragma unroll
    for (int j = 0; j < 4; ++j) xr[64 * j] = v[j] * r * gr[64 * j];
}

__device__ __forceinline__ float dot8(const u32x4 w, const LAS float* q) {
    return bflo(w.x) * q[0] + bfhi(w.x) * q[1] + bflo(w.y) * q[2] + bfhi(w.y) * q[3] + bflo(w.z) * q[4] + bfhi(w.z) * q[5] + bflo(w.w) * q[6] + bfhi(w.w) * q[7];
}
__device__ __forceinline__ float gelu_tanh(float x) { const float u = 0.7978845608028654f * (x + 0.044715f * x * x * x); return 0.5f * x * (1.f + tanhf(u)); }

__device__ __forceinline__ void compress_naive_unit(const Ctx& C, int u, const bf16* PROJ, const float* pos, const float* w1, const float* w2, bf16* KCV) {
    const int n = u % NCMP, g = (u / NCMP) & 1, b = (u / (2 * NCMP)) % NBC, kv = u / (2 * NCMP * NBC);
    LAS float* xin = (LAS float*)C.lds; LAS float* part = xin + 2048; LAS float* hid = part + 512;
    const float* pe = pos;
    for (int i = C.tid; i < 2048; i += 512) { const int l = i >> 6, d = i & 63;
        xin[i] = bf2f(PROJ[(size_t)(b * T_ + n * 16 + l) * CPAD + PC_KV + kv * 128 + g * 64 + d]) + pe[i]; }
    __syncthreads();
    { const int j = C.tid & 255, half = C.tid >> 8; float s = 0.f; const float* wp = w1 + (size_t)(half * 1024) * 256 + j; const LAS float* xp = xin + half * 1024;
      for (int i = 0; i < 1024; ++i) s += xp[i] * wp[(size_t)i * 256];
      part[half * 256 + j] = s; }
    __syncthreads();
    if (C.tid < 256) hid[C.tid] = gelu_tanh(part[C.tid] + part[256 + C.tid]);
    __syncthreads();
    if (C.tid < 64) { float s = 0.f; for (int j = 0; j < 256; ++j) s += hid[j] * w2[j * 64 + C.tid];
        bf16* o = KCV + ((size_t)((kv * NBC + b) * 2 + g) * NCMP_PAD) * 64;
        o[n * 64 + C.tid] = (bf16)f2bf(s); if (n == 0) o[127 * 64 + C.tid] = 0; }
    __syncthreads();
}

__device__ __forceinline__ void ret_naive_unit(const Ctx& C, int u, const bf16* PROJ, bf16* ORET) {
    const int tq = u & 255, h = (u >> 8) & 3, b = u >> 10, t = tq * 8 + C.wave, lane = C.lane;
    const size_t tok0 = (size_t)b * T_;
    LAS float* qs = (LAS float*)C.lds + C.wave * 256; LAS float* sc = (LAS float*)(C.lds + 8192) + C.wave * 2048;
    const bf16* qrow = PROJ + (tok0 + t) * CPAD + PC_QR + h * 256;
    for (int d = lane; d < 256; d += 64) qs[d] = bf2f(qrow[d]);
    __syncthreads();
    const float l2g = log2f(1.f - exp2f(-5.f - (float)h));
    for (int m0 = 0; m0 <= t; m0 += 64) { const int m = m0 + lane;
        if (m <= t) { const bf16* krow = PROJ + (tok0 + m) * CPAD + PC_KR + h * 256; float s = 0.f;
            for (int c = 0; c < 32; ++c) s += dot8(*(const u32x4*)(krow + 8 * c), qs + 8 * c);
            sc[m] = s * exp2f((float)(t - m) * l2g); } }
    __syncthreads();
    float acc[8];
#pragma unroll
    for (int i = 0; i < 8; ++i) acc[i] = 0.f;
    const bf16* vb = PROJ + tok0 * CPAD + PC_VR + h * 512 + lane * 8;
    for (int m = 0; m <= t; ++m) { const float p = sc[m]; const u32x4 w = *(const u32x4*)(vb + (size_t)m * CPAD);
        acc[0] += p * bflo(w.x); acc[1] += p * bfhi(w.x); acc[2] += p * bflo(w.y); acc[3] += p * bfhi(w.y); acc[4] += p * bflo(w.z); acc[5] += p * bfhi(w.z); acc[6] += p * bflo(w.w); acc[7] += p * bfhi(w.w); }
    float s = 0.f;
#pragma unroll
    for (int i = 0; i < 8; ++i) s += acc[i];
    const float mean = wave_sum(s, lane) * (1.f / 512.f); float q = 0.f;
#pragma unroll
    for (int i = 0; i < 8; ++i) { acc[i] -= mean; q += acc[i] * acc[i]; }
    const float rstd = 1.f / sqrtf(wave_sum(q, lane) * (1.f / 512.f) + 1e-5f);
    const u32x4 gw = *(const u32x4*)(PROJ + (tok0 + t) * CPAD + PC_GR + h * 512 + lane * 8);
    u32x4 o; o.x = pk2(acc[0] * rstd * bflo(gw.x), acc[1] * rstd * bfhi(gw.x)); o.y = pk2(acc[2] * rstd * bflo(gw.y), acc[3] * rstd * bfhi(gw.y));
    o.z = pk2(acc[4] * rstd * bflo(gw.z), acc[5] * rstd * bfhi(gw.z)); o.w = pk2(acc[6] * rstd * bflo(gw.w), acc[7] * rstd * bfhi(gw.w));
    *(u32x4*)(ORET + (tok0 + t) * 2048 + h * 512 + lane * 8) = o;
    __syncthreads();
}


typedef short s16x4 __attribute__((ext_vector_type(4)));
typedef short bf16x8 __attribute__((ext_vector_type(8)));
#define MFMA16(a, b, c) __builtin_amdgcn_mfma_f32_16x16x32_bf16((a), (b), (c), 0, 0, 0)
constexpr int RK_PITCH = 528, RV_PITCH = 144, RR_PITCH = 528;
constexpr int RL_K = 0, RL_V = 128 * RK_PITCH, RL_R = RL_V + 128 * RV_PITCH, RL_END = RL_R + 64 * RR_PITCH;
static_assert(RL_END <= RING_BYTES, "retention LDS map");
__device__ __forceinline__ bf16x8 tr_frag(LAS unsigned char* tile, int pitch, int rowA, int rowB, int col0, int lane) {
    const int q = (lane & 15) >> 2, p = lane & 3;
    const s16x4 a = __builtin_amdgcn_ds_read_tr16_b64_v4i16((LAS s16x4*)(tile + (rowA + q) * pitch + (col0 + 4 * p) * 2));
    const s16x4 b = __builtin_amdgcn_ds_read_tr16_b64_v4i16((LAS s16x4*)(tile + (rowB + q) * pitch + (col0 + 4 * p) * 2));
    return __builtin_shufflevector(a, b, 0, 1, 2, 3, 4, 5, 6, 7);
}
__device__ __forceinline__ bf16x8 tr_frag2(LAS unsigned char* lb, int offA, int offB) {
    const s16x4 a = __builtin_amdgcn_ds_read_tr16_b64_v4i16((LAS s16x4*)(lb + offA));
    const s16x4 b = __builtin_amdgcn_ds_read_tr16_b64_v4i16((LAS s16x4*)(lb + offB));
    return __builtin_shufflevector(a, b, 0, 1, 2, 3, 4, 5, 6, 7);
}
__device__ __forceinline__ bf16x8 pack_bf8(const f32x4 a, const f32x4 b) { u32x4 w; w.x = pk2(a[0], a[1]); w.y = pk2(a[2], a[3]); w.z = pk2(b[0], b[1]); w.w = pk2(b[2], b[3]); return __builtin_bit_cast(bf16x8, w); }

__device__ __forceinline__ void ret_unit(const Ctx& C, int u, const bf16* PROJ, bf16* ORET, float* GNP) {
    const int es = u & 7, h = (u >> 3) & 3, b = u >> 5;
    const int lane = C.lane, w = C.wave, i16 = lane & 15, g = lane >> 4, tid = C.tid;
    LAS unsigned char* lds = C.lds;
    const size_t tok0 = (size_t)b * T_;
    const float l2g = log2f(1.f - exp2f(-5.f - (float)h));
    const float xi = exp2f(l2g * (float)(w * 16 + i16 + 1));
    const float gchunk = exp2f(l2g * 128.f);
    float dbase[4];
#pragma unroll
    for (int r = 0; r < 4; ++r) dbase[r] = exp2f(l2g * (float)(i16 - 4 * g - r));
    f32x4 racc[2][4];
#pragma unroll
    for (int dt = 0; dt < 2; ++dt)
#pragma unroll
        for (int et = 0; et < 4; ++et) racc[dt][et] = (f32x4){0.f, 0.f, 0.f, 0.f};
    u32x4 stK[8], stV[2]; bf16x8 qfrag[8];
    const unsigned kvo = (unsigned)(tid >> 5) * (CPAD * 2) + (unsigned)(tid & 31) * 16u, vvo = (unsigned)(tid >> 3) * (CPAD * 2) + (unsigned)(tid & 7) * 16u;
    const unsigned qvo = (unsigned)(w * 16 + i16) * (CPAD * 2) + (unsigned)g * 16u;
    const int klo = RL_K + (tid >> 5) * RK_PITCH + (tid & 31) * 16, vlo = RL_V + (tid >> 3) * RV_PITCH + (tid & 7) * 16;
    const char* kch = (const char*)(PROJ + tok0 * CPAD + PC_KR + h * 256);
    const char* vch = (const char*)(PROJ + tok0 * CPAD + PC_VR + h * 512 + es * 64);
    const char* qch = (const char*)(PROJ + tok0 * CPAD + PC_QR + h * 256);
#pragma unroll
    for (int i = 0; i < 8; ++i) stK[i] = *(const u32x4*)(kch + (size_t)i * 16 * CPAD * 2 + kvo);
#pragma unroll
    for (int i = 0; i < 2; ++i) stV[i] = *(const u32x4*)(vch + (size_t)i * 64 * CPAD * 2 + vvo);
#pragma unroll
    for (int kb = 0; kb < 8; ++kb) qfrag[kb] = *(const bf16x8*)(qch + kb * 64 + qvo);
#pragma unroll
    for (int i = 0; i < 8; ++i) *(LAS u32x4*)(lds + klo + i * 16 * RK_PITCH) = stK[i];
#pragma unroll
    for (int i = 0; i < 2; ++i) *(LAS u32x4*)(lds + vlo + i * 64 * RV_PITCH) = stV[i];
    __syncthreads();
    for (int c = 0; c < 16; ++c) {
        const bool more = c + 1 < 16;
        int lane_c = lane; float l2c = l2g; asm volatile("" : "+v"(lane_c), "+v"(l2c));
        const int i16 = lane_c & 15, g = lane_c >> 4;
        const char* kn = kch + (size_t)(c + 1) * 128 * CPAD * 2; const char* vn = vch + (size_t)(c + 1) * 128 * CPAD * 2; const char* qn = qch + (size_t)(c + 1) * 128 * CPAD * 2;
        f32x4 oacc[4];
#pragma unroll
        for (int et = 0; et < 4; ++et) oacc[et] = (f32x4){0.f, 0.f, 0.f, 0.f};
        if (c > 0) {
#pragma unroll
            for (int et = 0; et < 4; ++et) {
#pragma unroll
                for (int kb = 0; kb < 8; ++kb) { const bf16x8 rf = *(const LAS bf16x8*)(lds + RL_R + (et * 16 + i16) * RR_PITCH + (kb * 32 + 8 * g) * 2); oacc[et] = MFMA16(rf, qfrag[kb], oacc[et]); }
                oacc[et] = oacc[et] * xi; __builtin_amdgcn_sched_barrier(0); }
        }
        for (int i = 0; i <= (w >> 1); ++i) {
            f32x4 sa = (f32x4){0.f, 0.f, 0.f, 0.f}, sb = (f32x4){0.f, 0.f, 0.f, 0.f};
            const int mb0 = 2 * i, mb1 = 2 * i + 1;
#pragma unroll
            for (int kb = 0; kb < 8; ++kb) { const bf16x8 kf = *(const LAS bf16x8*)(lds + RL_K + (mb0 * 16 + i16) * RK_PITCH + (kb * 32 + 8 * g) * 2); sa = MFMA16(kf, qfrag[kb], sa); }
            __builtin_amdgcn_sched_barrier(0);
            if (mb1 <= w) {
#pragma unroll
                for (int kb = 0; kb < 8; ++kb) { const bf16x8 kf = *(const LAS bf16x8*)(lds + RL_K + (mb1 * 16 + i16) * RK_PITCH + (kb * 32 + 8 * g) * 2); sb = MFMA16(kf, qfrag[kb], sb); }
            }
            __builtin_amdgcn_sched_barrier(0);
            const float ga = exp2f(l2c * (float)(16 * (w - mb0))), gb = exp2f(l2c * (float)(16 * (w - mb1)));
#pragma unroll
            for (int r = 0; r < 4; ++r) { const bool da = (mb0 < w) || (i16 - 4 * g - r >= 0), db = (mb1 < w) || (i16 - 4 * g - r >= 0);
                sa[r] = da ? sa[r] * (dbase[r] * ga) : 0.f; sb[r] = (mb1 <= w && db) ? sb[r] * (dbase[r] * gb) : 0.f; }
            const bf16x8 sf = pack_bf8(sa, sb);
            __builtin_amdgcn_sched_barrier(0);
#pragma unroll
            for (int et = 0; et < 4; ++et) { const bf16x8 vf = tr_frag(lds + RL_V, RV_PITCH, mb0 * 16 + 4 * g, mb1 * 16 + 4 * g, et * 16, lane_c); oacc[et] = MFMA16(vf, sf, oacc[et]); }
        }
        { const size_t tok = tok0 + (size_t)c * 128 + w * 16 + i16; float s1 = 0.f, s2 = 0.f;
#pragma unroll
          for (int et = 0; et < 4; ++et) { const f32x4 o = oacc[et]; s1 += (o[0] + o[1]) + (o[2] + o[3]); s2 += (o[0] * o[0] + o[1] * o[1]) + (o[2] * o[2] + o[3] * o[3]);
              u32x2 wv; wv.x = pk2(o[0], o[1]); wv.y = pk2(o[2], o[3]); *(u32x2*)(ORET + tok * 2048 + h * 512 + es * 64 + et * 16 + 4 * g) = wv; }
          s1 += shx(s1, 16, lane_c); s1 += shx(s1, 32, lane_c); s2 += shx(s2, 16, lane_c); s2 += shx(s2, 32, lane_c);
          if (g == 0) *(f32x2*)(GNP + ((tok * 4 + h) * 8 + es) * 2) = (f32x2){s1, s2}; }
        if (more) {
#pragma unroll
            for (int i = 0; i < 8; ++i) stK[i] = *(const u32x4*)(kn + (size_t)i * 16 * CPAD * 2 + kvo);
#pragma unroll
            for (int i = 0; i < 2; ++i) stV[i] = *(const u32x4*)(vn + (size_t)i * 64 * CPAD * 2 + vvo);
#pragma unroll
            for (int kb = 0; kb < 8; ++kb) qfrag[kb] = *(const bf16x8*)(qn + kb * 64 + qvo);
        }
#pragma unroll
        for (int dt = 0; dt < 2; ++dt)
#pragma unroll
            for (int et = 0; et < 4; ++et) racc[dt][et] = racc[dt][et] * gchunk;
#pragma unroll
        for (int kb = 0; kb < 4; ++kb) {
            float zl[8];
#pragma unroll
            for (int j = 0; j < 8; ++j) zl[j] = __builtin_amdgcn_exp2f(l2c * (float)(127 - 32 * kb - 8 * g - j));
            const float zk = 1.f;
            bf16x8 af[2];
#pragma unroll
            for (int dt = 0; dt < 2; ++dt) { const bf16x8 raw = tr_frag(lds + RL_K, RK_PITCH, kb * 32 + 8 * g, kb * 32 + 8 * g + 4, (2 * w + dt) * 16, lane_c);
                const u32x4 rw = __builtin_bit_cast(u32x4, raw); u32x4 o;
                o.x = pk2(bflo(rw.x) * (zl[0] * zk), bfhi(rw.x) * (zl[1] * zk)); o.y = pk2(bflo(rw.y) * (zl[2] * zk), bfhi(rw.y) * (zl[3] * zk));
                o.z = pk2(bflo(rw.z) * (zl[4] * zk), bfhi(rw.z) * (zl[5] * zk)); o.w = pk2(bflo(rw.w) * (zl[6] * zk), bfhi(rw.w) * (zl[7] * zk));
                af[dt] = __builtin_bit_cast(bf16x8, o); }
#pragma unroll
            for (int et = 0; et < 4; ++et) { const bf16x8 vf = tr_frag(lds + RL_V, RV_PITCH, kb * 32 + 8 * g, kb * 32 + 8 * g + 4, et * 16, lane_c);
#pragma unroll
                for (int dt = 0; dt < 2; ++dt) racc[dt][et] = MFMA16(af[dt], vf, racc[dt][et]); }
            __builtin_amdgcn_sched_barrier(0);
        }
        __syncthreads();
        if (more) {
#pragma unroll
            for (int dt = 0; dt < 2; ++dt)
#pragma unroll
                for (int et = 0; et < 4; ++et) { const f32x4 rv = racc[dt][et]; u32x2 wv; wv.x = pk2(rv[0], rv[1]); wv.y = pk2(rv[2], rv[3]);
                    *(LAS u32x2*)(lds + RL_R + (et * 16 + i16) * RR_PITCH + ((2 * w + dt) * 16 + 4 * g) * 2) = wv; }
#pragma unroll
            for (int i = 0; i < 8; ++i) *(LAS u32x4*)(lds + klo + i * 16 * RK_PITCH) = stK[i];
#pragma unroll
            for (int i = 0; i < 2; ++i) *(LAS u32x4*)(lds + vlo + i * 64 * RV_PITCH) = stV[i];
        }
        __syncthreads();
    }
}
__device__ __forceinline__ void gn_gate_row(const bf16* PROJ, bf16* ORET, const float* GNP, size_t tok, int lane) {
#pragma unroll
    for (int h = 0; h < 4; ++h) {
        const f32x4* sp = (const f32x4*)(GNP + (tok * 4 + h) * 16); float s1 = 0.f, s2 = 0.f;
#pragma unroll
        for (int i = 0; i < 4; ++i) { const f32x4 v = sp[i]; s1 += v[0] + v[2]; s2 += v[1] + v[3]; }
        const float mean = s1 * (1.f / 512.f), var = fmaxf(s2 * (1.f / 512.f) - mean * mean, 0.f), rstd = 1.f / sqrtf(var + 1e-5f);
        bf16* op = ORET + tok * 2048 + h * 512 + lane * 8;
        const u32x4 ow = *(const u32x4*)op, gw = *(const u32x4*)(PROJ + tok * CPAD + PC_GR + h * 512 + lane * 8);
        u32x4 o; o.x = pk2((bflo(ow.x) - mean) * rstd * bflo(gw.x), (bfhi(ow.x) - mean) * rstd * bfhi(gw.x)); o.y = pk2((bflo(ow.y) - mean) * rstd * bflo(gw.y), (bfhi(ow.y) - mean) * rstd * bfhi(gw.y));
        o.z = pk2((bflo(ow.z) - mean) * rstd * bflo(gw.z), (bfhi(ow.z) - mean) * rstd * bfhi(gw.z)); o.w = pk2((bflo(ow.w) - mean) * rstd * bflo(gw.w), (bfhi(ow.w) - mean) * rstd * bfhi(gw.w));
        *(u32x4*)op = o;
    }
}


constexpr int NL_T5 = 0, NL_TILE = 64 * 144, NL_K0 = 4096, NL_V0 = NL_K0 + 2 * NL_TILE, NL_IMP = NL_K0 + 4 * NL_TILE, NL_SEL = NL_IMP + 8 * 64 * 33 * 4, NL_XCH = NL_SEL + 512, NL_END = NL_XCH + 8 * 512 * 4;
static_assert(NL_END <= RING_BYTES, "NSA LDS map");
__device__ __forceinline__ int ishx(int v, int m, int lane) { return __builtin_amdgcn_ds_bpermute((lane ^ m) << 2, v); }

__device__ __forceinline__ void nsa_unit(const Ctx& C, int u, const bf16* PROJ, const bf16* KCV, const float* t5, float* ONF, bf16* ON, unsigned* DBGSEL = nullptr) {
    const int qb = u < 256 ? 31 - (u >> 4) : ((u - 256) >> 4), bg = u & 15, g_ = bg & 1, b = bg >> 1;
    int tid_u = C.tid; asm volatile("" : "+v"(tid_u));
    const int w = C.wave, tid = tid_u, lane = tid & 63, head = g_ * 8 + w, s0 = qb * 64, i16 = lane & 15, g = lane >> 4;
    LAS unsigned char* lds = C.lds;
    const size_t tok0 = (size_t)b * T_;
    LAS float* T5L = (LAS float*)(lds + NL_T5) + w * 128;
    LAS float* impH = (LAS float*)(lds + NL_IMP);
    LAS unsigned* selm = (LAS unsigned*)(lds + NL_SEL);
    for (int i = tid; i < 1024; i += 512) ((LAS float*)(lds + NL_T5))[i] = t5[g_ * 1024 + i];
    { const bf16* kc = KCV + ((size_t)((0 * NBC + b) * 2 + g_) * NCMP_PAD) * 64; const bf16* vc = KCV + ((size_t)((1 * NBC + b) * 2 + g_) * NCMP_PAD) * 64;
#pragma unroll
      for (int i = 0; i < 2; ++i) { const int p = tid + 512 * i, row = p >> 3, c16 = p & 7;
          *(LAS u32x4*)(lds + NL_K0 + row * 144 + c16 * 16) = *(const u32x4*)(kc + row * 64 + c16 * 8);
          *(LAS u32x4*)(lds + NL_V0 + row * 144 + c16 * 16) = *(const u32x4*)(vc + row * 64 + c16 * 8); } }
    bf16x8 qf[4][2];
#pragma unroll
    for (int tt = 0; tt < 4; ++tt)
#pragma unroll
        for (int kb = 0; kb < 2; ++kb) qf[tt][kb] = *(const bf16x8*)(PROJ + (tok0 + s0 + tt * 16 + i16) * CPAD + PC_QN + head * 64 + kb * 32 + 8 * g);
    __syncthreads();
#pragma unroll
    for (int tt = 0; tt < 4; ++tt) {
        int lane_b = lane; asm volatile("" : "+v"(lane_b));
        const int i16 = lane_b & 15, g = lane_b >> 4;
        LAS unsigned char* kl = lds + NL_K0 + i16 * 144 + g * 16; LAS unsigned char* vl = lds + NL_V0 + (4 * g + ((lane_b & 15) >> 2)) * 144 + (lane_b & 3) * 8;
        f32x4 st[8];
#pragma unroll
        for (int kt = 0; kt < 8; ++kt) { st[kt] = (f32x4){0.f, 0.f, 0.f, 0.f};
#pragma unroll
            for (int kb = 0; kb < 2; ++kb) { const bf16x8 kf = *(const LAS bf16x8*)(kl + kt * 16 * 144 + kb * 64); st[kt] = MFMA16(kf, qf[tt][kb], st[kt]); } }
        const int pos = s0 + tt * 16 + i16; float mx = -1e30f;
#pragma unroll
        for (int kt = 0; kt < 8; ++kt)
#pragma unroll
            for (int r = 0; r < 4; ++r) { const int dist = pos - 16 * (kt * 16 + 4 * g + r) - 31; const int idx = dist < 0 ? 0 : (dist > 127 ? 127 : dist);
                const float l = dist >= 0 ? st[kt][r] + T5L[idx] : -1e30f; st[kt][r] = l; mx = fmaxf(mx, l); }
        mx = fmaxf(mx, shx(mx, 16, lane_b)); mx = fmaxf(mx, shx(mx, 32, lane_b));
        float sum = 0.f;
#pragma unroll
        for (int kt = 0; kt < 8; ++kt)
#pragma unroll
            for (int r = 0; r < 4; ++r) { const float p = st[kt][r] > -1e29f ? __builtin_amdgcn_exp2f(st[kt][r] - mx) : 0.f; st[kt][r] = p; sum += p; }
        sum += shx(sum, 16, lane_b); sum += shx(sum, 32, lane_b);
        const float inv = 1.f / fmaxf(sum, 1e-30f);
        float rv[8];
#pragma unroll
        for (int kt = 0; kt < 8; ++kt) st[kt] = st[kt] * inv;
        { LAS float* xs = (LAS float*)(lds + NL_XCH) + w * 512;
#pragma unroll
          for (int kt = 0; kt < 8; ++kt) xs[kt * 64 + lane_b] = st[kt][3];
#pragma unroll
          for (int kt = 0; kt < 8; ++kt) rv[kt] = xs[kt * 64 + ((lane_b - 16) & 63)]; }
#pragma unroll
        for (int kt = 0; kt < 8; ++kt) { const float prev = g > 0 ? rv[kt] : (kt > 0 ? rv[kt > 0 ? kt - 1 : 0] : 0.f);
            impH[(w * 64 + tt * 16 + i16) * 33 + 4 * kt + g] = (st[kt][0] + st[kt][1]) + (st[kt][2] + st[kt][3]) + (DBG_NSA == 2 ? 0.f : prev); }
        f32x4 o[4];
#pragma unroll
        for (int dt = 0; dt < 4; ++dt) o[dt] = (f32x4){0.f, 0.f, 0.f, 0.f};
#pragma unroll
        for (int i = 0; i < 4; ++i) { const bf16x8 pf = pack_bf8(st[2 * i], st[2 * i + 1]);
#pragma unroll
            for (int dt = 0; dt < 4; ++dt) { const bf16x8 vf = tr_frag2(vl, (2 * i) * 16 * 144 + dt * 32, (2 * i + 1) * 16 * 144 + dt * 32); o[dt] = MFMA16(vf, pf, o[dt]); } }
        const float g0 = (DBG_BR < 0 || DBG_BR == 0) ? bf2f(PROJ[(tok0 + pos) * CPAD + PC_GATE + head * 3 + 0]) : 0.f;
#pragma unroll
        for (int dt = 0; dt < 4; ++dt) *(f32x4*)(ONF + (tok0 + pos) * DM + head * 64 + dt * 16 + 4 * g) = o[dt] * g0;
        __builtin_amdgcn_sched_barrier(0);
    }
    __syncthreads();
    int tid_s = C.tid; asm volatile("" : "+v"(tid_s));
    if (tid_s < 64) {
        const int tid = tid_s, lane = tid_s & 63;
        LAS float* row = impH + tid * 33; float im[32];
#pragma unroll
        for (int j = 0; j < 32; ++j) { float v = row[j];
#pragma unroll
            for (int hh = 1; hh < 8; ++hh) v += impH[(hh * 64 + tid) * 33 + j];
            im[j] = v;
#if DBG_NSA
            ((float*)DBGSEL)[(size_t)32 * T_ + (size_t)16 * T_ * 32 + ((size_t)(b * 2 + g_) * T_ + s0 + tid) * 32 + j] = j <= qb ? v : 0.f;
#endif
        }
        unsigned m = 1u | (1u << qb) | (qb > 0 ? (1u << (qb - 1)) : 0u);
        int cnt = __builtin_popcount(m);
        const int navail = qb + 1;
        const int want = navail < 8 ? navail : 8;
        for (; cnt < want; ++cnt) { int best = -1; float bv = -1.f;
#pragma unroll
            for (int j = 0; j < 32; ++j) { const bool cand = j <= qb && !((m >> j) & 1u); if (cand && im[j] > bv) { bv = im[j]; best = j; } }
            if (best < 0) break; m |= 1u << best; }
        selm[tid] = m;
#if DBG_NSA
        DBGSEL[(size_t)(16 + b * 2 + g_) * T_ + s0 + tid] = m;
#endif
        unsigned um = m;
#pragma unroll
        for (int o = 1; o < 64; o <<= 1) um |= (unsigned)ishx((int)um, o, lane);
        if (tid == 0) selm[64] = um;
    }
    __syncthreads();
    int tid_t = C.tid; asm volatile("" : "+v"(tid_t));
    const int tid2 = tid_t, lane2 = tid_t & 63;
    const unsigned umask = selm[64];
    unsigned selw[4];
#pragma unroll
    for (int tt = 0; tt < 4; ++tt) selw[tt] = selm[tt * 16 + (lane2 & 15)];
    const int nw = (qb < 8 ? qb : 8) + 1, ntile = nw + __builtin_popcount(umask);
    const float bfar = T5L[127];
    float mrun[4], lrun[4]; f32x4 oacc[4][4];
#pragma unroll
    for (int tt = 0; tt < 4; ++tt) { mrun[tt] = -1e30f; lrun[tt] = 0.f;
#pragma unroll
        for (int dt = 0; dt < 4; ++dt) oacc[dt][tt] = (f32x4){0.f, 0.f, 0.f, 0.f}; }
    const int srow = tid2 >> 3, sc16 = tid2 & 7;
    const bf16* kvb = PROJ + tok0 * CPAD + PC_KV + g_ * 64 + sc16 * 8;
    const int slds = srow * 144 + sc16 * 16;
    unsigned rem = umask;
    int cur_blk = qb, cur_br = 0;
    { const bf16* kp = kvb + (size_t)(cur_blk * 64 + srow) * CPAD; *(LAS u32x4*)(lds + NL_K0 + slds) = *(const u32x4*)(kp + 4 * 128); *(LAS u32x4*)(lds + NL_V0 + slds) = *(const u32x4*)(kp + 5 * 128); }
    __syncthreads();
    for (int it = 0; it < ntile; ++it) {
        int lane_c = lane2; asm volatile("" : "+v"(lane_c));
        const int i16c = lane_c & 15, gc = lane_c >> 4;
        const int buf = it & 1;
        int nxt_blk, nxt_br; const bool more = it + 1 < ntile;
        if (it + 1 < nw) { nxt_blk = qb - (it + 1); nxt_br = 0; } else { nxt_br = 1; nxt_blk = rem ? __builtin_ctz(rem) : 0; if (more) rem &= rem - 1; }
        u32x4 nk, nv;
        if (more) { const bf16* kp = kvb + (size_t)(nxt_blk * 64 + srow) * CPAD; nk = *(const u32x4*)(kp + (nxt_br ? 2 : 4) * 128); nv = *(const u32x4*)(kp + (nxt_br ? 3 : 5) * 128); }
        LAS unsigned char* kt_ = lds + NL_K0 + buf * NL_TILE + i16c * 144 + gc * 16; LAS unsigned char* vt_ = lds + NL_V0 + buf * NL_TILE + (4 * gc + (i16c >> 2)) * 144 + (lane_c & 3) * 8;
        const int dl = qb - cur_blk;
#pragma unroll
        for (int th = 0; th < 2; ++th) {
            f32x4 st[4][2];
#pragma unroll
            for (int kt = 0; kt < 4; ++kt) { const bf16x8 kf0 = *(const LAS bf16x8*)(kt_ + kt * 16 * 144), kf1 = *(const LAS bf16x8*)(kt_ + kt * 16 * 144 + 64);
#pragma unroll
                for (int tx = 0; tx < 2; ++tx) { st[kt][tx] = MFMA16(kf0, qf[2 * th + tx][0], ((f32x4){0.f, 0.f, 0.f, 0.f})); st[kt][tx] = MFMA16(kf1, qf[2 * th + tx][1], st[kt][tx]); } }
            if (dl >= 3 && !(cur_br == 0 && dl == 8)) {
#pragma unroll
                for (int tx = 0; tx < 2; ++tx) { const float off = (cur_br == 0 || ((selw[2 * th + tx] >> cur_blk) & 1u)) ? bfar : -1e30f;
#pragma unroll
                    for (int kt = 0; kt < 4; ++kt) st[kt][tx] = st[kt][tx] + off; }
            } else {
#pragma unroll
                for (int tx = 0; tx < 2; ++tx) { const bool sel = cur_br == 0 || ((selw[2 * th + tx] >> cur_blk) & 1u);
#pragma unroll
                    for (int kt = 0; kt < 4; ++kt)
#pragma unroll
                        for (int r = 0; r < 4; ++r) { const int dist = 64 * dl + ((2 * th + tx) * 16 + i16c) - (kt * 16 + 4 * gc + r); const int idx = dist < 0 ? 0 : (dist > 127 ? 127 : dist);
                            const bool ok = sel && dist >= 0 && (cur_br == 1 || dist < 512);
                            st[kt][tx][r] = ok ? st[kt][tx][r] + T5L[idx] : -1e30f; } }
            }
            bf16x8 pf[2][2];
#pragma unroll
            for (int tx = 0; tx < 2; ++tx) { const int tt = 2 * th + tx;
                float mx = fmaxf(fmaxf(fmaxf(st[0][tx][0], st[0][tx][1]), fmaxf(st[0][tx][2], st[0][tx][3])), fmaxf(fmaxf(st[1][tx][0], st[1][tx][1]), fmaxf(st[1][tx][2], st[1][tx][3])));
                mx = fmaxf(mx, fmaxf(fmaxf(fmaxf(st[2][tx][0], st[2][tx][1]), fmaxf(st[2][tx][2], st[2][tx][3])), fmaxf(fmaxf(st[3][tx][0], st[3][tx][1]), fmaxf(st[3][tx][2], st[3][tx][3]))));
                mx = fmaxf(mx, shx(mx, 16, lane_c)); mx = fmaxf(mx, shx(mx, 32, lane_c));
                const float mn = fmaxf(mrun[tt], mx), al = __builtin_amdgcn_exp2f(mrun[tt] - mn); mrun[tt] = mn;
                float ps = 0.f;
#pragma unroll
                for (int kt = 0; kt < 4; ++kt)
#pragma unroll
                    for (int r = 0; r < 4; ++r) { const float p = __builtin_amdgcn_exp2f(st[kt][tx][r] - mn); st[kt][tx][r] = p; ps += p; }
                lrun[tt] = lrun[tt] * al + ps;
#pragma unroll
                for (int dt = 0; dt < 4; ++dt) oacc[dt][tt] = oacc[dt][tt] * al;
                pf[0][tx] = pack_bf8(st[0][tx], st[1][tx]); pf[1][tx] = pack_bf8(st[2][tx], st[3][tx]);
            }
#pragma unroll
            for (int i = 0; i < 2; ++i)
#pragma unroll
                for (int dt = 0; dt < 4; ++dt) { const bf16x8 vf = tr_frag2(vt_, (2 * i) * 16 * 144 + dt * 32, (2 * i + 1) * 16 * 144 + dt * 32);
#pragma unroll
                    for (int tx = 0; tx < 2; ++tx) oacc[dt][2 * th + tx] = MFMA16(vf, pf[i][tx], oacc[dt][2 * th + tx]); }
            __builtin_amdgcn_sched_barrier(0);
        }
        const bool last = !more;
        if (last || (cur_br == 0 && nxt_br == 1)) {
#pragma unroll
            for (int tt = 0; tt < 4; ++tt) { float l = lrun[tt]; l += shx(l, 16, lane_c); l += shx(l, 32, lane_c);
                const size_t tok = tok0 + s0 + tt * 16 + i16c;
                const float gt = ((DBG_BR < 0 || DBG_BR == (cur_br == 0 ? 2 : 1)) ? bf2f(PROJ[tok * CPAD + PC_GATE + head * 3 + (cur_br == 0 ? 2 : 1)]) : 0.f) / fmaxf(l, 1e-30f);
#pragma unroll
                for (int dt = 0; dt < 4; ++dt) { float* op = ONF + tok * DM + head * 64 + dt * 16 + 4 * gc; const f32x4 v = *(const f32x4*)op + oacc[dt][tt] * gt;
                    if (last) { u32x2 wv; wv.x = pk2(v[0], v[1]); wv.y = pk2(v[2], v[3]); *(u32x2*)(ON + tok * DM + head * 64 + dt * 16 + 4 * gc) = wv; }
                    else *(f32x4*)op = v;
                    oacc[dt][tt] = (f32x4){0.f, 0.f, 0.f, 0.f}; }
                mrun[tt] = -1e30f; lrun[tt] = 0.f; }
        }
        if (more) { *(LAS u32x4*)(lds + NL_K0 + (buf ^ 1) * NL_TILE + slds) = nk; *(LAS u32x4*)(lds + NL_V0 + (buf ^ 1) * NL_TILE + slds) = nv; }
        cur_blk = nxt_blk; cur_br = nxt_br;
        __syncthreads();
    }
}

__device__ __forceinline__ float nsa_dot64(const bf16* krow, const LAS float* q) {
    float s = 0.f;
#pragma unroll
    for (int c = 0; c < 8; ++c) s += dot8(*(const u32x4*)(krow + 8 * c), q + 8 * c);
    return s;
}
__device__ __forceinline__ void nsa_naive_unit(const Ctx& C, int u, const bf16* PROJ, const bf16* KCV, const float* t5, bf16* ON, bf16* ONB = nullptr, unsigned* DBGSEL = nullptr) {
    const int t = u & (T_ - 1), g = (u >> 11) & 1, b = u >> 12, h = C.wave, head = g * 8 + h, lane = C.lane;
    const size_t tok0 = (size_t)b * T_, tok = tok0 + t;
    LAS float* qs = (LAS float*)C.lds + h * 64; LAS float* pcs = (LAS float*)(C.lds + 2048); LAS float* lg = (LAS float*)(C.lds + 8192) + h * 512;
    LAS float* imp = (LAS float*)(C.lds + 24576); LAS int* sel = (LAS int*)(C.lds + 24576 + 128);
    const float* tb = t5 + head * 128;
    qs[lane] = bf2f(PROJ[tok * CPAD + PC_QN + head * 64 + lane]);
    __syncthreads();
    const bf16* kc = KCV + ((size_t)((0 * NBC + b) * 2 + g) * NCMP_PAD) * 64; const bf16* vc = KCV + ((size_t)((1 * NBC + b) * 2 + g) * NCMP_PAD) * 64;
    float l[2]; bool ok[2];
#pragma unroll
    for (int r = 0; r < 2; ++r) { const int n = lane + 64 * r; ok[r] = (n < NCMP) && (16 * n + 31 <= t);
        l[r] = -1e30f; if (ok[r]) { int dist = t - 16 * n - 31; dist = dist > 127 ? 127 : dist; l[r] = nsa_dot64(kc + n * 64, qs) + tb[dist]; } }
    { const float mx = wave_max(fmaxf(l[0], l[1]), lane); const float e0 = ok[0] ? exp2f(l[0] - mx) : 0.f, e1 = ok[1] ? exp2f(l[1] - mx) : 0.f;
      const float inv = 1.f / fmaxf(wave_sum(e0 + e1, lane), 1e-30f); pcs[h * 128 + lane] = e0 * inv; pcs[h * 128 + 64 + lane] = e1 * inv; }
    __syncthreads();
    float oc = 0.f;
    for (int n = 0; n < NCMP; ++n) oc += pcs[h * 128 + n] * bf2f(vc[n * 64 + lane]);
    const int cur = t >> 6;
    if (C.tid < 32) { const int j = C.tid; float v = 0.f; const int n0 = DBG_NSA == 2 ? 4 * j : (4 * j - 1 < 0 ? 0 : 4 * j - 1), n1 = 4 * j + 3 > NCMP - 1 ? NCMP - 1 : 4 * j + 3;
        for (int hh = 0; hh < 8; ++hh) for (int n = n0; n <= n1; ++n) v += pcs[hh * 128 + n];
#if DBG_NSA
        ((float*)DBGSEL)[(size_t)32 * T_ + ((size_t)(b * 2 + g) * T_ + t) * 32 + j] = j <= cur ? v : 0.f;
#endif
        if (j == 0 || j == cur || j == cur - 1) v = 1e4f; if (j > cur) v = -1e30f; imp[j] = v; }
    __syncthreads();
    if (C.tid == 0) { unsigned used = 0u; int ns = 0;
        for (int k = 0; k < 8; ++k) { int best = -1; float bv = -1e29f;
            for (int j = 0; j < 32; ++j) if (!((used >> j) & 1u) && imp[j] > bv) { bv = imp[j]; best = j; }
            if (best < 0) break; used |= 1u << best; sel[ns++] = best; }
        sel[8] = ns;
#if DBG_NSA
        { unsigned mk = 0u; for (int k = 0; k < ns; ++k) mk |= 1u << sel[k]; DBGSEL[(size_t)(b * 2 + g) * T_ + t] = mk; }
#endif
    }
    __syncthreads();
    const int ns = sel[8];
    float os = 0.f;
    { float mx = -1e30f;
      for (int i = 0; i < ns; ++i) { const int key = 64 * sel[i] + lane; float v = -1e30f;
          if (key <= t) { int dist = t - key; dist = dist > 127 ? 127 : dist; v = nsa_dot64(PROJ + (tok0 + key) * CPAD + PC_KV + 2 * 128 + g * 64, qs) + tb[dist]; }
          lg[i * 64 + lane] = v; mx = fmaxf(mx, v); }
      mx = wave_max(mx, lane); float s = 0.f;
      for (int i = 0; i < ns; ++i) { const int key = 64 * sel[i] + lane; const float e = key <= t ? exp2f(lg[i * 64 + lane] - mx) : 0.f; lg[i * 64 + lane] = e; s += e; }
      const float inv = 1.f / fmaxf(wave_sum(s, lane), 1e-30f);
      __syncthreads();
      for (int i = 0; i < ns; ++i) { const bf16* vb = PROJ + (tok0 + 64 * sel[i]) * CPAD + PC_KV + 3 * 128 + g * 64 + lane;
          for (int kk = 0; kk < 64; ++kk) os += lg[i * 64 + kk] * bf2f(vb[(size_t)kk * CPAD]); }
      os *= inv; }
    __syncthreads();
    float ow = 0.f;
    { float mx = -1e30f;
      for (int i = 0; i < 8; ++i) { const int key = t - 511 + 64 * i + lane; float v = -1e30f;
          if (key >= 0) { int dist = t - key; dist = dist > 127 ? 127 : dist; v = nsa_dot64(PROJ + (tok0 + key) * CPAD + PC_KV + 4 * 128 + g * 64, qs) + tb[dist]; }
          lg[i * 64 + lane] = v; mx = fmaxf(mx, v); }
      mx = wave_max(mx, lane); float s = 0.f;
      for (int i = 0; i < 8; ++i) { const int key = t - 511 + 64 * i + lane; const float e = key >= 0 ? exp2f(lg[i * 64 + lane] - mx) : 0.f; lg[i * 64 + lane] = e; s += e; }
      const float inv = 1.f / fmaxf(wave_sum(s, lane), 1e-30f);
      __syncthreads();
      for (int i = 0; i < 8; ++i) for (int kk = 0; kk < 64; ++kk) { const int key = t - 511 + 64 * i + kk; if (key >= 0) ow += lg[i * 64 + kk] * bf2f(PROJ[(tok0 + key) * CPAD + PC_KV + 5 * 128 + g * 64 + lane]); }
      ow *= inv; }
    const bf16* gp = PROJ + tok * CPAD + PC_GATE + head * 3;
    const float r = bf2f(gp[0]) * oc + bf2f(gp[1]) * os + bf2f(gp[2]) * ow;
    ON[tok * DM + head * 64 + lane] = (bf16)f2bf(r);
#if DBG_NSA
    { const float rb = (DBG_BR < 0 || DBG_BR == 0 ? bf2f(gp[0]) * oc : 0.f) + (DBG_BR < 0 || DBG_BR == 1 ? bf2f(gp[1]) * os : 0.f) + (DBG_BR < 0 || DBG_BR == 2 ? bf2f(gp[2]) * ow : 0.f);
      ONB[tok * DM + head * 64 + lane] = (bf16)f2bf(rb); }
#endif
    __syncthreads();
}

#ifndef RET_NAIVE
#define RET_NAIVE 0
#endif
#ifndef NSA_NAIVE
#define NSA_NAIVE 0
#endif
__global__ void __launch_bounds__(NWAVES * 64, 2) fwd(Args a) {
    extern __shared__ __attribute__((aligned(16))) unsigned char lds_raw[];
    Ctx C; C.lds = (LAS unsigned char*)lds_raw; C.tid = threadIdx.x; C.lane = C.tid & 63; C.wave = __builtin_amdgcn_readfirstlane(C.tid >> 6); C.G = gridDim.x; C.bid = blockIdx.x;
    unsigned char* ws = a.ws;
    gu32* ctl = (gu32*)(ws + WS_CTL);
    volatile LAS unsigned* MISC = (volatile LAS unsigned*)(C.lds + MISC_OFF);
    for (int u = C.tid; u < (LDS_BYTES - LDSCTL_OFF) / 4; u += NWAVES * 64) ((LAS unsigned*)(C.lds + LDSCTL_OFF))[u] = 0u;
    __syncthreads();
    const bool one = (a.flags & 1) != 0;
    XcdBarrier bar; bar.bar = (unsigned*)(ctl + CW_BAR); bar.x = 0; bar.st = nullptr;
    if (one) bar = xcd_barrier_post((unsigned*)(ctl + CW_BAR), MISC + 8);
#define SEAM() do { int f_ = a.flags; asm volatile("" : "+s"(f_)); if (f_ & 1) xcd_barrier(bar); } while (0)
#define PH(k) (plo_ <= (k) && (k) < phi_)
#define RELOAD() do { int t_ = threadIdx.x; asm volatile("" : "+v"(t_)); C.tid = t_; C.lane = t_ & 63; C.wave = __builtin_amdgcn_readfirstlane(t_ >> 6); gw = C.bid * NWAVES + C.wave; } while (0)
    int gw = C.bid * NWAVES + C.wave; const int NGW = C.G * NWAVES;
    bf16* const H = (bf16*)(ws + WS_H); bf16* const PROJ = (bf16*)(ws + WS_BIG); bf16* const FFH = (bf16*)(ws + WS_BIG);
    bf16* const ORET = (bf16*)(ws + WS_ORET); bf16* const ON = (bf16*)(ws + WS_ON); bf16* const TMP = (bf16*)(ws + WS_TMP); bf16* const MERGED = (bf16*)(ws + WS_MERGED);
    bf16* const KCV = (bf16*)(ws + WS_KC); float* const GNP = (float*)(ws + WS_GNS); float* const ONF = (float*)(ws + WS_ONF);
    const float* rot = (const float*)(ws + WS_ROT); const float* t5 = (const float*)(ws + WS_T5);

    if (a.it_lo < 0) { RELOAD(); p0_prologue(C, a); SEAM(); }
    const int it0 = a.it_lo < 0 ? 0 : a.it_lo, it1 = a.it_hi > 10 ? 10 : a.it_hi;
    for (int it = it0; it < it1; ++it) {
        int itv = it, plo_ = a.ph_lo, phi_ = a.ph_hi; asm volatile("" : "+s"(itv), "+s"(plo_), "+s"(phi_)); const int L = itv / 5, sub = itv % 5;
        if (sub < 4) {
            const size_t row0 = (size_t)sub * MC;
            const float* xsrc = (L == 0 ? a.in[0] : (const float*)a.out) + row0 * DM;
            float* xdst = a.out + row0 * DM;
            if (PH(0)) { RELOAD(); const float* g = a.in[1] + L * DM; for (int m = gw; m < MC; m += NGW) rms_row_to_bf16(xsrc + (size_t)m * DM, g, H + (size_t)m * DM, C.lane); SEAM(); }
            if (PH(1)) { pg8::Gemm g{H, (const bf16*)(ws + WS_WIN) + (size_t)L * CPAD * DM, MC, CPAD, DM}; pg8::StaticOrder S; S.init(MC, CPAD, C.G, C.bid);
                epi::EpiInProj E{PROJ, rot}; pg8::gemm_phase<epi::EpiInProj, pg8::StaticOrder, true, true>(C.lds, g, S, E); SEAM(); }
            if (PH(2)) { RELOAD(); for (int u = C.bid; u < 2 * NBC * 2 * NCMP; u += C.G) { const int kv = u / (2 * NCMP * NBC);
                    compress_naive_unit(C, u, PROJ, (kv ? a.in[4] : a.in[3]) + L * 2048, (kv ? a.in[7] : a.in[5]) + (size_t)L * 2048 * 256, (kv ? a.in[8] : a.in[6]) + (size_t)L * 256 * 64, KCV); }
                SEAM(); }
            if (PH(3)) {
#if RET_NAIVE
                RELOAD(); for (int u = C.bid; u < NBC * 4 * 256; u += C.G) ret_naive_unit(C, u, PROJ, ORET);
#else
                RELOAD(); for (int u = C.bid; u < NBC * 4 * 8; u += C.G) ret_unit(C, u, PROJ, ORET, GNP);
#endif
#if DBG_NSA
                RELOAD(); for (int u = C.bid; u < NBC * 2 * T_; u += C.G) nsa_naive_unit(C, u, PROJ, KCV, t5, ON, MERGED, (unsigned*)(ws + WS_END));
                RELOAD(); for (int u = C.bid; u < NBC * 2 * 32; u += C.G) nsa_unit(C, u, PROJ, KCV, t5, ONF, TMP, (unsigned*)(ws + WS_END));
                SEAM();
                { RELOAD(); float d2 = 0.f, r2 = 0.f; const float* sm = (const float*)(ws + WS_END) + 32 * T_; for (int i = C.bid * 512 + C.tid; i < 16 * T_ * 32; i += C.G * 512) { const float a_ = sm[i], b_ = sm[16 * T_ * 32 + i]; d2 += (a_ - b_) * (a_ - b_); r2 += a_ * a_; }
                  d2 = wave_sum(d2, C.lane); r2 = wave_sum(r2, C.lane); if (C.lane == 0) { atomicAdd((float*)(ctl + 8), d2); atomicAdd((float*)(ctl + 9), r2); } }
#elif NSA_NAIVE
                RELOAD(); for (int u = C.bid; u < NBC * 2 * T_; u += C.G) nsa_naive_unit(C, u, PROJ, KCV, t5, ON);
#else
                RELOAD(); for (int u = C.bid; u < NBC * 2 * 32; u += C.G) nsa_unit(C, u, PROJ, KCV, t5, ONF, ON);
#endif
                SEAM(); }
            if (PH(4)) {
#if !RET_NAIVE
                RELOAD(); for (int m = gw; m < MC; m += NGW) gn_gate_row(PROJ, ORET, GNP, (size_t)m, C.lane);
#endif
                SEAM(); }
            if (PH(5)) { pg8::Gemm g{ORET, (const bf16*)(ws + WS_WORET) + (size_t)L * DM * 2048, MC, DM, 2048}; pg8::StaticOrder S; S.init(MC, DM, C.G, C.bid);
                epi::EpiGate<false> E{TMP, nullptr, PROJ + PC_MA, DM, CPAD}; pg8::gemm_phase<epi::EpiGate<false>, pg8::StaticOrder, true, true>(C.lds, g, S, E); SEAM(); }
            if (PH(6)) { pg8::Gemm g{ON, (const bf16*)(ws + WS_WONSA) + (size_t)L * DM * DM, MC, DM, DM}; pg8::StaticOrder S; S.init(MC, DM, C.G, C.bid);
                epi::EpiGate<true> E{MERGED, TMP, PROJ + PC_MB, DM, CPAD}; pg8::gemm_phase<epi::EpiGate<true>, pg8::StaticOrder, true, true>(C.lds, g, S, E); SEAM(); }
            if (PH(7)) { pg8::Gemm g{MERGED, (const bf16*)(ws + WS_WOUT) + (size_t)L * DM * DM, MC, DM, DM}; pg8::StaticOrder S; S.init(MC, DM, C.G, C.bid);
                epi::EpiResid E{xsrc, xdst}; pg8::gemm_phase<epi::EpiResid, pg8::StaticOrder, true, true>(C.lds, g, S, E); SEAM(); }
        } else {
            if (PH(0)) { RELOAD(); const float* g = a.in[12] + L * DM; for (int m = gw; m < NTOK; m += NGW) rms_row_to_bf16(a.out + (size_t)m * DM, g, H + (size_t)m * DM, C.lane); SEAM(); }
            if (PH(1)) { pg8::Gemm g{H, (const bf16*)(ws + WS_WFFI) + (size_t)L * 2 * FFH_ * DM, NTOK, 2 * FFH_, DM}; pg8::StaticOrder S; S.init(NTOK, 2 * FFH_, C.G, C.bid);
                epi::EpiSwiGlu E{FFH}; pg8::gemm_phase<epi::EpiSwiGlu, pg8::StaticOrder, true, true>(C.lds, g, S, E); SEAM(); }
            if (PH(2)) { pg8::Gemm g{FFH, (const bf16*)(ws + WS_WFFO) + (size_t)L * DM * FFH_, NTOK, DM, FFH_}; pg8::StaticOrder S; S.init(NTOK, DM, C.G, C.bid);
                epi::EpiResid E{a.out, a.out}; pg8::gemm_phase<epi::EpiResid, pg8::StaticOrder, true, true>(C.lds, g, S, E); SEAM(); }
        }
    }
    if (a.it_hi > 10) { RELOAD(); const float* g = a.in[16]; for (int m = gw; m < NTOK; m += NGW) rms_row_f32(a.out + (size_t)m * DM, g, C.lane);
#if DBG_NSA
        SEAM();
        { const float d2 = __hip_atomic_load((float*)(ctl + 8), RLX_AGENT), r2 = __hip_atomic_load((float*)(ctl + 9), RLX_AGENT); const float e = sqrtf(d2 / fmaxf(r2, 1e-30f));
          for (size_t i = (size_t)C.bid * 512 + C.tid; i < (size_t)NTOK * DM; i += (size_t)C.G * 512) a.out[i] *= (1.f + e); }
#endif
    }
#undef SEAM
#undef PH
}

#ifndef ONE_LAUNCH
#define ONE_LAUNCH 1
#endif
extern "C" void kernel_launch(void* const* d_in, const int* in_sizes, int n_in, void* d_out, int out_size, void* d_ws, size_t ws_size, hipStream_t stream) {
    static int grid = 0;
    if (grid == 0) {
        if (n_in != 17 || in_sizes[0] != NTOK * DM || out_size != NTOK * DM || ws_size < WS_END) { fprintf(stderr, "kernel_launch: unexpected shapes (n_in %d, in0 %d, out %d, ws %zu); nothing launched\n", n_in, n_in > 0 ? in_sizes[0] : -1, out_size, ws_size); grid = -1; return; }
        int dev = 0, cus = 0, per_cu = 0;
        if (hipGetDevice(&dev) != hipSuccess || hipDeviceGetAttribute(&cus, hipDeviceAttributeMultiprocessorCount, dev) != hipSuccess) { grid = -1; return; }
        if (hipFuncSetAttribute((const void*)fwd, hipFuncAttributeMaxDynamicSharedMemorySize, LDS_BYTES) != hipSuccess) { fprintf(stderr, "kernel_launch: hipFuncSetAttribute failed\n"); grid = -1; return; }
        if (hipOccupancyMaxActiveBlocksPerMultiprocessor(&per_cu, (const void*)fwd, NWAVES * 64, LDS_BYTES) != hipSuccess || per_cu < 1) { fprintf(stderr, "kernel_launch: occupancy query says %d\n", per_cu); }
        (void)hipGetLastError();
        grid = cus;
    }
    if (grid < 0) return;
    (void)hipMemsetAsync((char*)d_ws + WS_CTL, 0, CTL_ZERO_BYTES, stream);
    Args a{};
    for (int i = 0; i < 17; ++i) a.in[i] = (const float*)d_in[i];
    a.out = (float*)d_out; a.ws = (unsigned char*)d_ws;
#if ONE_LAUNCH
    a.it_lo = -1; a.it_hi = 11; a.ph_lo = 0; a.ph_hi = 99; a.flags = 1;
    hipLaunchKernelGGL(fwd, dim3(grid), dim3(NWAVES * 64), LDS_BYTES, stream, a);
#else
    a.flags = 0;
    a.it_lo = -1; a.it_hi = 0; a.ph_lo = 0; a.ph_hi = 0; hipLaunchKernelGGL(fwd, dim3(grid), dim3(NWAVES * 64), LDS_BYTES, stream, a);
    for (int it = 0; it < 10; ++it) { const int nph = (it % 5 < 4) ? 8 : 3;
        for (int ph = 0; ph < nph; ++ph) { a.it_lo = it; a.it_hi = it + 1; a.ph_lo = ph; a.ph_hi = ph + 1; hipLaunchKernelGGL(fwd, dim3(grid), dim3(NWAVES * 64), LDS_BYTES, stream, a); } }
    a.it_lo = 10; a.it_hi = 11; a.ph_lo = 0; a.ph_hi = 0; hipLaunchKernelGGL(fwd, dim3(grid), dim3(NWAVES * 64), LDS_BYTES, stream, a);
#endif
}
```

```cpp
#include <hip/hip_runtime.h>
#include <cstdio>
#include <cstdint>
#ifndef DBG_NSA
#define DBG_NSA 0
#endif
#ifndef DBG_BR
#define DBG_BR -1
#endif
namespace pg8 {
#define PG8_LAS __attribute__((address_space(3)))
typedef unsigned short bf16_t;
typedef short bf16x8 __attribute__((ext_vector_type(8)));
typedef float f32x4 __attribute__((ext_vector_type(4)));
typedef unsigned u32x4 __attribute__((ext_vector_type(4)));
constexpr int BM = 256, BK = 64, HALF = 128, HTB = HALF * BK * 2  , STAGE_BYTES = 8 * HTB, NXCD = 8, WGM = 8;

__host__ __device__ __forceinline__ int lds_byte(int r, int c) { const int st = (r >> 4) * 2 + (c >> 5), rr = r & 15, cc = c & 31, ob = rr * 64 + cc * 2; return st * 1024 + (ob ^ (((ob >> 9) & 1) << 5)); }
__host__ __device__ __forceinline__ void stage_rc(int b, int& R, int& C) { const int st = b / 1024, sb = b % 1024, swz = sb ^ (((sb >> 9) & 1) << 5); R = (st >> 1) * 16 + swz / 64; C = (st & 1) * 32 + (swz % 64) / 2; }
__host__ __device__ __forceinline__ int perm32(int rho) { const int n = rho >> 4, i = rho & 15; return 8 * (i >> 2) + 4 * n + (i & 3); }

struct Unit { int pm, pn; };
struct Gemm { const bf16_t* A; const bf16_t* Bt; int M, N, K; int lda = 0; };

struct StaticOrder {
    int nM, nN, nwg, G, c;
    __host__ __device__ void init(int M, int N, int G_, int c_) { nM = M / BM; nN = N / BM; nwg = nM * nN; G = G_; c = c_; }
    __host__ __device__ bool next(int i, Unit& u) const {
        const long L = (long)i * G + c; if (L >= nwg) return false;
        int wgid = (int)L; { const int q = nwg / NXCD, r = nwg % NXCD, xcd = wgid % NXCD, off = wgid / NXCD; wgid = (xcd < r ? xcd * (q + 1) : r * (q + 1) + (xcd - r) * q) + off; }
        const int nig = WGM * nN, gid = wgid / nig, fm = gid * WGM, gsz = (nM - fm) < WGM ? (nM - fm) : WGM;
        u.pm = fm + ((wgid % nig) % gsz); u.pn = (wgid % nig) / gsz; return true;
    }
    __device__ __forceinline__ void a_ready(const Unit&) const {}
    __device__ __forceinline__ void done(const Unit&) const {}
};

template <class Epi, class Sched, bool ALIGN_EPI = false, bool SP2 = false>
__device__ __forceinline__ void gemm_phase(PG8_LAS unsigned char* lds, const Gemm g, const Sched& S, const Epi& E) {
    int tid_ = threadIdx.x; asm volatile("" : "+v"(tid_));
    const int tid = tid_, wid = __builtin_amdgcn_readfirstlane(tid >> 6), lane = tid & 63, wr = wid >> 2, wc = wid & 3, fr = lane & 15, fq = lane >> 4;
    const int K = g.K, nt = K / BK, LDA = g.lda ? g.lda : g.K;
    unsigned voffA[2], voffB[2];
#pragma unroll
    for (int i = 0; i < 2; ++i) { int R, C; stage_rc(tid * 16 + i * 8192, R, C); const int Rb = Epi::PERM ? ((R & ~31) + perm32(R & 31)) : R;
        voffA[i] = (unsigned)(R * LDA + C) * 2u; voffB[i] = (unsigned)(Rb * K + C) * 2u; }
    const size_t kstep = (size_t)(BK * 2);
    const size_t hstep = (size_t)HALF * K * 2;
    const size_t tstep = 2 * hstep;
    const size_t hstepA = (size_t)HALF * LDA * 2, tstepA = 2 * hstepA;
    const unsigned ldsw = (unsigned)wid * 1024u;
    const int aoff = lds_byte(wr * 64 + fr, fq * 8), boff = lds_byte(wc * 32 + fr, fq * 8);
#define PG8_SA(b, h) (((b) * 2 + (h)) * HTB)
#define PG8_SB(b, h) ((4 + (b) * 2 + (h)) * HTB)
#define PG8_STAGE(bufoff, gbase, voff) do { _Pragma("unroll") for (int _i = 0; _i < 2; ++_i) \
        __builtin_amdgcn_global_load_lds((const unsigned*)((const char*)(gbase) + (voff)[_i]), (PG8_LAS unsigned*)(lds + (bufoff) + ldsw + _i * 8192), 16, 0, 0); } while (0)
#define PG8_LDA(dst, b, h) do { _Pragma("unroll") for (int m = 0; m < 4; ++m) _Pragma("unroll") for (int k = 0; k < 2; ++k) dst[m][k] = *(const PG8_LAS bf16x8*)(lds + PG8_SA(b, h) + aoff + m * 2048 + k * 1024); } while (0)
#define PG8_LDB(dst, b, h) do { _Pragma("unroll") for (int n = 0; n < 2; ++n) _Pragma("unroll") for (int k = 0; k < 2; ++k) dst[n][k] = *(const PG8_LAS bf16x8*)(lds + PG8_SB(b, h) + boff + n * 2048 + k * 1024); } while (0)
#define PG8_MMA(ai, bj, At, Bt) do { __builtin_amdgcn_s_setprio(1); _Pragma("unroll") for (int m = 0; m < 4; ++m) _Pragma("unroll") for (int n = 0; n < 2; ++n) _Pragma("unroll") for (int k = 0; k < 2; ++k) \
        acc[ai][bj][m][n] = __builtin_amdgcn_mfma_f32_16x16x32_bf16(Bt[n][k], At[m][k], acc[ai][bj][m][n], 0, 0, 0); __builtin_amdgcn_s_setprio(0); } while (0)
#define PG8_WAIT_V(n) asm volatile("s_waitcnt vmcnt(" #n ")" ::: "memory")
#define PG8_WAIT_L(n) asm volatile("s_waitcnt lgkmcnt(" #n ")" ::: "memory")
#define PG8_BAR __builtin_amdgcn_s_barrier()
#define PG8_SCHED __builtin_amdgcn_sched_barrier(0)
    Unit cur, nxt; int ui = 0;
    if (!S.next(0, cur)) return;
    f32x4 acc[2][2][4][2];
#pragma unroll
    for (int a = 0; a < 2; ++a)
#pragma unroll
        for (int b = 0; b < 2; ++b)
#pragma unroll
            for (int m = 0; m < 4; ++m)
#pragma unroll
                for (int n = 0; n < 2; ++n) acc[a][b][m][n] = (f32x4){0.f, 0.f, 0.f, 0.f};
    bf16x8 At[4][2], B0[2][2], B1[2][2];
    const char* cA = (const char*)g.A + (size_t)cur.pm * tstepA; const char* cB = (const char*)g.Bt + (size_t)cur.pn * tstep;
    S.a_ready(cur);
    if constexpr (SP2) {
        PG8_STAGE(PG8_SB(0, 0), cB, voffB); PG8_STAGE(PG8_SB(0, 1), cB + hstep, voffB); PG8_STAGE(PG8_SA(0, 0), cA, voffA); PG8_STAGE(PG8_SA(0, 1), cA + hstepA, voffA);
        if (wr == 1) PG8_BAR;
        PG8_WAIT_V(2); PG8_BAR;
        PG8_STAGE(PG8_SB(1, 0), cB + kstep, voffB); PG8_STAGE(PG8_SA(1, 0), cA + kstep, voffA); PG8_STAGE(PG8_SB(1, 1), cB + hstep + kstep, voffB);
        PG8_WAIT_V(6); PG8_BAR;
    } else {
        PG8_STAGE(PG8_SB(0, 0), cB, voffB); PG8_STAGE(PG8_SA(0, 0), cA, voffA); PG8_STAGE(PG8_SB(0, 1), cB + hstep, voffB); PG8_STAGE(PG8_SA(0, 1), cA + hstepA, voffA);
        if (wr == 1) PG8_BAR;
        PG8_WAIT_V(4); PG8_BAR;
        PG8_STAGE(PG8_SB(1, 0), cB + kstep, voffB); PG8_STAGE(PG8_SA(1, 0), cA + kstep, voffA); PG8_STAGE(PG8_SB(1, 1), cB + hstep + kstep, voffB);
        PG8_WAIT_V(6); PG8_BAR;
    }
    for (;;) {
        const bool has_next = S.next(ui + 1, nxt);
        const char* nA = has_next ? (const char*)g.A + (size_t)nxt.pm * tstepA : cA; const char* nB = has_next ? (const char*)g.Bt + (size_t)nxt.pn * tstep : cB;
        for (int t = 0; t < nt; t += 2) {
            const bool last = (t == nt - 2);
            const char* a1 = cA + (size_t)(t + 1) * kstep;
            const char* a2 = last ? nA : cA + (size_t)(t + 2) * kstep; const char* b2 = last ? nB : cB + (size_t)(t + 2) * kstep;
            const char* a3 = a2 + kstep; const char* b3 = b2 + kstep;
            if (last && has_next) S.a_ready(nxt);
            if constexpr (SP2) {
            PG8_LDB(B0, 0, 0); PG8_LDB(B1, 0, 1); PG8_SCHED; PG8_LDA(At, 0, 0); PG8_STAGE(PG8_SA(1, 1), a1 + hstepA, voffA);
            PG8_WAIT_V(8); PG8_WAIT_L(0); PG8_BAR; PG8_MMA(0, 0, At, B0); PG8_MMA(0, 1, At, B1); PG8_BAR; PG8_SCHED;
            PG8_LDA(At, 0, 1); PG8_STAGE(PG8_SB(0, 0), b2, voffB); PG8_STAGE(PG8_SB(0, 1), b2 + hstep, voffB); PG8_STAGE(PG8_SA(0, 0), a2, voffA);
            PG8_WAIT_V(8); PG8_WAIT_L(0); PG8_BAR; PG8_MMA(1, 0, At, B0); PG8_MMA(1, 1, At, B1); PG8_BAR; PG8_SCHED;
            PG8_LDB(B0, 1, 0); PG8_LDB(B1, 1, 1); PG8_SCHED; PG8_LDA(At, 1, 0); PG8_STAGE(PG8_SA(0, 1), a2 + hstepA, voffA);
            PG8_WAIT_V(8); PG8_WAIT_L(0); PG8_BAR; PG8_MMA(0, 0, At, B0); PG8_MMA(0, 1, At, B1); PG8_BAR; PG8_SCHED;
            PG8_LDA(At, 1, 1); PG8_STAGE(PG8_SB(1, 0), b3, voffB); PG8_STAGE(PG8_SB(1, 1), b3 + hstep, voffB); PG8_STAGE(PG8_SA(1, 0), a3, voffA);
            PG8_WAIT_V(8); PG8_WAIT_L(0); PG8_BAR; PG8_MMA(1, 0, At, B0); PG8_MMA(1, 1, At, B1); PG8_BAR; PG8_SCHED;
            } else {
            PG8_LDB(B0, 0, 0); PG8_SCHED; PG8_LDA(At, 0, 0); PG8_STAGE(PG8_SA(1, 1), a1 + hstepA, voffA);
            PG8_WAIT_L(8); PG8_BAR; PG8_WAIT_L(0); PG8_MMA(0, 0, At, B0); PG8_BAR; PG8_SCHED;
            PG8_LDB(B1, 0, 1); PG8_STAGE(PG8_SB(0, 0), b2, voffB);
            PG8_BAR; PG8_WAIT_L(0); PG8_MMA(0, 1, At, B1); PG8_BAR;
            PG8_LDA(At, 0, 1); PG8_STAGE(PG8_SA(0, 0), a2, voffA);
            PG8_BAR; PG8_WAIT_L(0); PG8_MMA(1, 0, At, B0); PG8_BAR; PG8_SCHED;
            PG8_STAGE(PG8_SB(0, 1), b2 + hstep, voffB);
            PG8_WAIT_V(6); PG8_BAR; PG8_MMA(1, 1, At, B1); PG8_BAR;
            PG8_LDB(B0, 1, 0); PG8_SCHED; PG8_LDA(At, 1, 0); PG8_STAGE(PG8_SA(0, 1), a2 + hstepA, voffA);
            PG8_WAIT_L(8); PG8_BAR; PG8_WAIT_L(0); PG8_MMA(0, 0, At, B0); PG8_BAR; PG8_SCHED;
            PG8_LDB(B1, 1, 1); PG8_STAGE(PG8_SB(1, 0), b3, voffB);
            PG8_BAR; PG8_WAIT_L(0); PG8_MMA(0, 1, At, B1); PG8_BAR;
            PG8_LDA(At, 1, 1); PG8_STAGE(PG8_SA(1, 0), a3, voffA);
            PG8_BAR; PG8_WAIT_L(0); PG8_MMA(1, 0, At, B0); PG8_BAR; PG8_SCHED;
            PG8_STAGE(PG8_SB(1, 1), b3 + hstep, voffB);
            PG8_WAIT_V(6); PG8_BAR; PG8_MMA(1, 1, At, B1); PG8_BAR;
            }
        }
        if constexpr (ALIGN_EPI) { if (wr == 0) PG8_BAR; }
        if constexpr (!Epi::AFTER_DRAIN) { E(acc, cur, wr, wc, fr, fq); S.done(cur); }
        if (!has_next) break;
#pragma unroll
        for (int a = 0; a < 2; ++a)
#pragma unroll
            for (int b = 0; b < 2; ++b)
#pragma unroll
                for (int m = 0; m < 4; ++m)
#pragma unroll
                    for (int n = 0; n < 2; ++n) acc[a][b][m][n] = (f32x4){0.f, 0.f, 0.f, 0.f};
        cur = nxt; cA = nA; cB = nB; ++ui;
        if constexpr (ALIGN_EPI) { if (wr == 1) PG8_BAR; }
    }
    PG8_WAIT_V(0);
    if constexpr (!ALIGN_EPI) { if (wr == 0) PG8_BAR; }
    PG8_BAR;
    if constexpr (Epi::AFTER_DRAIN) { E.fused(acc, cur, wr, wc, fr, fq, lds, wid, lane); S.done(cur); }
#undef PG8_SA
#undef PG8_SB
#undef PG8_STAGE
#undef PG8_LDA
#undef PG8_LDB
#undef PG8_MMA
#undef PG8_WAIT_V
#undef PG8_WAIT_L
#undef PG8_BAR
#undef PG8_SCHED
}
}

constexpr int NB = 32, T_ = 2048, DM = 1024, NTOK = NB * T_;
constexpr int NLAYER = 2;
constexpr int CIN = 10032, CPAD = 10240;
constexpr int FFH_ = 2816;
constexpr int NBC = 8, MC = NBC * T_, NCHUNK = NB / NBC;
constexpr int PC_QR = 0, PC_KR = 1024, PC_VR = 2048, PC_GR = 4096, PC_QN = 6144, PC_KV = 7168, PC_MA = 7936, PC_MB = 8960, PC_GATE = 9984;
constexpr int NCMP = 127, NCMP_PAD = 128;
constexpr float LOG2E = 1.4426950408889634f;
constexpr float QSCALE = 0.125f * LOG2E;

constexpr size_t MiB = 1u << 20;
constexpr size_t WS_CTL = 0, CTL_ZERO_BYTES = 1 * MiB;
constexpr size_t WS_ROT = 1 * MiB;
constexpr size_t WS_T5 = 3 * MiB;
constexpr size_t WS_CB = 3 * MiB + 64 * 1024;
constexpr size_t WS_WIN = 4 * MiB;
constexpr size_t WS_WORET = 44 * MiB;
constexpr size_t WS_WONSA = 52 * MiB;
constexpr size_t WS_WOUT = 56 * MiB;
constexpr size_t WS_WFFI = 60 * MiB;
constexpr size_t WS_WFFO = 82 * MiB;
constexpr size_t WS_WC1 = 93 * MiB;
constexpr size_t WS_WC2 = 97 * MiB;
constexpr size_t WS_H = 100 * MiB;
constexpr size_t WS_BIG = 228 * MiB;
constexpr size_t WS_ORET = 580 * MiB;
constexpr size_t WS_ON = 644 * MiB;
constexpr size_t WS_TMP = 676 * MiB;
constexpr size_t WS_MERGED = 708 * MiB;
constexpr size_t WS_KC = 740 * MiB;
constexpr size_t WS_GNS = 741 * MiB;
constexpr size_t WS_ONF = 746 * MiB;
constexpr size_t WS_XC = 810 * MiB;
constexpr size_t WS_HID = 819 * MiB;
constexpr size_t WS_END = 822 * MiB;
constexpr int CW_TMO = 0, CW_BAR = 4096, CW_Q = 16384;

constexpr int NWAVES = 8;
constexpr int RING_BYTES = 131072, LDSCTL_OFF = RING_BYTES, MISC_OFF = LDSCTL_OFF + 320, LDS_BYTES = 147456;

typedef pg8::bf16_t bf16;
typedef float f32x4 __attribute__((ext_vector_type(4)));
typedef float f32x2 __attribute__((ext_vector_type(2)));
typedef unsigned u32x4 __attribute__((ext_vector_type(4)));
typedef unsigned u32x2 __attribute__((ext_vector_type(2)));
#define LAS __attribute__((address_space(3)))
#define GAS __attribute__((address_space(1)))
#define RLX_AGENT __ATOMIC_RELAXED, __HIP_MEMORY_SCOPE_AGENT
#define LDS_WAIT() asm volatile("s_waitcnt lgkmcnt(0)" ::: "memory")
#define VM_WAIT() asm volatile("s_waitcnt vmcnt(0)" ::: "memory")
typedef GAS unsigned gu32;

__device__ __forceinline__ unsigned f2bf(float f) { unsigned u = __builtin_bit_cast(unsigned, f); return (u + 0x7fffu + ((u >> 16) & 1u)) >> 16; }
__device__ __forceinline__ unsigned pk2(float lo, float hi) { return f2bf(lo) | (f2bf(hi) << 16); }
__device__ __forceinline__ float bf2f(unsigned short h) { return __builtin_bit_cast(float, (unsigned)h << 16); }
__device__ __forceinline__ float bflo(unsigned w) { return __builtin_bit_cast(float, w << 16); }
__device__ __forceinline__ float bfhi(unsigned w) { return __builtin_bit_cast(float, w & 0xffff0000u); }
__device__ __forceinline__ float sigm(float x) { return 1.f / (1.f + __expf(-x)); }
__device__ __forceinline__ float silu(float x) { return x / (1.f + __expf(-x)); }
__device__ __forceinline__ float shx(float v, int m, int lane) { return __builtin_bit_cast(float, __builtin_amdgcn_ds_bpermute((lane ^ m) << 2, __builtin_bit_cast(int, v))); }
__device__ __forceinline__ float wave_sum(float v, int lane) {
#pragma unroll
    for (int o = 1; o < 64; o <<= 1) v += shx(v, o, lane);
    return v;
}
__device__ __forceinline__ float wave_max(float v, int lane) {
#pragma unroll
    for (int o = 1; o < 64; o <<= 1) v = fmaxf(v, shx(v, o, lane));
    return v;
}

__device__ __forceinline__ float gelu_tanh_f(float x) { const float u = 0.7978845608028654f * (x + 0.044715f * x * x * x); const float e = __expf(2.f * u); return x * (1.f - 1.f / (e + 1.f)); }
namespace epi {
using pg8::Unit;
__device__ __forceinline__ u32x4 pack8(const f32x4 a, const f32x4 b) { u32x4 w; w.x = pk2(a[0], a[1]); w.y = pk2(a[2], a[3]); w.z = pk2(b[0], b[1]); w.w = pk2(b[2], b[3]); return w; }
__device__ __forceinline__ void unpack8(const u32x4 w, f32x4& a, f32x4& b) { a = (f32x4){bflo(w.x), bfhi(w.x), bflo(w.y), bfhi(w.y)}; b = (f32x4){bflo(w.z), bfhi(w.z), bflo(w.w), bfhi(w.w)}; }

struct EpiInProj {
    static constexpr bool PERM = true, AFTER_DRAIN = false;
    bf16* O; const float* rot; bf16* XC;
    __device__ __forceinline__ void operator()(const f32x4 (&acc)[2][2][4][2], const Unit& u, int wr, int wc, int fr, int fq) const {
        const int pn = u.pn, row0 = u.pm * 256 + wr * 64 + fr, colw = wc * 32 + 8 * fq;
        bf16* base = O + (size_t)row0 * CPAD + pn * 256 + colw;
        if (pn < 8) {
            const float sc = pn >= 4 ? 0.0625f : 1.f;
#pragma unroll
            for (int ai = 0; ai < 2; ++ai)
#pragma unroll
                for (int m = 0; m < 4; ++m) {
                    const int row = row0 + ai * 128 + m * 16, pos = row & (T_ - 1);
                    const float* cp = rot + (size_t)pos * 128 + colw; const float* sp = cp + T_ * 128;
                    f32x4 y1[2], y2[2];
#pragma unroll
                    for (int n = 0; n < 2; ++n) { const f32x4 c = *(const f32x4*)(cp + 4 * n), s = *(const f32x4*)(sp + 4 * n); const f32x4 x1 = acc[ai][0][m][n], x2 = acc[ai][1][m][n];
                        y1[n] = (x1 * c - x2 * s) * sc; y2[n] = (x1 * s + x2 * c) * sc; }
                    bf16* rp = base + (size_t)(ai * 128 + m * 16) * CPAD;
                    *(u32x4*)(rp) = pack8(y1[0], y1[1]); *(u32x4*)(rp + 128) = pack8(y2[0], y2[1]);
                }
        } else if (pn == 28) {
            const int g2 = wc >> 1, d0 = (wc & 1) * 32 + 8 * fq;
#pragma unroll
            for (int ai = 0; ai < 2; ++ai)
#pragma unroll
                for (int m = 0; m < 4; ++m) { const int row = row0 + ai * 128 + m * 16, bb = row >> 11, t = row & (T_ - 1);
#pragma unroll
                    for (int bj = 0; bj < 2; ++bj) *(u32x4*)(XC + ((size_t)((bj * NBC + bb) * 2 + g2) * T_ + t) * 64 + d0) = pack8(acc[ai][bj][m][0], acc[ai][bj][m][1]); }
        } else {
            const int mode = (pn >= 16 && pn < 24) ? 1 : (pn >= 24 && pn < 28) ? 2 : (pn >= 31) ? 3 : 0;
#pragma unroll
            for (int ai = 0; ai < 2; ++ai)
#pragma unroll
                for (int m = 0; m < 4; ++m) { bf16* rp = base + (size_t)(ai * 128 + m * 16) * CPAD;
#pragma unroll
                    for (int bj = 0; bj < 2; ++bj) { f32x4 v0 = acc[ai][bj][m][0], v1 = acc[ai][bj][m][1];
                        if (mode == 1) {
#pragma unroll
                            for (int i = 0; i < 4; ++i) { v0[i] = silu(v0[i]); v1[i] = silu(v1[i]); } }
                        else if (mode == 2) { v0 = v0 * QSCALE; v1 = v1 * QSCALE; }
                        else if (mode == 3) {
#pragma unroll
                            for (int i = 0; i < 4; ++i) { v0[i] = sigm(v0[i]); v1[i] = sigm(v1[i]); } }
                        *(u32x4*)(rp + bj * 128) = pack8(v0, v1); } }
        }
    }
};
template <bool ADD> struct EpiGate {
    static constexpr bool PERM = true, AFTER_DRAIN = false;
    bf16* O; const bf16* P; const bf16* G; int ldo, ldg;
    __device__ __forceinline__ void operator()(const f32x4 (&acc)[2][2][4][2], const Unit& u, int wr, int wc, int fr, int fq) const {
        const int row0 = u.pm * 256 + wr * 64 + fr, col0 = u.pn * 256 + wc * 32 + 8 * fq;
#pragma unroll
        for (int ai = 0; ai < 2; ++ai)
#pragma unroll
            for (int m = 0; m < 4; ++m) { const size_t r = (size_t)(row0 + ai * 128 + m * 16);
#pragma unroll
                for (int bj = 0; bj < 2; ++bj) { const int c = col0 + bj * 128;
                    f32x4 g0, g1; unpack8(*(const u32x4*)(G + r * ldg + c), g0, g1);
                    f32x4 v0 = acc[ai][bj][m][0] * g0, v1 = acc[ai][bj][m][1] * g1;
                    if (ADD) { f32x4 p0, p1; unpack8(*(const u32x4*)(P + r * ldo + c), p0, p1); v0 += p0; v1 += p1; }
                    *(u32x4*)(O + r * ldo + c) = pack8(v0, v1); } }
    }
};
struct EpiResid {
    static constexpr bool PERM = false, AFTER_DRAIN = false;
    const float* src; float* out;
    __device__ __forceinline__ void operator()(const f32x4 (&acc)[2][2][4][2], const Unit& u, int wr, int wc, int fr, int fq) const {
        const int row0 = u.pm * 256 + wr * 64 + fr, col0 = u.pn * 256 + wc * 32 + 4 * fq;
#pragma unroll
        for (int ai = 0; ai < 2; ++ai)
#pragma unroll
            for (int m = 0; m < 4; ++m) { const size_t off = (size_t)(row0 + ai * 128 + m * 16) * DM + col0;
#pragma unroll
                for (int bj = 0; bj < 2; ++bj)
#pragma unroll
                    for (int n = 0; n < 2; ++n) { const f32x4 s = *(const f32x4*)(src + off + bj * 128 + n * 16); *(f32x4*)(out + off + bj * 128 + n * 16) = s + acc[ai][bj][m][n]; } }
    }
};
struct EpiSwiGlu {
    static constexpr bool PERM = true, AFTER_DRAIN = false;
    bf16* O;
    __device__ __forceinline__ void operator()(const f32x4 (&acc)[2][2][4][2], const Unit& u, int wr, int wc, int fr, int fq) const {
        const int row0 = u.pm * 256 + wr * 64 + fr, col0 = u.pn * 128 + wc * 32 + 8 * fq;
#pragma unroll
        for (int ai = 0; ai < 2; ++ai)
#pragma unroll
            for (int m = 0; m < 4; ++m) { f32x4 v[2];
#pragma unroll
                for (int n = 0; n < 2; ++n) { const f32x4 a = acc[ai][0][m][n], b = acc[ai][1][m][n];
#pragma unroll
                    for (int i = 0; i < 4; ++i) v[n][i] = silu(a[i]) * b[i]; }
                *(u32x4*)(O + (size_t)(row0 + ai * 128 + m * 16) * FFH_ + col0) = pack8(v[0], v[1]); }
    }
};
struct EpiCmp {
    static constexpr bool PERM = true, AFTER_DRAIN = false;
    bf16* HID; const float* cb;
    __device__ __forceinline__ void operator()(const f32x4 (&acc)[2][2][4][2], const Unit& u, int wr, int wc, int fr, int fq) const {
        const int kv = u.pn; if ((u.pm >> 3) != kv) return;
        const int row0 = (u.pm & 7) * 256 + wr * 64 + fr, col0 = wc * 32 + 8 * fq;
#pragma unroll
        for (int bj = 0; bj < 2; ++bj) { const f32x4 b0 = *(const f32x4*)(cb + kv * 256 + col0 + bj * 128), b1 = *(const f32x4*)(cb + kv * 256 + col0 + bj * 128 + 4);
#pragma unroll
            for (int ai = 0; ai < 2; ++ai)
#pragma unroll
                for (int m = 0; m < 4; ++m) { f32x4 v0 = acc[ai][bj][m][0] + b0, v1 = acc[ai][bj][m][1] + b1;
#pragma unroll
                    for (int i = 0; i < 4; ++i) { v0[i] = gelu_tanh_f(v0[i]); v1[i] = gelu_tanh_f(v1[i]); }
                    *(u32x4*)(HID + ((size_t)kv * 2048 + row0 + ai * 128 + m * 16) * 256 + col0 + bj * 128) = pack8(v0, v1); } }
    }
};
}
#define XB_TMO      128
#define XB_XCNT(j)  (256  + 64 * (j))
#define XB_XSUB(j)  (1280 + 64 * (j))
#define XB_XGEN(j)  (2304 + 64 * (j))
#define XB_TOP      3328
#define XB_TOPGEN   3392
#define XCD_BAR_WORDS 3456
#define XB_SPIN_CAP (1u << 18)

__device__ __forceinline__ unsigned xb_ld(unsigned* p)              { return __hip_atomic_load(p, __ATOMIC_RELAXED, __HIP_MEMORY_SCOPE_AGENT); }
__device__ __forceinline__ unsigned xb_add(unsigned* p, unsigned v) { return __hip_atomic_fetch_add(p, v, __ATOMIC_RELAXED, __HIP_MEMORY_SCOPE_AGENT); }
__device__ __forceinline__ unsigned xb_xcc_id() { return (unsigned)__builtin_amdgcn_s_getreg((3 << 11) | 20) & 0xFu; }
#define XB_SPIN(cond, bar) do { unsigned _sp = 0; while (cond) { __builtin_amdgcn_s_sleep(1); \
    if ((++_sp & 255u) == 0u) { if (xb_ld(&(bar)[XB_TMO])) break; if (_sp > XB_SPIN_CAP) { atomicAdd(&(bar)[XB_TMO], 1u); break; } } } } while (0)

struct XcdBarrier {
    unsigned* bar; unsigned x;
    volatile LAS unsigned* st;
};

__device__ __forceinline__ XcdBarrier xcd_barrier_post(unsigned* bar, volatile LAS unsigned* st) {
    XcdBarrier b; b.bar = bar; b.x = xb_xcc_id(); b.st = st;
    if (threadIdx.x == 0) (void)xb_add(&bar[XB_XCNT(b.x)], 1u);
    return b;
}
__device__ __forceinline__ void xcd_barrier_complete(unsigned* bar, unsigned x, unsigned& nloc, unsigned& nx) {
    const unsigned G = gridDim.x * gridDim.y * gridDim.z;
    unsigned sum, cnt, mine, sp = 0u;
    for (;;) {
        sum = 0u; cnt = 0u; mine = 0u;
#pragma unroll
        for (unsigned j = 0; j < 16; ++j) { const unsigned c = xb_ld(&bar[XB_XCNT(j)]); sum += c; cnt += (c > 0u) ? 1u : 0u; mine = (j == x) ? c : mine; }
        if (sum == G) break;
        __builtin_amdgcn_s_sleep(1);
        if ((++sp & 255u) == 0u) { if (xb_ld(&bar[XB_TMO])) break; if (sp > XB_SPIN_CAP) { atomicAdd(&bar[XB_TMO], 1u); break; } }
    }
    nloc = mine > 0u ? mine : 1u; nx = cnt > 0u ? cnt : 1u;
}

__device__ __forceinline__ void xcd_barrier(const XcdBarrier& b) {
    asm volatile("s_waitcnt vmcnt(0)" ::: "memory");
    __syncthreads();
    if (threadIdx.x == 0) {
        unsigned* bar = b.bar;
        __builtin_amdgcn_s_waitcnt(0);
        unsigned nloc = b.st[0], nx = b.st[1];
        if (nloc == 0u) { xcd_barrier_complete(bar, b.x, nloc, nx); b.st[0] = nloc; b.st[1] = nx; }
        const unsigned old = xb_add(&bar[XB_XSUB(b.x)], 1u);
        const unsigned gen = old / nloc;
        if (old + 1u == (gen + 1u) * nloc) {
            __builtin_amdgcn_fence(__ATOMIC_RELEASE, "agent");
            asm volatile("s_waitcnt vmcnt(0)" ::: "memory");
            const unsigned og = xb_add(&bar[XB_TOP], 1u);
            const unsigned tg = og / nx;
            if (og + 1u == (tg + 1u) * nx) xb_add(&bar[XB_TOPGEN], 1u);
            else XB_SPIN(xb_ld(&bar[XB_TOPGEN]) == tg, bar);
            __builtin_amdgcn_fence(__ATOMIC_ACQUIRE, "agent");
            xb_add(&bar[XB_XGEN(b.x)], 1u);
            asm volatile("s_waitcnt vmcnt(0)" ::: "memory");
        } else {
            XB_SPIN(xb_ld(&bar[XB_XGEN(b.x)]) == gen, bar);
            __builtin_amdgcn_fence(__ATOMIC_ACQUIRE, "agent");
            asm volatile("s_waitcnt vmcnt(0)" ::: "memory");
        }
    }
    __syncthreads();
}

struct Args { const float* in[17]; float* out; unsigned char* ws; int it_lo, it_hi, ph_lo, ph_hi, flags, pad; };

struct Ctx { LAS unsigned char* lds; int tid, lane, wave, G, bid; };

template <class Map>
__device__ __forceinline__ void p0_transpose_item(const float* W, int K, int Nsrc, bf16* WT, int ngrp, LAS float* scr, int item, int lane, const Map& map) {
    const int kb = item / ngrp, nb = item % ngrp, k0 = 64 * kb, n0 = 32 * nb;
    const int sc = map(n0 + (lane & 31));
#pragma unroll 8
    for (int i = 0; i < 32; ++i) { const int kk = 2 * i + (lane >> 5); scr[kk * 33 + (lane & 31)] = sc >= 0 ? W[(size_t)(k0 + kk) * Nsrc + sc] : 0.f; }
    LDS_WAIT(); asm volatile("" ::: "memory");
    const int c = lane & 7;
#pragma unroll
    for (int j = 0; j < 4; ++j) { const int n = (lane >> 3) + 8 * j; const LAS float* s = scr + (8 * c) * 33 + n;
        u32x4 o; o.x = pk2(s[0 * 33], s[1 * 33]); o.y = pk2(s[2 * 33], s[3 * 33]); o.z = pk2(s[4 * 33], s[5 * 33]); o.w = pk2(s[6 * 33], s[7 * 33]);
        *(u32x4*)(WT + (size_t)(n0 + n) * K + k0 + 8 * c) = o; }
    LDS_WAIT(); asm volatile("" ::: "memory");
}
struct MapId { __device__ __forceinline__ int operator()(int n) const { return n; } };
struct MapWin { __device__ __forceinline__ int operator()(int n) const { return n < 7936 ? n : (n < 9984 ? n + 48 : (n < 10032 ? n - 2048 : -1)); } };
struct MapFfi { __device__ __forceinline__ int operator()(int n) const { const int pn = n >> 8, j = n & 255; return j < 128 ? 128 * pn + j : FFH_ + 128 * pn + (j - 128); } };

__device__ __forceinline__ void p0_prologue(const Ctx& C, const Args& a) {
    unsigned char* ws = a.ws;
    LAS float* scr = (LAS float*)(C.lds + C.wave * 16384);
    const int gw = C.bid * NWAVES + C.wave, NGW = C.G * NWAVES;
    constexpr int I_IN = 16 * 320, I_OR = 32 * 32, I_ON = 16 * 32, I_OUT = 16 * 32, I_FI = 16 * 176, I_FO = 44 * 32, I_C1 = 32 * 8, I_L = I_IN + I_OR + I_ON + I_OUT + I_FI + I_FO + 2 * I_C1;
    for (int it = gw; it < NLAYER * I_L; it += NGW) {
        const int L = it / I_L; int r = it % I_L;
        if (r < I_IN) { p0_transpose_item(a.in[2] + (size_t)L * DM * CIN, DM, CIN, (bf16*)(ws + WS_WIN) + (size_t)L * CPAD * DM, 320, scr, r, C.lane, MapWin()); continue; } r -= I_IN;
        if (r < I_OR) { p0_transpose_item(a.in[9] + (size_t)L * 2048 * DM, 2048, DM, (bf16*)(ws + WS_WORET) + (size_t)L * DM * 2048, 32, scr, r, C.lane, MapId()); continue; } r -= I_OR;
        if (r < I_ON) { p0_transpose_item(a.in[10] + (size_t)L * DM * DM, DM, DM, (bf16*)(ws + WS_WONSA) + (size_t)L * DM * DM, 32, scr, r, C.lane, MapId()); continue; } r -= I_ON;
        if (r < I_OUT) { p0_transpose_item(a.in[11] + (size_t)L * DM * DM, DM, DM, (bf16*)(ws + WS_WOUT) + (size_t)L * DM * DM, 32, scr, r, C.lane, MapId()); continue; } r -= I_OUT;
        if (r < I_FI) { p0_transpose_item(a.in[13] + (size_t)L * DM * 2 * FFH_, DM, 2 * FFH_, (bf16*)(ws + WS_WFFI) + (size_t)L * 2 * FFH_ * DM, 176, scr, r, C.lane, MapFfi()); continue; } r -= I_FI;
        if (r < I_FO) { p0_transpose_item(a.in[14] + (size_t)L * FFH_ * DM, FFH_, DM, (bf16*)(ws + WS_WFFO) + (size_t)L * DM * FFH_, 32, scr, r, C.lane, MapId()); continue; } r -= I_FO;
        if (r < I_C1) { p0_transpose_item(a.in[5] + (size_t)L * 2048 * 256, 2048, 256, (bf16*)(ws + WS_WC1) + (size_t)(L * 2 + 0) * 256 * 2048, 8, scr, r, C.lane, MapId()); continue; } r -= I_C1;
        p0_transpose_item(a.in[7] + (size_t)L * 2048 * 256, 2048, 256, (bf16*)(ws + WS_WC1) + (size_t)(L * 2 + 1) * 256 * 2048, 8, scr, r, C.lane, MapId());
    }
    const int gt = C.bid * 512 + C.tid, NGT = C.G * 512;
    float* rot = (float*)(ws + WS_ROT);
    for (int i = gt; i < T_ * 128; i += NGT) { const int pos = i >> 7, d = i & 127; const double f = pow(10000.0, -(double)d / 128.0), ang = (double)pos * f; rot[i] = (float)cos(ang); rot[T_ * 128 + i] = (float)sin(ang); }
    float* cbp = (float*)(ws + WS_CB);
    for (int i = gt; i < NLAYER * 2 * 256; i += NGT) { const int hid = i & 255, kv = (i >> 8) & 1, L = i >> 9; const float* pe = (kv ? a.in[4] : a.in[3]) + L * 2048; const float* w1 = (kv ? a.in[7] : a.in[5]) + (size_t)L * 2048 * 256 + hid;
        float s_ = 0.f; for (int k = 0; k < 2048; ++k) s_ += pe[k] * w1[(size_t)k * 256]; cbp[i] = s_; }
    float* t5 = (float*)(ws + WS_T5);
    for (int i = gt; i < 16 * 128; i += NGT) { const int hd = i >> 7, dist = i & 127; int bk = dist;
        if (dist >= 16) { bk = 16 + (int)(log((double)dist / 16.0) / log(8.0) * 16.0); if (bk > 31) bk = 31; }
        t5[i] = a.in[15][bk * 16 + hd] * LOG2E; }
}

__device__ __forceinline__ void rms_row_to_bf16(const float* xrow, const float* g, bf16* orow, int lane) {
    const f32x4* xr = (const f32x4*)xrow + lane; const f32x4* gr = (const f32x4*)g + lane;
    f32x4 v[4]; float s = 0.f;
#pragma unroll
    for (int j = 0; j < 4; ++j) { v[j] = xr[64 * j]; s += (v[j].x * v[j].x + v[j].y * v[j].y) + (v[j].z * v[j].z + v[j].w * v[j].w); }
    const float r = 1.f / sqrtf(wave_sum(s, lane) * (1.f / DM) + 1e-6f);
    u32x2* o8 = (u32x2*)orow + lane;
#pragma unroll
    for (int j = 0; j < 4; ++j) { const f32x4 gg = gr[64 * j]; u32x2 w; w.x = pk2(v[j].x * r * gg.x, v[j].y * r * gg.y); w.y = pk2(v[j].z * r * gg.z, v[j].w * r * gg.w); o8[64 * j] = w; }
}
__device__ __forceinline__ void rms_row_f32(float* xrow, const float* g, int lane) {
    f32x4* xr = (f32x4*)xrow + lane; const f32x4* gr = (const f32x4*)g + lane;
    f32x4 v[4]; float s = 0.f;
#pragma unroll
    for (int j = 0; j < 4; ++j) { v[j] = xr[64 * j]; s += (v[j].x * v[j].x + v[j].y * v[j].y) + (v[j].z * v[j].z + v[j].w * v[j].w); }
    const float r = 1.f / sqrtf(wave_sum(s, lane) * (1.f / DM) + 1e-6f);
#pragma unroll
    for (int j = 0; j < 4; ++j) xr[64 * j] = v[j] * r * gr[64 * j];
}

__device__ __forceinline__ float dot8(const u32x4 w, const LAS float* q) {
    return bflo(w.x) * q[0] + bfhi(w.x) * q[1] + bflo(w.y) * q[2] + bfhi(w.y) * q[3] + bflo(w.z) * q[4] + bfhi(w.z) * q[5] + bflo(w.w) * q[6] + bfhi(w.w) * q[7];
}
__device__ __forceinline__ float gelu_tanh(float x) { const float u = 0.7978845608028654f * (x + 0.044715f * x * x * x); return 0.5f * x * (1.f + tanhf(u)); }

__device__ __forceinline__ void compress_naive_unit(const Ctx& C, int u, const bf16* PROJ, const float* pos, const float* w1, const float* w2, bf16* KCV) {
    const int n = u % NCMP, g = (u / NCMP) & 1, b = (u / (2 * NCMP)) % NBC, kv = u / (2 * NCMP * NBC);
    LAS float* xin = (LAS float*)C.lds; LAS float* part = xin + 2048; LAS float* hid = part + 512;
    const float* pe = pos;
    for (int i = C.tid; i < 2048; i += 512) { const int l = i >> 6, d = i & 63;
        xin[i] = bf2f(PROJ[(size_t)(b * T_ + n * 16 + l) * CPAD + PC_KV + kv * 128 + g * 64 + d]) + pe[i]; }
    __syncthreads();
    { const int j = C.tid & 255, half = C.tid >> 8; float s = 0.f; const float* wp = w1 + (size_t)(half * 1024) * 256 + j; const LAS float* xp = xin + half * 1024;
      for (int i = 0; i < 1024; ++i) s += xp[i] * wp[(size_t)i * 256];
      part[half * 256 + j] = s; }
    __syncthreads();
    if (C.tid < 256) hid[C.tid] = gelu_tanh(part[C.tid] + part[256 + C.tid]);
    __syncthreads();
    if (C.tid < 64) { float s = 0.f; for (int j = 0; j < 256; ++j) s += hid[j] * w2[j * 64 + C.tid];
        bf16* o = KCV + ((size_t)((kv * NBC + b) * 2 + g) * NCMP_PAD) * 64;
        o[n * 64 + C.tid] = (bf16)f2bf(s); if (n == 0) o[127 * 64 + C.tid] = 0; }
    __syncthreads();
}

__device__ __forceinline__ void ret_naive_unit(const Ctx& C, int u, const bf16* PROJ, bf16* ORET) {
    const int tq = u & 255, h = (u >> 8) & 3, b = u >> 10, t = tq * 8 + C.wave, lane = C.lane;
    const size_t tok0 = (size_t)b * T_;
    LAS float* qs = (LAS float*)C.lds + C.wave * 256; LAS float* sc = (LAS float*)(C.lds + 8192) + C.wave * 2048;
    const bf16* qrow = PROJ + (tok0 + t) * CPAD + PC_QR + h * 256;
    for (int d = lane; d < 256; d += 64) qs[d] = bf2f(qrow[d]);
    __syncthreads();
    const float l2g = log2f(1.f - exp2f(-5.f - (float)h));
    for (int m0 = 0; m0 <= t; m0 += 64) { const int m = m0 + lane;
        if (m <= t) { const bf16* krow = PROJ + (tok0 + m) * CPAD + PC_KR + h * 256; float s = 0.f;
            for (int c = 0; c < 32; ++c) s += dot8(*(const u32x4*)(krow + 8 * c), qs + 8 * c);
            sc[m] = s * exp2f((float)(t - m) * l2g); } }
    __syncthreads();
    float acc[8];
#pragma unroll
    for (int i = 0; i < 8; ++i) acc[i] = 0.f;
    const bf16* vb = PROJ + tok0 * CPAD + PC_VR + h * 512 + lane * 8;
    for (int m = 0; m <= t; ++m) { const float p = sc[m]; const u32x4 w = *(const u32x4*)(vb + (size_t)m * CPAD);
        acc[0] += p * bflo(w.x); acc[1] += p * bfhi(w.x); acc[2] += p * bflo(w.y); acc[3] += p * bfhi(w.y); acc[4] += p * bflo(w.z); acc[5] += p * bfhi(w.z); acc[6] += p * bflo(w.w); acc[7] += p * bfhi(w.w); }
    float s = 0.f;
#pragma unroll
    for (int i = 0; i < 8; ++i) s += acc[i];
    const float mean = wave_sum(s, lane) * (1.f / 512.f); float q = 0.f;
#pragma unroll
    for (int i = 0; i < 8; ++i) { acc[i] -= mean; q += acc[i] * acc[i]; }
    const float rstd = 1.f / sqrtf(wave_sum(q, lane) * (1.f / 512.f) + 1e-5f);
    const u32x4 gw = *(const u32x4*)(PROJ + (tok0 + t) * CPAD + PC_GR + h * 512 + lane * 8);
    u32x4 o; o.x = pk2(acc[0] * rstd * bflo(gw.x), acc[1] * rstd * bfhi(gw.x)); o.y = pk2(acc[2] * rstd * bflo(gw.y), acc[3] * rstd * bfhi(gw.y));
    o.z = pk2(acc[4] * rstd * bflo(gw.z), acc[5] * rstd * bfhi(gw.z)); o.w = pk2(acc[6] * rstd * bflo(gw.w), acc[7] * rstd * bfhi(gw.w));
    *(u32x4*)(ORET + (tok0 + t) * 2048 + h * 512 + lane * 8) = o;
    __syncthreads();
}


typedef short s16x4 __attribute__((ext_vector_type(4)));
typedef short bf16x8 __attribute__((ext_vector_type(8)));
#define MFMA16(a, b, c) __builtin_amdgcn_mfma_f32_16x16x32_bf16((a), (b), (c), 0, 0, 0)
constexpr int RK_PITCH = 528, RV_PITCH = 144, RR_PITCH = 528;
constexpr int RL_K = 0, RL_V = 128 * RK_PITCH, RL_R = RL_V + 128 * RV_PITCH, RL_END = RL_R + 64 * RR_PITCH;
static_assert(RL_END <= RING_BYTES, "retention LDS map");
__device__ __forceinline__ bf16x8 tr_frag(LAS unsigned char* tile, int pitch, int rowA, int rowB, int col0, int lane) {
    const int q = (lane & 15) >> 2, p = lane & 3;
    const s16x4 a = __builtin_amdgcn_ds_read_tr16_b64_v4i16((LAS s16x4*)(tile + (rowA + q) * pitch + (col0 + 4 * p) * 2));
    const s16x4 b = __builtin_amdgcn_ds_read_tr16_b64_v4i16((LAS s16x4*)(tile + (rowB + q) * pitch + (col0 + 4 * p) * 2));
    return __builtin_shufflevector(a, b, 0, 1, 2, 3, 4, 5, 6, 7);
}
__device__ __forceinline__ bf16x8 tr_frag2(LAS unsigned char* lb, int offA, int offB) {
    const s16x4 a = __builtin_amdgcn_ds_read_tr16_b64_v4i16((LAS s16x4*)(lb + offA));
    const s16x4 b = __builtin_amdgcn_ds_read_tr16_b64_v4i16((LAS s16x4*)(lb + offB));
    return __builtin_shufflevector(a, b, 0, 1, 2, 3, 4, 5, 6, 7);
}
__device__ __forceinline__ bf16x8 pack_bf8(const f32x4 a, const f32x4 b) { u32x4 w; w.x = pk2(a[0], a[1]); w.y = pk2(a[2], a[3]); w.z = pk2(b[0], b[1]); w.w = pk2(b[2], b[3]); return __builtin_bit_cast(bf16x8, w); }

__device__ __forceinline__ void ret_unit(const Ctx& C, int u, const bf16* PROJ, bf16* ORET, float* GNP) {
    const int es = u & 7, h = (u >> 3) & 3, b = u >> 5;
    const int lane = C.lane, w = C.wave, i16 = lane & 15, g = lane >> 4, tid = C.tid;
    LAS unsigned char* lds = C.lds;
    const size_t tok0 = (size_t)b * T_;
    const float l2g = log2f(1.f - exp2f(-5.f - (float)h));
    const float xi = exp2f(l2g * (float)(w * 16 + i16 + 1));
    const float gchunk = exp2f(l2g * 128.f);
    float dbase[4];
#pragma unroll
    for (int r = 0; r < 4; ++r) dbase[r] = exp2f(l2g * (float)(i16 - 4 * g - r));
    f32x4 racc[2][4];
#pragma unroll
    for (int dt = 0; dt < 2; ++dt)
#pragma unroll
        for (int et = 0; et < 4; ++et) racc[dt][et] = (f32x4){0.f, 0.f, 0.f, 0.f};
    u32x4 stK[8], stV[2]; bf16x8 qfrag[8];
    const unsigned kvo = (unsigned)(tid >> 5) * (CPAD * 2) + (unsigned)(tid & 31) * 16u, vvo = (unsigned)(tid >> 3) * (CPAD * 2) + (unsigned)(tid & 7) * 16u;
    const unsigned qvo = (unsigned)(w * 16 + i16) * (CPAD * 2) + (unsigned)g * 16u;
    const int klo = RL_K + (tid >> 5) * RK_PITCH + (tid & 31) * 16, vlo = RL_V + (tid >> 3) * RV_PITCH + (tid & 7) * 16;
    const char* kch = (const char*)(PROJ + tok0 * CPAD + PC_KR + h * 256);
    const char* vch = (const char*)(PROJ + tok0 * CPAD + PC_VR + h * 512 + es * 64);
    const char* qch = (const char*)(PROJ + tok0 * CPAD + PC_QR + h * 256);
#pragma unroll
    for (int i = 0; i < 8; ++i) stK[i] = *(const u32x4*)(kch + (size_t)i * 16 * CPAD * 2 + kvo);
#pragma unroll
    for (int i = 0; i < 2; ++i) stV[i] = *(const u32x4*)(vch + (size_t)i * 64 * CPAD * 2 + vvo);
#pragma unroll
    for (int kb = 0; kb < 8; ++kb) qfrag[kb] = *(const bf16x8*)(qch + kb * 64 + qvo);
#pragma unroll
    for (int i = 0; i < 8; ++i) *(LAS u32x4*)(lds + klo + i * 16 * RK_PITCH) = stK[i];
#pragma unroll
    for (int i = 0; i < 2; ++i) *(LAS u32x4*)(lds + vlo + i * 64 * RV_PITCH) = stV[i];
    __syncthreads();
    for (int c = 0; c < 16; ++c) {
        const bool more = c + 1 < 16;
        int lane_c = lane; float l2c = l2g; asm volatile("" : "+v"(lane_c), "+v"(l2c));
        const int i16 = lane_c & 15, g = lane_c >> 4;
        const char* kn = kch + (size_t)(c + 1) * 128 * CPAD * 2; const char* vn = vch + (size_t)(c + 1) * 128 * CPAD * 2; const char* qn = qch + (size_t)(c + 1) * 128 * CPAD * 2;
        f32x4 oacc[4];
#pragma unroll
        for (int et = 0; et < 4; ++et) oacc[et] = (f32x4){0.f, 0.f, 0.f, 0.f};
        if (c > 0) {
#pragma unroll
            for (int et = 0; et < 4; ++et) {
#pragma unroll
                for (int kb = 0; kb < 8; ++kb) { const bf16x8 rf = *(const LAS bf16x8*)(lds + RL_R + (et * 16 + i16) * RR_PITCH + (kb * 32 + 8 * g) * 2); oacc[et] = MFMA16(rf, qfrag[kb], oacc[et]); }
                oacc[et] = oacc[et] * xi; __builtin_amdgcn_sched_barrier(0); }
        }
        for (int i = 0; i <= (w >> 1); ++i) {
            f32x4 sa = (f32x4){0.f, 0.f, 0.f, 0.f}, sb = (f32x4){0.f, 0.f, 0.f, 0.f};
            const int mb0 = 2 * i, mb1 = 2 * i + 1;
#pragma unroll
            for (int kb = 0; kb < 8; ++kb) { const bf16x8 kf = *(const LAS bf16x8*)(lds + RL_K + (mb0 * 16 + i16) * RK_PITCH + (kb * 32 + 8 * g) * 2); sa = MFMA16(kf, qfrag[kb], sa); }
            __builtin_amdgcn_sched_barrier(0);
            if (mb1 <= w) {
#pragma unroll
                for (int kb = 0; kb < 8; ++kb) { const bf16x8 kf = *(const LAS bf16x8*)(lds + RL_K + (mb1 * 16 + i16) * RK_PITCH + (kb * 32 + 8 * g) * 2); sb = MFMA16(kf, qfrag[kb], sb); }
            }
            __builtin_amdgcn_sched_barrier(0);
            const float ga = exp2f(l2c * (float)(16 * (w - mb0))), gb = exp2f(l2c * (float)(16 * (w - mb1)));
#pragma unroll
            for (int r = 0; r < 4; ++r) { const bool da = (mb0 < w) || (i16 - 4 * g - r >= 0), db = (mb1 < w) || (i16 - 4 * g - r >= 0);
                sa[r] = da ? sa[r] * (dbase[r] * ga) : 0.f; sb[r] = (mb1 <= w && db) ? sb[r] * (dbase[r] * gb) : 0.f; }
            const bf16x8 sf = pack_bf8(sa, sb);
            __builtin_amdgcn_sched_barrier(0);
#pragma unroll
            for (int et = 0; et < 4; ++et) { const bf16x8 vf = tr_frag(lds + RL_V, RV_PITCH, mb0 * 16 + 4 * g, mb1 * 16 + 4 * g, et * 16, lane_c); oacc[et] = MFMA16(vf, sf, oacc[et]); }
        }
        { const size_t tok = tok0 + (size_t)c * 128 + w * 16 + i16; float s1 = 0.f, s2 = 0.f;
#pragma unroll
          for (int et = 0; et < 4; ++et) { const f32x4 o = oacc[et]; s1 += (o[0] + o[1]) + (o[2] + o[3]); s2 += (o[0] * o[0] + o[1] * o[1]) + (o[2] * o[2] + o[3] * o[3]);
              u32x2 wv; wv.x = pk2(o[0], o[1]); wv.y = pk2(o[2], o[3]); *(u32x2*)(ORET + tok * 2048 + h * 512 + es * 64 + et * 16 + 4 * g) = wv; }
          s1 += shx(s1, 16, lane_c); s1 += shx(s1, 32, lane_c); s2 += shx(s2, 16, lane_c); s2 += shx(s2, 32, lane_c);
          if (g == 0) *(f32x2*)(GNP + ((tok * 4 + h) * 8 + es) * 2) = (f32x2){s1, s2}; }
        if (more) {
#pragma unroll
            for (int i = 0; i < 8; ++i) stK[i] = *(const u32x4*)(kn + (size_t)i * 16 * CPAD * 2 + kvo);
#pragma unroll
            for (int i = 0; i < 2; ++i) stV[i] = *(const u32x4*)(vn + (size_t)i * 64 * CPAD * 2 + vvo);
#pragma unroll
            for (int kb = 0; kb < 8; ++kb) qfrag[kb] = *(const bf16x8*)(qn + kb * 64 + qvo);
        }
#pragma unroll
        for (int dt = 0; dt < 2; ++dt)
#pragma unroll
            for (int et = 0; et < 4; ++et) racc[dt][et] = racc[dt][et] * gchunk;
#pragma unroll
        for (int kb = 0; kb < 4; ++kb) {
            float zl[8];
#pragma unroll
            for (int j = 0; j < 8; ++j) zl[j] = __builtin_amdgcn_exp2f(l2c * (float)(127 - 32 * kb - 8 * g - j));
            const float zk = 1.f;
            bf16x8 af[2];
#pragma unroll
            for (int dt = 0; dt < 2; ++dt) { const bf16x8 raw = tr_frag(lds + RL_K, RK_PITCH, kb * 32 + 8 * g, kb * 32 + 8 * g + 4, (2 * w + dt) * 16, lane_c);
                const u32x4 rw = __builtin_bit_cast(u32x4, raw); u32x4 o;
                o.x = pk2(bflo(rw.x) * (zl[0] * zk), bfhi(rw.x) * (zl[1] * zk)); o.y = pk2(bflo(rw.y) * (zl[2] * zk), bfhi(rw.y) * (zl[3] * zk));
                o.z = pk2(bflo(rw.z) * (zl[4] * zk), bfhi(rw.z) * (zl[5] * zk)); o.w = pk2(bflo(rw.w) * (zl[6] * zk), bfhi(rw.w) * (zl[7] * zk));
                af[dt] = __builtin_bit_cast(bf16x8, o); }
#pragma unroll
            for (int et = 0; et < 4; ++et) { const bf16x8 vf = tr_frag(lds + RL_V, RV_PITCH, kb * 32 + 8 * g, kb * 32 + 8 * g + 4, et * 16, lane_c);
#pragma unroll
                for (int dt = 0; dt < 2; ++dt) racc[dt][et] = MFMA16(af[dt], vf, racc[dt][et]); }
            __builtin_amdgcn_sched_barrier(0);
        }
        __syncthreads();
        if (more) {
#pragma unroll
            for (int dt = 0; dt < 2; ++dt)
#pragma unroll
                for (int et = 0; et < 4; ++et) { const f32x4 rv = racc[dt][et]; u32x2 wv; wv.x = pk2(rv[0], rv[1]); wv.y = pk2(rv[2], rv[3]);
                    *(LAS u32x2*)(lds + RL_R + (et * 16 + i16) * RR_PITCH + ((2 * w + dt) * 16 + 4 * g) * 2) = wv; }
#pragma unroll
            for (int i = 0; i < 8; ++i) *(LAS u32x4*)(lds + klo + i * 16 * RK_PITCH) = stK[i];
#pragma unroll
            for (int i = 0; i < 2; ++i) *(LAS u32x4*)(lds + vlo + i * 64 * RV_PITCH) = stV[i];
        }
        __syncthreads();
    }
}
__device__ __forceinline__ void gn_gate_row(const bf16* PROJ, bf16* ORET, const float* GNP, size_t tok, int lane) {
#pragma unroll
    for (int h = 0; h < 4; ++h) {
        const f32x4* sp = (const f32x4*)(GNP + (tok * 4 + h) * 16); float s1 = 0.f, s2 = 0.f;
#pragma unroll
        for (int i = 0; i < 4; ++i) { const f32x4 v = sp[i]; s1 += v[0] + v[2]; s2 += v[1] + v[3]; }
        const float mean = s1 * (1.f / 512.f), var = fmaxf(s2 * (1.f / 512.f) - mean * mean, 0.f), rstd = 1.f / sqrtf(var + 1e-5f);
        bf16* op = ORET + tok * 2048 + h * 512 + lane * 8;
        const u32x4 ow = *(const u32x4*)op, gw = *(const u32x4*)(PROJ + tok * CPAD + PC_GR + h * 512 + lane * 8);
        u32x4 o; o.x = pk2((bflo(ow.x) - mean) * rstd * bflo(gw.x), (bfhi(ow.x) - mean) * rstd * bfhi(gw.x)); o.y = pk2((bflo(ow.y) - mean) * rstd * bflo(gw.y), (bfhi(ow.y) - mean) * rstd * bfhi(gw.y));
        o.z = pk2((bflo(ow.z) - mean) * rstd * bflo(gw.z), (bfhi(ow.z) - mean) * rstd * bfhi(gw.z)); o.w = pk2((bflo(ow.w) - mean) * rstd * bflo(gw.w), (bfhi(ow.w) - mean) * rstd * bfhi(gw.w));
        *(u32x4*)op = o;
    }
}


constexpr int NL_T5 = 0, NL_TILE = 64 * 144, NL_K0 = 4096, NL_V0 = NL_K0 + 2 * NL_TILE, NL_IMP = NL_K0 + 4 * NL_TILE, NL_SEL = NL_IMP + 8 * 64 * 33 * 4, NL_XCH = NL_SEL + 512, NL_END = NL_XCH + 8 * 512 * 4;
static_assert(NL_END <= RING_BYTES, "NSA LDS map");
__device__ __forceinline__ int ishx(int v, int m, int lane) { return __builtin_amdgcn_ds_bpermute((lane ^ m) << 2, v); }

__device__ __forceinline__ void nsa_unit(const Ctx& C, int u, const bf16* PROJ, const bf16* KCV, const float* t5, float* ONF, bf16* ON, unsigned* DBGSEL = nullptr) {
    const int qb = u < 256 ? 31 - (u >> 4) : ((u - 256) >> 4), bg = u & 15, g_ = bg & 1, b = bg >> 1;
    int tid_u = C.tid; asm volatile("" : "+v"(tid_u));
    const int w = C.wave, tid = tid_u, lane = tid & 63, head = g_ * 8 + w, s0 = qb * 64, i16 = lane & 15, g = lane >> 4;
    LAS unsigned char* lds = C.lds;
    const size_t tok0 = (size_t)b * T_;
    LAS float* T5L = (LAS float*)(lds + NL_T5) + w * 128;
    LAS float* impH = (LAS float*)(lds + NL_IMP);
    LAS unsigned* selm = (LAS unsigned*)(lds + NL_SEL);
    for (int i = tid; i < 1024; i += 512) ((LAS float*)(lds + NL_T5))[i] = t5[g_ * 1024 + i];
    { const bf16* kc = KCV + ((size_t)((0 * NBC + b) * 2 + g_) * NCMP_PAD) * 64; const bf16* vc = KCV + ((size_t)((1 * NBC + b) * 2 + g_) * NCMP_PAD) * 64;
#pragma unroll
      for (int i = 0; i < 2; ++i) { const int p = tid + 512 * i, row = p >> 3, c16 = p & 7;
          *(LAS u32x4*)(lds + NL_K0 + row * 144 + c16 * 16) = *(const u32x4*)(kc + row * 64 + c16 * 8);
          *(LAS u32x4*)(lds + NL_V0 + row * 144 + c16 * 16) = *(const u32x4*)(vc + row * 64 + c16 * 8); } }
    bf16x8 qf[4][2];
#pragma unroll
    for (int tt = 0; tt < 4; ++tt)
#pragma unroll
        for (int kb = 0; kb < 2; ++kb) qf[tt][kb] = *(const bf16x8*)(PROJ + (tok0 + s0 + tt * 16 + i16) * CPAD + PC_QN + head * 64 + kb * 32 + 8 * g);
    __syncthreads();
#pragma unroll
    for (int tt = 0; tt < 4; ++tt) {
        int lane_b = lane; asm volatile("" : "+v"(lane_b));
        const int i16 = lane_b & 15, g = lane_b >> 4;
        LAS unsigned char* kl = lds + NL_K0 + i16 * 144 + g * 16; LAS unsigned char* vl = lds + NL_V0 + (4 * g + ((lane_b & 15) >> 2)) * 144 + (lane_b & 3) * 8;
        f32x4 st[8];
#pragma unroll
        for (int kt = 0; kt < 8; ++kt) { st[kt] = (f32x4){0.f, 0.f, 0.f, 0.f};
#pragma unroll
            for (int kb = 0; kb < 2; ++kb) { const bf16x8 kf = *(const LAS bf16x8*)(kl + kt * 16 * 144 + kb * 64); st[kt] = MFMA16(kf, qf[tt][kb], st[kt]); } }
        const int pos = s0 + tt * 16 + i16; float mx = -1e30f;
#pragma unroll
        for (int kt = 0; kt < 8; ++kt)
#pragma unroll
            for (int r = 0; r < 4; ++r) { const int dist = pos - 16 * (kt * 16 + 4 * g + r) - 31; const int idx = dist < 0 ? 0 : (dist > 127 ? 127 : dist);
                const float l = dist >= 0 ? st[kt][r] + T5L[idx] : -1e30f; st[kt][r] = l; mx = fmaxf(mx, l); }
        mx = fmaxf(mx, shx(mx, 16, lane_b)); mx = fmaxf(mx, shx(mx, 32, lane_b));
        float sum = 0.f;
#pragma unroll
        for (int kt = 0; kt < 8; ++kt)
#pragma unroll
            for (int r = 0; r < 4; ++r) { const float p = st[kt][r] > -1e29f ? __builtin_amdgcn_exp2f(st[kt][r] - mx) : 0.f; st[kt][r] = p; sum += p; }
        sum += shx(sum, 16, lane_b); sum += shx(sum, 32, lane_b);
        const float inv = 1.f / fmaxf(sum, 1e-30f);
        float rv[8];
#pragma unroll
        for (int kt = 0; kt < 8; ++kt) st[kt] = st[kt] * inv;
        { LAS float* xs = (LAS float*)(lds + NL_XCH) + w * 512;
#pragma unroll
          for (int kt = 0; kt < 8; ++kt) xs[kt * 64 + lane_b] = st[kt][3];
#pragma unroll
          for (int kt = 0; kt < 8; ++kt) rv[kt] = xs[kt * 64 + ((lane_b - 16) & 63)]; }
#pragma unroll
        for (int kt = 0; kt < 8; ++kt) { const float prev = g > 0 ? rv[kt] : (kt > 0 ? rv[kt > 0 ? kt - 1 : 0] : 0.f);
            impH[(w * 64 + tt * 16 + i16) * 33 + 4 * kt + g] = (st[kt][0] + st[kt][1]) + (st[kt][2] + st[kt][3]) + (DBG_NSA == 2 ? 0.f : prev); }
        f32x4 o[4];
#pragma unroll
        for (int dt = 0; dt < 4; ++dt) o[dt] = (f32x4){0.f, 0.f, 0.f, 0.f};
#pragma unroll
        for (int i = 0; i < 4; ++i) { const bf16x8 pf = pack_bf8(st[2 * i], st[2 * i + 1]);
#pragma unroll
            for (int dt = 0; dt < 4; ++dt) { const bf16x8 vf = tr_frag2(vl, (2 * i) * 16 * 144 + dt * 32, (2 * i + 1) * 16 * 144 + dt * 32); o[dt] = MFMA16(vf, pf, o[dt]); } }
        const float g0 = (DBG_BR < 0 || DBG_BR == 0) ? bf2f(PROJ[(tok0 + pos) * CPAD + PC_GATE + head * 3 + 0]) : 0.f;
#pragma unroll
        for (int dt = 0; dt < 4; ++dt) *(f32x4*)(ONF + (tok0 + pos) * DM + head * 64 + dt * 16 + 4 * g) = o[dt] * g0;
        __builtin_amdgcn_sched_barrier(0);
    }
    __syncthreads();
    int tid_s = C.tid; asm volatile("" : "+v"(tid_s));
    if (tid_s < 64) {
        const int tid = tid_s, lane = tid_s & 63;
        LAS float* row = impH + tid * 33; float im[32];
#pragma unroll
        for (int j = 0; j < 32; ++j) { float v = row[j];
#pragma unroll
            for (int hh = 1; hh < 8; ++hh) v += impH[(hh * 64 + tid) * 33 + j];
            im[j] = v;
#if DBG_NSA
            ((float*)DBGSEL)[(size_t)32 * T_ + (size_t)16 * T_ * 32 + ((size_t)(b * 2 + g_) * T_ + s0 + tid) * 32 + j] = j <= qb ? v : 0.f;
#endif
        }
        unsigned m = 1u | (1u << qb) | (qb > 0 ? (1u << (qb - 1)) : 0u);
        int cnt = __builtin_popcount(m);
        const int navail = qb + 1;
        const int want = navail < 8 ? navail : 8;
        for (; cnt < want; ++cnt) { int best = -1; float bv = -1.f;
#pragma unroll
            for (int j = 0; j < 32; ++j) { const bool cand = j <= qb && !((m >> j) & 1u); if (cand && im[j] > bv) { bv = im[j]; best = j; } }
            if (best < 0) break; m |= 1u << best; }
        selm[tid] = m;
#if DBG_NSA
        DBGSEL[(size_t)(16 + b * 2 + g_) * T_ + s0 + tid] = m;
#endif
        unsigned um = m;
#pragma unroll
        for (int o = 1; o < 64; o <<= 1) um |= (unsigned)ishx((int)um, o, lane);
        if (tid == 0) selm[64] = um;
    }
    __syncthreads();
    int tid_t = C.tid; asm volatile("" : "+v"(tid_t));
    const int tid2 = tid_t, lane2 = tid_t & 63;
    const unsigned umask = selm[64];
    unsigned selw[4];
#pragma unroll
    for (int tt = 0; tt < 4; ++tt) selw[tt] = selm[tt * 16 + (lane2 & 15)];
    const int nw = (qb < 8 ? qb : 8) + 1, ntile = nw + __builtin_popcount(umask);
    const float bfar = T5L[127];
    float mrun[4], lrun[4]; f32x4 oacc[4][4];
#pragma unroll
    for (int tt = 0; tt < 4; ++tt) { mrun[tt] = -1e30f; lrun[tt] = 0.f;
#pragma unroll
        for (int dt = 0; dt < 4; ++dt) oacc[dt][tt] = (f32x4){0.f, 0.f, 0.f, 0.f}; }
    const int srow = tid2 >> 3, sc16 = tid2 & 7;
    const bf16* kvb = PROJ + tok0 * CPAD + PC_KV + g_ * 64 + sc16 * 8;
    const int slds = srow * 144 + sc16 * 16;
    unsigned rem = umask;
    int cur_blk = qb, cur_br = 0;
    { const bf16* kp = kvb + (size_t)(cur_blk * 64 + srow) * CPAD; *(LAS u32x4*)(lds + NL_K0 + slds) = *(const u32x4*)(kp + 4 * 128); *(LAS u32x4*)(lds + NL_V0 + slds) = *(const u32x4*)(kp + 5 * 128); }
    __syncthreads();
    for (int it = 0; it < ntile; ++it) {
        int lane_c = lane2; asm volatile("" : "+v"(lane_c));
        const int i16c = lane_c & 15, gc = lane_c >> 4;
        const int buf = it & 1;
        int nxt_blk, nxt_br; const bool more = it + 1 < ntile;
        if (it + 1 < nw) { nxt_blk = qb - (it + 1); nxt_br = 0; } else { nxt_br = 1; nxt_blk = rem ? __builtin_ctz(rem) : 0; if (more) rem &= rem - 1; }
        u32x4 nk, nv;
        if (more) { const bf16* kp = kvb + (size_t)(nxt_blk * 64 + srow) * CPAD; nk = *(const u32x4*)(kp + (nxt_br ? 2 : 4) * 128); nv = *(const u32x4*)(kp + (nxt_br ? 3 : 5) * 128); }
        LAS unsigned char* kt_ = lds + NL_K0 + buf * NL_TILE + i16c * 144 + gc * 16; LAS unsigned char* vt_ = lds + NL_V0 + buf * NL_TILE + (4 * gc + (i16c >> 2)) * 144 + (lane_c & 3) * 8;
        const int dl = qb - cur_blk;
#pragma unroll
        for (int th = 0; th < 2; ++th) {
            f32x4 st[4][2];
#pragma unroll
            for (int kt = 0; kt < 4; ++kt) { const bf16x8 kf0 = *(const LAS bf16x8*)(kt_ + kt * 16 * 144), kf1 = *(const LAS bf16x8*)(kt_ + kt * 16 * 144 + 64);
#pragma unroll
                for (int tx = 0; tx < 2; ++tx) { st[kt][tx] = MFMA16(kf0, qf[2 * th + tx][0], ((f32x4){0.f, 0.f, 0.f, 0.f})); st[kt][tx] = MFMA16(kf1, qf[2 * th + tx][1], st[kt][tx]); } }
            if (dl >= 3 && !(cur_br == 0 && dl == 8)) {
#pragma unroll
                for (int tx = 0; tx < 2; ++tx) { const float off = (cur_br == 0 || ((selw[2 * th + tx] >> cur_blk) & 1u)) ? bfar : -1e30f;
#pragma unroll
                    for (int kt = 0; kt < 4; ++kt) st[kt][tx] = st[kt][tx] + off; }
            } else {
#pragma unroll
                for (int tx = 0; tx < 2; ++tx) { const bool sel = cur_br == 0 || ((selw[2 * th + tx] >> cur_blk) & 1u);
#pragma unroll
                    for (int kt = 0; kt < 4; ++kt)
#pragma unroll
                        for (int r = 0; r < 4; ++r) { const int dist = 64 * dl + ((2 * th + tx) * 16 + i16c) - (kt * 16 + 4 * gc + r); const int idx = dist < 0 ? 0 : (dist > 127 ? 127 : dist);
                            const bool ok = sel && dist >= 0 && (cur_br == 1 || dist < 512);
                            st[kt][tx][r] = ok ? st[kt][tx][r] + T5L[idx] : -1e30f; } }
            }
            bf16x8 pf[2][2];
#pragma unroll
            for (int tx = 0; tx < 2; ++tx) { const int tt = 2 * th + tx;
                float mx = fmaxf(fmaxf(fmaxf(st[0][tx][0], st[0][tx][1]), fmaxf(st[0][tx][2], st[0][tx][3])), fmaxf(fmaxf(st[1][tx][0], st[1][tx][1]), fmaxf(st[1][tx][2], st[1][tx][3])));
                mx = fmaxf(mx, fmaxf(fmaxf(fmaxf(st[2][tx][0], st[2][tx][1]), fmaxf(st[2][tx][2], st[2][tx][3])), fmaxf(fmaxf(st[3][tx][0], st[3][tx][1]), fmaxf(st[3][tx][2], st[3][tx][3]))));
                mx = fmaxf(mx, shx(mx, 16, lane_c)); mx = fmaxf(mx, shx(mx, 32, lane_c));
                const float mn = fmaxf(mrun[tt], mx), al = __builtin_amdgcn_exp2f(mrun[tt] - mn); mrun[tt] = mn;
                float ps = 0.f;
#pragma unroll
                for (int kt = 0; kt < 4; ++kt)
#pragma unroll
                    for (int r = 0; r < 4; ++r) { const float p = __builtin_amdgcn_exp2f(st[kt][tx][r] - mn); st[kt][tx][r] = p; ps += p; }
                lrun[tt] = lrun[tt] * al + ps;
#pragma unroll
                for (int dt = 0; dt < 4; ++dt) oacc[dt][tt] = oacc[dt][tt] * al;
                pf[0][tx] = pack_bf8(st[0][tx], st[1][tx]); pf[1][tx] = pack_bf8(st[2][tx], st[3][tx]);
            }
#pragma unroll
            for (int i = 0; i < 2; ++i)
#pragma unroll
                for (int dt = 0; dt < 4; ++dt) { const bf16x8 vf = tr_frag2(vt_, (2 * i) * 16 * 144 + dt * 32, (2 * i + 1) * 16 * 144 + dt * 32);
#pragma unroll
                    for (int tx = 0; tx < 2; ++tx) oacc[dt][2 * th + tx] = MFMA16(vf, pf[i][tx], oacc[dt][2 * th + tx]); }
            __builtin_amdgcn_sched_barrier(0);
        }
        const bool last = !more;
        if (last || (cur_br == 0 && nxt_br == 1)) {
#pragma unroll
            for (int tt = 0; tt < 4; ++tt) { float l = lrun[tt]; l += shx(l, 16, lane_c); l += shx(l, 32, lane_c);
                const size_t tok = tok0 + s0 + tt * 16 + i16c;
                const float gt = ((DBG_BR < 0 || DBG_BR == (cur_br == 0 ? 2 : 1)) ? bf2f(PROJ[tok * CPAD + PC_GATE + head * 3 + (cur_br == 0 ? 2 : 1)]) : 0.f) / fmaxf(l, 1e-30f);
#pragma unroll
                for (int dt = 0; dt < 4; ++dt) { float* op = ONF + tok * DM + head * 64 + dt * 16 + 4 * gc; const f32x4 v = *(const f32x4*)op + oacc[dt][tt] * gt;
                    if (last) { u32x2 wv; wv.x = pk2(v[0], v[1]); wv.y = pk2(v[2], v[3]); *(u32x2*)(ON + tok * DM + head * 64 + dt * 16 + 4 * gc) = wv; }
                    else *(f32x4*)op = v;
                    oacc[dt][tt] = (f32x4){0.f, 0.f, 0.f, 0.f}; }
                mrun[tt] = -1e30f; lrun[tt] = 0.f; }
        }
        if (more) { *(LAS u32x4*)(lds + NL_K0 + (buf ^ 1) * NL_TILE + slds) = nk; *(LAS u32x4*)(lds + NL_V0 + (buf ^ 1) * NL_TILE + slds) = nv; }
        cur_blk = nxt_blk; cur_br = nxt_br;
        __syncthreads();
    }
}

__device__ __forceinline__ float nsa_dot64(const bf16* krow, const LAS float* q) {
    float s = 0.f;
#pragma unroll
    for (int c = 0; c < 8; ++c) s += dot8(*(const u32x4*)(krow + 8 * c), q + 8 * c);
    return s;
}
__device__ __forceinline__ void nsa_naive_unit(const Ctx& C, int u, const bf16* PROJ, const bf16* KCV, const float* t5, bf16* ON, bf16* ONB = nullptr, unsigned* DBGSEL = nullptr) {
    const int t = u & (T_ - 1), g = (u >> 11) & 1, b = u >> 12, h = C.wave, head = g * 8 + h, lane = C.lane;
    const size_t tok0 = (size_t)b * T_, tok = tok0 + t;
    LAS float* qs = (LAS float*)C.lds + h * 64; LAS float* pcs = (LAS float*)(C.lds + 2048); LAS float* lg = (LAS float*)(C.lds + 8192) + h * 512;
    LAS float* imp = (LAS float*)(C.lds + 24576); LAS int* sel = (LAS int*)(C.lds + 24576 + 128);
    const float* tb = t5 + head * 128;
    qs[lane] = bf2f(PROJ[tok * CPAD + PC_QN + head * 64 + lane]);
    __syncthreads();
    const bf16* kc = KCV + ((size_t)((0 * NBC + b) * 2 + g) * NCMP_PAD) * 64; const bf16* vc = KCV + ((size_t)((1 * NBC + b) * 2 + g) * NCMP_PAD) * 64;
    float l[2]; bool ok[2];
#pragma unroll
    for (int r = 0; r < 2; ++r) { const int n = lane + 64 * r; ok[r] = (n < NCMP) && (16 * n + 31 <= t);
        l[r] = -1e30f; if (ok[r]) { int dist = t - 16 * n - 31; dist = dist > 127 ? 127 : dist; l[r] = nsa_dot64(kc + n * 64, qs) + tb[dist]; } }
    { const float mx = wave_max(fmaxf(l[0], l[1]), lane); const float e0 = ok[0] ? exp2f(l[0] - mx) : 0.f, e1 = ok[1] ? exp2f(l[1] - mx) : 0.f;
      const float inv = 1.f / fmaxf(wave_sum(e0 + e1, lane), 1e-30f); pcs[h * 128 + lane] = e0 * inv; pcs[h * 128 + 64 + lane] = e1 * inv; }
    __syncthreads();
    float oc = 0.f;
    for (int n = 0; n < NCMP; ++n) oc += pcs[h * 128 + n] * bf2f(vc[n * 64 + lane]);
    const int cur = t >> 6;
    if (C.tid < 32) { const int j = C.tid; float v = 0.f; const int n0 = DBG_NSA == 2 ? 4 * j : (4 * j - 1 < 0 ? 0 : 4 * j - 1), n1 = 4 * j + 3 > NCMP - 1 ? NCMP - 1 : 4 * j + 3;
        for (int hh = 0; hh < 8; ++hh) for (int n = n0; n <= n1; ++n) v += pcs[hh * 128 + n];
#if DBG_NSA
        ((float*)DBGSEL)[(size_t)32 * T_ + ((size_t)(b * 2 + g) * T_ + t) * 32 + j] = j <= cur ? v : 0.f;
#endif
        if (j == 0 || j == cur || j == cur - 1) v = 1e4f; if (j > cur) v = -1e30f; imp[j] = v; }
    __syncthreads();
    if (C.tid == 0) { unsigned used = 0u; int ns = 0;
        for (int k = 0; k < 8; ++k) { int best = -1; float bv = -1e29f;
            for (int j = 0; j < 32; ++j) if (!((used >> j) & 1u) && imp[j] > bv) { bv = imp[j]; best = j; }
            if (best < 0) break; used |= 1u << best; sel[ns++] = best; }
        sel[8] = ns;
#if DBG_NSA
        { unsigned mk = 0u; for (int k = 0; k < ns; ++k) mk |= 1u << sel[k]; DBGSEL[(size_t)(b * 2 + g) * T_ + t] = mk; }
#endif
    }
    __syncthreads();
    const int ns = sel[8];
    float os = 0.f;
    { float mx = -1e30f;
      for (int i = 0; i < ns; ++i) { const int key = 64 * sel[i] + lane; float v = -1e30f;
          if (key <= t) { int dist = t - key; dist = dist > 127 ? 127 : dist; v = nsa_dot64(PROJ + (tok0 + key) * CPAD + PC_KV + 2 * 128 + g * 64, qs) + tb[dist]; }
          lg[i * 64 + lane] = v; mx = fmaxf(mx, v); }
      mx = wave_max(mx, lane); float s = 0.f;
      for (int i = 0; i < ns; ++i) { const int key = 64 * sel[i] + lane; const float e = key <= t ? exp2f(lg[i * 64 + lane] - mx) : 0.f; lg[i * 64 + lane] = e; s += e; }
      const float inv = 1.f / fmaxf(wave_sum(s, lane), 1e-30f);
      __syncthreads();
      for (int i = 0; i < ns; ++i) { const bf16* vb = PROJ + (tok0 + 64 * sel[i]) * CPAD + PC_KV + 3 * 128 + g * 64 + lane;
          for (int kk = 0; kk < 64; ++kk) os += lg[i * 64 + kk] * bf2f(vb[(size_t)kk * CPAD]); }
      os *= inv; }
    __syncthreads();
    float ow = 0.f;
    { float mx = -1e30f;
      for (int i = 0; i < 8; ++i) { const int key = t - 511 + 64 * i + lane; float v = -1e30f;
          if (key >= 0) { int dist = t - key; dist = dist > 127 ? 127 : dist; v = nsa_dot64(PROJ + (tok0 + key) * CPAD + PC_KV + 4 * 128 + g * 64, qs) + tb[dist]; }
          lg[i * 64 + lane] = v; mx = fmaxf(mx, v); }
      mx = wave_max(mx, lane); float s = 0.f;
      for (int i = 0; i < 8; ++i) { const int key = t - 511 + 64 * i + lane; const float e = key >= 0 ? exp2f(lg[i * 64 + lane] - mx) : 0.f; lg[i * 64 + lane] = e; s += e; }
      const float inv = 1.f / fmaxf(wave_sum(s, lane), 1e-30f);
      __syncthreads();
      for (int i = 0; i < 8; ++i) for (int kk = 0; kk < 64; ++kk) { const int key = t - 511 + 64 * i + kk; if (key >= 0) ow += lg[i * 64 + kk] * bf2f(PROJ[(tok0 + key) * CPAD + PC_KV + 5 * 128 + g * 64 + lane]); }
      ow *= inv; }
    const bf16* gp = PROJ + tok * CPAD + PC_GATE + head * 3;
    const float r = bf2f(gp[0]) * oc + bf2f(gp[1]) * os + bf2f(gp[2]) * ow;
    ON[tok * DM + head * 64 + lane] = (bf16)f2bf(r);
#if DBG_NSA
    { const float rb = (DBG_BR < 0 || DBG_BR == 0 ? bf2f(gp[0]) * oc : 0.f) + (DBG_BR < 0 || DBG_BR == 1 ? bf2f(gp[1]) * os : 0.f) + (DBG_BR < 0 || DBG_BR == 2 ? bf2f(gp[2]) * ow : 0.f);
      ONB[tok * DM + head * 64 + lane] = (bf16)f2bf(rb); }
#endif
    __syncthreads();
}

#ifndef RET_NAIVE
#define RET_NAIVE 0
#endif
#ifndef CMP_NAIVE
#define CMP_NAIVE 0
#endif
#ifndef NSA_NAIVE
#define NSA_NAIVE 0
#endif
__global__ void __launch_bounds__(NWAVES * 64, 2) fwd(Args a) {
    extern __shared__ __attribute__((aligned(16))) unsigned char lds_raw[];
    Ctx C; C.lds = (LAS unsigned char*)lds_raw; C.tid = threadIdx.x; C.lane = C.tid & 63; C.wave = __builtin_amdgcn_readfirstlane(C.tid >> 6); C.G = gridDim.x; C.bid = blockIdx.x;
    unsigned char* ws = a.ws;
    gu32* ctl = (gu32*)(ws + WS_CTL);
    volatile LAS unsigned* MISC = (volatile LAS unsigned*)(C.lds + MISC_OFF);
    for (int u = C.tid; u < (LDS_BYTES - LDSCTL_OFF) / 4; u += NWAVES * 64) ((LAS unsigned*)(C.lds + LDSCTL_OFF))[u] = 0u;
    __syncthreads();
    const bool one = (a.flags & 1) != 0;
    XcdBarrier bar; bar.bar = (unsigned*)(ctl + CW_BAR); bar.x = 0; bar.st = nullptr;
    if (one) bar = xcd_barrier_post((unsigned*)(ctl + CW_BAR), MISC + 8);
#define SEAM() do { int f_ = a.flags; asm volatile("" : "+s"(f_)); if (f_ & 1) xcd_barrier(bar); } while (0)
#define PH(k) (plo_ <= (k) && (k) < phi_)
#define RELOAD() do { int t_ = threadIdx.x; asm volatile("" : "+v"(t_)); C.tid = t_; C.lane = t_ & 63; C.wave = __builtin_amdgcn_readfirstlane(t_ >> 6); gw = C.bid * NWAVES + C.wave; } while (0)
    int gw = C.bid * NWAVES + C.wave; const int NGW = C.G * NWAVES;
    bf16* const H = (bf16*)(ws + WS_H); bf16* const PROJ = (bf16*)(ws + WS_BIG); bf16* const FFH = (bf16*)(ws + WS_BIG);
    bf16* const ORET = (bf16*)(ws + WS_ORET); bf16* const ON = (bf16*)(ws + WS_ON); bf16* const TMP = (bf16*)(ws + WS_TMP); bf16* const MERGED = (bf16*)(ws + WS_MERGED);
    bf16* const KCV = (bf16*)(ws + WS_KC); float* const GNP = (float*)(ws + WS_GNS); float* const ONF = (float*)(ws + WS_ONF); bf16* const XC = (bf16*)(ws + WS_XC); bf16* const HID = (bf16*)(ws + WS_HID);
    const float* rot = (const float*)(ws + WS_ROT); const float* t5 = (const float*)(ws + WS_T5);

    if (a.it_lo < 0) { RELOAD(); p0_prologue(C, a); SEAM(); }
    const int it0 = a.it_lo < 0 ? 0 : a.it_lo, it1 = a.it_hi > 10 ? 10 : a.it_hi;
    for (int it = it0; it < it1; ++it) {
        int itv = it, plo_ = a.ph_lo, phi_ = a.ph_hi; asm volatile("" : "+s"(itv), "+s"(plo_), "+s"(phi_)); const int L = itv / 5, sub = itv % 5;
        if (sub < 4) {
            const size_t row0 = (size_t)sub * MC;
            const float* xsrc = (L == 0 ? a.in[0] : (const float*)a.out) + row0 * DM;
            float* xdst = a.out + row0 * DM;
            if (PH(0)) { RELOAD(); const float* g = a.in[1] + L * DM; for (int m = gw; m < MC; m += NGW) rms_row_to_bf16(xsrc + (size_t)m * DM, g, H + (size_t)m * DM, C.lane); SEAM(); }
            if (PH(1)) { pg8::Gemm g{H, (const bf16*)(ws + WS_WIN) + (size_t)L * CPAD * DM, MC, CPAD, DM}; pg8::StaticOrder S; S.init(MC, CPAD, C.G, C.bid);
                epi::EpiInProj E{PROJ, rot, XC}; pg8::gemm_phase<epi::EpiInProj, pg8::StaticOrder, true, true>(C.lds, g, S, E); SEAM(); }
            if (PH(2)) {
#if CMP_NAIVE
                RELOAD(); for (int u = C.bid; u < 2 * NBC * 2 * NCMP; u += C.G) { const int kv = u / (2 * NCMP * NBC);
                    compress_naive_unit(C, u, PROJ, (kv ? a.in[4] : a.in[3]) + L * 2048, (kv ? a.in[7] : a.in[5]) + (size_t)L * 2048 * 256, (kv ? a.in[8] : a.in[6]) + (size_t)L * 256 * 64, KCV); }
#else
                { pg8::Gemm g{XC, (const bf16*)(ws + WS_WC1) + (size_t)L * 2 * 256 * 2048, 4096, 512, 2048, 1024}; pg8::StaticOrder S; S.init(4096, 512, C.G, C.bid);
                  epi::EpiCmp E{HID, (const float*)(ws + WS_CB) + L * 512}; pg8::gemm_phase<epi::EpiCmp, pg8::StaticOrder, true, true>(C.lds, g, S, E); }
                SEAM();
                { RELOAD(); for (int o = C.bid * 512 + C.tid; o < 2 * 2048 * 64; o += C.G * 512) { const int d = o & 63, row = (o >> 6) & 2047, kv = o >> 17; const int n = row & 127;
                      const bf16* hp = HID + ((size_t)kv * 2048 + row) * 256; const float* w2 = (kv ? a.in[8] : a.in[6]) + (size_t)L * 256 * 64 + d; float s_ = 0.f;
                      for (int k8 = 0; k8 < 32; ++k8) { const u32x4 hw = *(const u32x4*)(hp + 8 * k8); const float* wp = w2 + (size_t)k8 * 8 * 64;
                          s_ += bflo(hw.x) * wp[0] + bfhi(hw.x) * wp[64] + bflo(hw.y) * wp[128] + bfhi(hw.y) * wp[192] + bflo(hw.z) * wp[256] + bfhi(hw.z) * wp[320] + bflo(hw.w) * wp[384] + bfhi(hw.w) * wp[448]; }
                      KCV[((size_t)kv * 2048 + row) * 64 + d] = n == 127 ? (bf16)0 : (bf16)f2bf(s_); } }
#endif
                SEAM(); }
            if (PH(3)) {
#if RET_NAIVE
                RELOAD(); for (int u = C.bid; u < NBC * 4 * 256; u += C.G) ret_naive_unit(C, u, PROJ, ORET);
#else
                RELOAD(); for (int u = C.bid; u < NBC * 4 * 8; u += C.G) ret_unit(C, u, PROJ, ORET, GNP);
#endif
#if DBG_NSA
                RELOAD(); for (int u = C.bid; u < NBC * 2 * T_; u += C.G) nsa_naive_unit(C, u, PROJ, KCV, t5, ON, MERGED, (unsigned*)(ws + WS_END));
                RELOAD(); for (int u = C.bid; u < NBC * 2 * 32; u += C.G) nsa_unit(C, u, PROJ, KCV, t5, ONF, TMP, (unsigned*)(ws + WS_END));
                SEAM();
                { RELOAD(); float d2 = 0.f, r2 = 0.f; const float* sm = (const float*)(ws + WS_END) + 32 * T_; for (int i = C.bid * 512 + C.tid; i < 16 * T_ * 32; i += C.G * 512) { const float a_ = sm[i], b_ = sm[16 * T_ * 32 + i]; d2 += (a_ - b_) * (a_ - b_); r2 += a_ * a_; }
                  d2 = wave_sum(d2, C.lane); r2 = wave_sum(r2, C.lane); if (C.lane == 0) { atomicAdd((float*)(ctl + 8), d2); atomicAdd((float*)(ctl + 9), r2); } }
#elif NSA_NAIVE
                RELOAD(); for (int u = C.bid; u < NBC * 2 * T_; u += C.G) nsa_naive_unit(C, u, PROJ, KCV, t5, ON);
#else
                RELOAD(); for (int u = C.bid; u < NBC * 2 * 32; u += C.G) nsa_unit(C, u, PROJ, KCV, t5, ONF, ON);
#endif
                SEAM(); }
            if (PH(4)) {
#if !RET_NAIVE
                RELOAD(); for (int m = gw; m < MC; m += NGW) gn_gate_row(PROJ, ORET, GNP, (size_t)m, C.lane);
#endif
                SEAM(); }
            if (PH(5)) { pg8::Gemm g{ORET, (const bf16*)(ws + WS_WORET) + (size_t)L * DM * 2048, MC, DM, 2048}; pg8::StaticOrder S; S.init(MC, DM, C.G, C.bid);
                epi::EpiGate<false> E{TMP, nullptr, PROJ + PC_MA, DM, CPAD}; pg8::gemm_phase<epi::EpiGate<false>, pg8::StaticOrder, true, true>(C.lds, g, S, E); SEAM(); }
            if (PH(6)) { pg8::Gemm g{ON, (const bf16*)(ws + WS_WONSA) + (size_t)L * DM * DM, MC, DM, DM}; pg8::StaticOrder S; S.init(MC, DM, C.G, C.bid);
                epi::EpiGate<true> E{MERGED, TMP, PROJ + PC_MB, DM, CPAD}; pg8::gemm_phase<epi::EpiGate<true>, pg8::StaticOrder, true, true>(C.lds, g, S, E); SEAM(); }
            if (PH(7)) { pg8::Gemm g{MERGED, (const bf16*)(ws + WS_WOUT) + (size_t)L * DM * DM, MC, DM, DM}; pg8::StaticOrder S; S.init(MC, DM, C.G, C.bid);
                epi::EpiResid E{xsrc, xdst}; pg8::gemm_phase<epi::EpiResid, pg8::StaticOrder, true, true>(C.lds, g, S, E); SEAM(); }
        } else {
            if (PH(0)) { RELOAD(); const float* g = a.in[12] + L * DM; for (int m = gw; m < NTOK; m += NGW) rms_row_to_bf16(a.out + (size_t)m * DM, g, H + (size_t)m * DM, C.lane); SEAM(); }
            if (PH(1)) { pg8::Gemm g{H, (const bf16*)(ws + WS_WFFI) + (size_t)L * 2 * FFH_ * DM, NTOK, 2 * FFH_, DM}; pg8::StaticOrder S; S.init(NTOK, 2 * FFH_, C.G, C.bid);
                epi::EpiSwiGlu E{FFH}; pg8::gemm_phase<epi::EpiSwiGlu, pg8::StaticOrder, true, true>(C.lds, g, S, E); SEAM(); }
            if (PH(2)) { pg8::Gemm g{FFH, (const bf16*)(ws + WS_WFFO) + (size_t)L * DM * FFH_, NTOK, DM, FFH_}; pg8::StaticOrder S; S.init(NTOK, DM, C.G, C.bid);
                epi::EpiResid E{a.out, a.out}; pg8::gemm_phase<epi::EpiResid, pg8::StaticOrder, true, true>(C.lds, g, S, E); SEAM(); }
        }
    }
    if (a.it_hi > 10) { RELOAD(); const float* g = a.in[16]; for (int m = gw; m < NTOK; m += NGW) rms_row_f32(a.out + (size_t)m * DM, g, C.lane);
#if DBG_NSA
        SEAM();
        { const float d2 = __hip_atomic_load((float*)(ctl + 8), RLX_AGENT), r2 = __hip_atomic_load((float*)(ctl + 9), RLX_AGENT); const float e = sqrtf(d2 / fmaxf(r2, 1e-30f));
          for (size_t i = (size_t)C.bid * 512 + C.tid; i < (size_t)NTOK * DM; i += (size_t)C.G * 512) a.out[i] *= (1.f + e); }
#endif
    }
#undef SEAM
#undef PH
}

#ifndef ONE_LAUNCH
#define ONE_LAUNCH 1
#endif
extern "C" void kernel_launch(void* const* d_in, const int* in_sizes, int n_in, void* d_out, int out_size, void* d_ws, size_t ws_size, hipStream_t stream) {
    static int grid = 0;
    if (grid == 0) {
        if (n_in != 17 || in_sizes[0] != NTOK * DM || out_size != NTOK * DM || ws_size < WS_END) { fprintf(stderr, "kernel_launch: unexpected shapes (n_in %d, in0 %d, out %d, ws %zu); nothing launched\n", n_in, n_in > 0 ? in_sizes[0] : -1, out_size, ws_size); grid = -1; return; }
        int dev = 0, cus = 0, per_cu = 0;
        if (hipGetDevice(&dev) != hipSuccess || hipDeviceGetAttribute(&cus, hipDeviceAttributeMultiprocessorCount, dev) != hipSuccess) { grid = -1; return; }
        if (hipFuncSetAttribute((const void*)fwd, hipFuncAttributeMaxDynamicSharedMemorySize, LDS_BYTES) != hipSuccess) { fprintf(stderr, "kernel_launch: hipFuncSetAttribute failed\n"); grid = -1; return; }
        if (hipOccupancyMaxActiveBlocksPerMultiprocessor(&per_cu, (const void*)fwd, NWAVES * 64, LDS_BYTES) != hipSuccess || per_cu < 1) { fprintf(stderr, "kernel_launch: occupancy query says %d\n", per_cu); }
        (void)hipGetLastError();
        grid = cus;
    }
    if (grid < 0) return;
    (void)hipMemsetAsync((char*)d_ws + WS_CTL, 0, CTL_ZERO_BYTES, stream);
    Args a{};
    for (int i = 0; i < 17; ++i) a.in[i] = (const float*)d_in[i];
    a.out = (float*)d_out; a.ws = (unsigned char*)d_ws;
#if ONE_LAUNCH
    a.it_lo = -1; a.it_hi = 11; a.ph_lo = 0; a.ph_hi = 99; a.flags = 1;
    hipLaunchKernelGGL(fwd, dim3(grid), dim3(NWAVES * 64), LDS_BYTES, stream, a);
#else
    a.flags = 0;
    a.it_lo = -1; a.it_hi = 0; a.ph_lo = 0; a.ph_hi = 0; hipLaunchKernelGGL(fwd, dim3(grid), dim3(NWAVES * 64), LDS_BYTES, stream, a);
    for (int it = 0; it < 10; ++it) { const int nph = (it % 5 < 4) ? 8 : 3;
        for (int ph = 0; ph < nph; ++ph) { a.it_lo = it; a.it_hi = it + 1; a.ph_lo = ph; a.ph_hi = ph + 1; hipLaunchKernelGGL(fwd, dim3(grid), dim3(NWAVES * 64), LDS_BYTES, stream, a); } }
    a.it_lo = 10; a.it_hi = 11; a.ph_lo = 0; a.ph_hi = 0; hipLaunchKernelGGL(fwd, dim3(grid), dim3(NWAVES * 64), LDS_BYTES, stream, a);
#endif
}
```

```cpp
#include <hip/hip_runtime.h>
#include <cstdio>
#include <cstdint>
#ifndef TIMED_MASK
#define TIMED_MASK 0
#endif
__device__ __forceinline__ int lane_now() { int z = 0; asm volatile("" : "+v"(z)); return __builtin_amdgcn_mbcnt_hi(-1, __builtin_amdgcn_mbcnt_lo(-1, z)); }
namespace pg8 {
#define PG8_LAS __attribute__((address_space(3)))
typedef unsigned short bf16_t;
typedef short bf16x8 __attribute__((ext_vector_type(8)));
typedef float f32x4 __attribute__((ext_vector_type(4)));
typedef unsigned u32x4 __attribute__((ext_vector_type(4)));
constexpr int BM = 256, BK = 64, HALF = 128, HTB = HALF * BK * 2  , STAGE_BYTES = 8 * HTB, NXCD = 8, WGM = 8;

__host__ __device__ __forceinline__ int lds_byte(int r, int c) { const int st = (r >> 4) * 2 + (c >> 5), rr = r & 15, cc = c & 31, ob = rr * 64 + cc * 2; return st * 1024 + (ob ^ (((ob >> 9) & 1) << 5)); }
__host__ __device__ __forceinline__ void stage_rc(int b, int& R, int& C) { const int st = b / 1024, sb = b % 1024, swz = sb ^ (((sb >> 9) & 1) << 5); R = (st >> 1) * 16 + swz / 64; C = (st & 1) * 32 + (swz % 64) / 2; }
__host__ __device__ __forceinline__ int perm32(int rho) { const int n = rho >> 4, i = rho & 15; return 8 * (i >> 2) + 4 * n + (i & 3); }

struct Unit { int pm, pn; };
struct Gemm { const bf16_t* A; const bf16_t* Bt; int M, N, K; int lda = 0, ldb = 0; };

struct StaticOrder {
    int nM, nN, nwg, G, c;
    __host__ __device__ void init(int M, int N, int G_, int c_) { nM = M / BM; nN = N / BM; nwg = nM * nN; G = G_; c = c_; }
    __host__ __device__ bool next(int i, Unit& u) const {
        const long L = (long)i * G + c; if (L >= nwg) return false;
        int wgid = (int)L; { const int q = nwg / NXCD, r = nwg % NXCD, xcd = wgid % NXCD, off = wgid / NXCD; wgid = (xcd < r ? xcd * (q + 1) : r * (q + 1) + (xcd - r) * q) + off; }
        const int nig = WGM * nN, gid = wgid / nig, fm = gid * WGM, gsz = (nM - fm) < WGM ? (nM - fm) : WGM;
        u.pm = fm + ((wgid % nig) % gsz); u.pn = (wgid % nig) / gsz; return true;
    }
    __device__ __forceinline__ void a_ready(const Unit&) const {}
    __device__ __forceinline__ void done(const Unit&) const {}
};

template <class Epi, class Sched, bool ALIGN_EPI = false, bool SP2 = false>
__device__ __forceinline__ void gemm_phase(PG8_LAS unsigned char* lds, const Gemm g, const Sched& S, const Epi& E, int wave0) {
    int tid_ = (wave0 << 6) | lane_now(); asm volatile("" : "+v"(tid_));
    const int tid = tid_, wid = __builtin_amdgcn_readfirstlane(tid >> 6), lane = tid & 63, wr = wid >> 2, wc = wid & 3, fr = lane & 15, fq = lane >> 4;
    const int K = g.K, nt = K / BK, LDA = g.lda ? g.lda : g.K, LDB = g.ldb ? g.ldb : g.K;
    unsigned voffA[2], voffB[2];
#pragma unroll
    for (int i = 0; i < 2; ++i) { int R, C; stage_rc(tid * 16 + i * 8192, R, C); const int Rb = Epi::PERM ? ((R & ~31) + perm32(R & 31)) : R;
        voffA[i] = (unsigned)(R * LDA + C) * 2u; voffB[i] = (unsigned)(Rb * LDB + C) * 2u; }
    const size_t kstep = (size_t)(BK * 2);
    const size_t hstep = (size_t)HALF * LDB * 2;
    const size_t tstep = 2 * hstep;
    const size_t hstepA = (size_t)HALF * LDA * 2, tstepA = 2 * hstepA;
    const unsigned ldsw = (unsigned)wid * 1024u;
    const int aoff = lds_byte(wr * 64 + fr, fq * 8), boff = lds_byte(wc * 32 + fr, fq * 8);
#define PG8_SA(b, h) (((b) * 2 + (h)) * HTB)
#define PG8_SB(b, h) ((4 + (b) * 2 + (h)) * HTB)
#define PG8_STAGE(bufoff, gbase, voff) do { _Pragma("unroll") for (int _i = 0; _i < 2; ++_i) \
        __builtin_amdgcn_global_load_lds((const unsigned*)((const char*)(gbase) + (voff)[_i]), (PG8_LAS unsigned*)(lds + (bufoff) + ldsw + _i * 8192), 16, 0, 0); } while (0)
#define PG8_LDA(dst, b, h) do { _Pragma("unroll") for (int m = 0; m < 4; ++m) _Pragma("unroll") for (int k = 0; k < 2; ++k) dst[m][k] = *(const PG8_LAS bf16x8*)(lds + PG8_SA(b, h) + aoff + m * 2048 + k * 1024); } while (0)
#define PG8_LDB(dst, b, h) do { _Pragma("unroll") for (int n = 0; n < 2; ++n) _Pragma("unroll") for (int k = 0; k < 2; ++k) dst[n][k] = *(const PG8_LAS bf16x8*)(lds + PG8_SB(b, h) + boff + n * 2048 + k * 1024); } while (0)
#define PG8_MMA(ai, bj, At, Bt) do { __builtin_amdgcn_s_setprio(1); _Pragma("unroll") for (int m = 0; m < 4; ++m) _Pragma("unroll") for (int n = 0; n < 2; ++n) _Pragma("unroll") for (int k = 0; k < 2; ++k) \
        acc[ai][bj][m][n] = __builtin_amdgcn_mfma_f32_16x16x32_bf16(Bt[n][k], At[m][k], acc[ai][bj][m][n], 0, 0, 0); __builtin_amdgcn_s_setprio(0); } while (0)
#define PG8_WAIT_V(n) asm volatile("s_waitcnt vmcnt(" #n ")" ::: "memory")
#define PG8_WAIT_L(n) asm volatile("s_waitcnt lgkmcnt(" #n ")" ::: "memory")
#define PG8_BAR __builtin_amdgcn_s_barrier()
#define PG8_SCHED __builtin_amdgcn_sched_barrier(0)
    Unit cur, nxt; int ui = 0;
    if (!S.next(0, cur)) return;
    f32x4 acc[2][2][4][2];
#pragma unroll
    for (int a = 0; a < 2; ++a)
#pragma unroll
        for (int b = 0; b < 2; ++b)
#pragma unroll
            for (int m = 0; m < 4; ++m)
#pragma unroll
                for (int n = 0; n < 2; ++n) acc[a][b][m][n] = (f32x4){0.f, 0.f, 0.f, 0.f};
    bf16x8 At[4][2], B0[2][2], B1[2][2];
    const char* cA = (const char*)g.A + (size_t)cur.pm * tstepA; const char* cB = (const char*)g.Bt + (size_t)cur.pn * tstep;
    S.a_ready(cur);
    if constexpr (SP2) {
        PG8_STAGE(PG8_SB(0, 0), cB, voffB); PG8_STAGE(PG8_SB(0, 1), cB + hstep, voffB); PG8_STAGE(PG8_SA(0, 0), cA, voffA); PG8_STAGE(PG8_SA(0, 1), cA + hstepA, voffA);
        if (wr == 1) PG8_BAR;
        PG8_WAIT_V(2); PG8_BAR;
        PG8_STAGE(PG8_SB(1, 0), cB + kstep, voffB); PG8_STAGE(PG8_SA(1, 0), cA + kstep, voffA); PG8_STAGE(PG8_SB(1, 1), cB + hstep + kstep, voffB);
        PG8_WAIT_V(6); PG8_BAR;
    } else {
        PG8_STAGE(PG8_SB(0, 0), cB, voffB); PG8_STAGE(PG8_SA(0, 0), cA, voffA); PG8_STAGE(PG8_SB(0, 1), cB + hstep, voffB); PG8_STAGE(PG8_SA(0, 1), cA + hstepA, voffA);
        if (wr == 1) PG8_BAR;
        PG8_WAIT_V(4); PG8_BAR;
        PG8_STAGE(PG8_SB(1, 0), cB + kstep, voffB); PG8_STAGE(PG8_SA(1, 0), cA + kstep, voffA); PG8_STAGE(PG8_SB(1, 1), cB + hstep + kstep, voffB);
        PG8_WAIT_V(6); PG8_BAR;
    }
    for (;;) {
        const bool has_next = S.next(ui + 1, nxt);
        const char* nA = has_next ? (const char*)g.A + (size_t)nxt.pm * tstepA : cA; const char* nB = has_next ? (const char*)g.Bt + (size_t)nxt.pn * tstep : cB;
        for (int t = 0; t < nt; t += 2) {
            const bool last = (t == nt - 2);
            const char* a1 = cA + (size_t)(t + 1) * kstep;
            const char* a2 = last ? nA : cA + (size_t)(t + 2) * kstep; const char* b2 = last ? nB : cB + (size_t)(t + 2) * kstep;
            const char* a3 = a2 + kstep; const char* b3 = b2 + kstep;
            if (last && has_next) S.a_ready(nxt);
            if constexpr (SP2) {
            PG8_LDB(B0, 0, 0); PG8_LDB(B1, 0, 1); PG8_SCHED; PG8_LDA(At, 0, 0); PG8_STAGE(PG8_SA(1, 1), a1 + hstepA, voffA);
            PG8_WAIT_V(8); PG8_WAIT_L(0); PG8_BAR; PG8_MMA(0, 0, At, B0); PG8_MMA(0, 1, At, B1); PG8_BAR; PG8_SCHED;
            PG8_LDA(At, 0, 1); PG8_STAGE(PG8_SB(0, 0), b2, voffB); PG8_STAGE(PG8_SB(0, 1), b2 + hstep, voffB); PG8_STAGE(PG8_SA(0, 0), a2, voffA);
            PG8_WAIT_V(8); PG8_WAIT_L(0); PG8_BAR; PG8_MMA(1, 0, At, B0); PG8_MMA(1, 1, At, B1); PG8_BAR; PG8_SCHED;
            PG8_LDB(B0, 1, 0); PG8_LDB(B1, 1, 1); PG8_SCHED; PG8_LDA(At, 1, 0); PG8_STAGE(PG8_SA(0, 1), a2 + hstepA, voffA);
            PG8_WAIT_V(8); PG8_WAIT_L(0); PG8_BAR; PG8_MMA(0, 0, At, B0); PG8_MMA(0, 1, At, B1); PG8_BAR; PG8_SCHED;
            PG8_LDA(At, 1, 1); PG8_STAGE(PG8_SB(1, 0), b3, voffB); PG8_STAGE(PG8_SB(1, 1), b3 + hstep, voffB); PG8_STAGE(PG8_SA(1, 0), a3, voffA);
            PG8_WAIT_V(8); PG8_WAIT_L(0); PG8_BAR; PG8_MMA(1, 0, At, B0); PG8_MMA(1, 1, At, B1); PG8_BAR; PG8_SCHED;
            } else {
            PG8_LDB(B0, 0, 0); PG8_SCHED; PG8_LDA(At, 0, 0); PG8_STAGE(PG8_SA(1, 1), a1 + hstepA, voffA);
            PG8_WAIT_L(8); PG8_BAR; PG8_WAIT_L(0); PG8_MMA(0, 0, At, B0); PG8_BAR; PG8_SCHED;
            PG8_LDB(B1, 0, 1); PG8_STAGE(PG8_SB(0, 0), b2, voffB);
            PG8_BAR; PG8_WAIT_L(0); PG8_MMA(0, 1, At, B1); PG8_BAR;
            PG8_LDA(At, 0, 1); PG8_STAGE(PG8_SA(0, 0), a2, voffA);
            PG8_BAR; PG8_WAIT_L(0); PG8_MMA(1, 0, At, B0); PG8_BAR; PG8_SCHED;
            PG8_STAGE(PG8_SB(0, 1), b2 + hstep, voffB);
            PG8_WAIT_V(6); PG8_BAR; PG8_MMA(1, 1, At, B1); PG8_BAR;
            PG8_LDB(B0, 1, 0); PG8_SCHED; PG8_LDA(At, 1, 0); PG8_STAGE(PG8_SA(0, 1), a2 + hstepA, voffA);
            PG8_WAIT_L(8); PG8_BAR; PG8_WAIT_L(0); PG8_MMA(0, 0, At, B0); PG8_BAR; PG8_SCHED;
            PG8_LDB(B1, 1, 1); PG8_STAGE(PG8_SB(1, 0), b3, voffB);
            PG8_BAR; PG8_WAIT_L(0); PG8_MMA(0, 1, At, B1); PG8_BAR;
            PG8_LDA(At, 1, 1); PG8_STAGE(PG8_SA(1, 0), a3, voffA);
            PG8_BAR; PG8_WAIT_L(0); PG8_MMA(1, 0, At, B0); PG8_BAR; PG8_SCHED;
            PG8_STAGE(PG8_SB(1, 1), b3 + hstep, voffB);
            PG8_WAIT_V(6); PG8_BAR; PG8_MMA(1, 1, At, B1); PG8_BAR;
            }
        }
        if constexpr (ALIGN_EPI) { if (wr == 0) PG8_BAR; }
        if constexpr (!Epi::AFTER_DRAIN) { E(acc, cur, wr, wc, fr, fq); S.done(cur); }
        if (!has_next) break;
#pragma unroll
        for (int a = 0; a < 2; ++a)
#pragma unroll
            for (int b = 0; b < 2; ++b)
#pragma unroll
                for (int m = 0; m < 4; ++m)
#pragma unroll
                    for (int n = 0; n < 2; ++n) acc[a][b][m][n] = (f32x4){0.f, 0.f, 0.f, 0.f};
        cur = nxt; cA = nA; cB = nB; ++ui;
        if constexpr (ALIGN_EPI) { if (wr == 1) PG8_BAR; }
    }
    PG8_WAIT_V(0);
    if constexpr (!ALIGN_EPI) { if (wr == 0) PG8_BAR; }
    PG8_BAR;
    if constexpr (Epi::AFTER_DRAIN) { E.fused(acc, cur, wr, wc, fr, fq, lds, wid, lane); S.done(cur); }
#undef PG8_SA
#undef PG8_SB
#undef PG8_STAGE
#undef PG8_LDA
#undef PG8_LDB
#undef PG8_MMA
#undef PG8_WAIT_V
#undef PG8_WAIT_L
#undef PG8_BAR
#undef PG8_SCHED
}
}

constexpr int NB = 32, T_ = 2048, DM = 1024, NTOK = NB * T_;
constexpr int NLAYER = 2;
constexpr int CIN = 10032, CPAD = 10240;
constexpr int FFH_ = 2816;
constexpr int NBC = 16, MC = NBC * T_, NCHUNK = NB / NBC, NSUB = NCHUNK + 1, NIT = NLAYER * NSUB;
constexpr int PPITCH = 6144;
static_assert(NBC == 16, "unit decodes below assume 16-batch chunks");
constexpr int PC_QR = 0, PC_KR = 1024, PC_VR = 2048, PC_GR = 4096, PC_QN = 6144, PC_KV = 7168, PC_MA = 7936, PC_MB = 8960, PC_GATE = 9984;
constexpr int NCMP = 127, NCMP_PAD = 128;
constexpr float LOG2E = 1.4426950408889634f;
constexpr float QSCALE = 0.125f * LOG2E;

constexpr size_t MiB = 1u << 20;
constexpr size_t WS_CTL = 0, CTL_ZERO_BYTES = 1 * MiB;
constexpr size_t WS_ROT = 1 * MiB;
constexpr size_t WS_RSTD = 1 * MiB + 256 * 1024;
constexpr size_t WS_ONES = 1 * MiB + 512 * 1024;
constexpr size_t WS_T5 = 3 * MiB;
constexpr size_t WS_CB = 3 * MiB + 64 * 1024;
constexpr size_t WS_WIN = 4 * MiB;
constexpr size_t WS_WORET = 44 * MiB;
constexpr size_t WS_WONSA = 52 * MiB;
constexpr size_t WS_WOUT = 56 * MiB;
constexpr size_t WS_WFFI = 60 * MiB;
constexpr size_t WS_WFFO = 82 * MiB;
constexpr size_t WS_WC1 = 93 * MiB;
constexpr size_t WS_WC2 = 97 * MiB;
constexpr size_t WS_H = 100 * MiB;
constexpr size_t WS_BIG = 228 * MiB;
constexpr size_t WS_QKR = 612 * MiB;
constexpr size_t WS_ON = 612 * MiB;
constexpr size_t WS_TMP = 676 * MiB;
constexpr size_t WS_VR = 740 * MiB;
constexpr size_t WS_MERGED = 868 * MiB;
constexpr size_t WS_HIDP = 868 * MiB;
constexpr size_t WS_KC = 932 * MiB;
constexpr size_t WS_GNS = 934 * MiB;
constexpr size_t WS_XC = 942 * MiB;
constexpr size_t WS_PART = 960 * MiB;
constexpr size_t WS_KVX = 966 * MiB;
constexpr size_t WS_END = 998 * MiB;
constexpr int CW_TMO = 0, CW_BAR = 4096, CW_Q = 16384;

constexpr int NWAVES = 8;
constexpr int RING_BYTES = 131072, LDS_BYTES = 147456, LDSCTL_OFF = LDS_BYTES - 1024, MISC_OFF = LDSCTL_OFF + 320;

typedef pg8::bf16_t bf16;
typedef float f32x4 __attribute__((ext_vector_type(4)));
typedef float f32x2 __attribute__((ext_vector_type(2)));
typedef unsigned u32x4 __attribute__((ext_vector_type(4)));
typedef unsigned u32x2 __attribute__((ext_vector_type(2)));
#define LAS __attribute__((address_space(3)))
#define GAS __attribute__((address_space(1)))
#define RLX_AGENT __ATOMIC_RELAXED, __HIP_MEMORY_SCOPE_AGENT
#define LDS_WAIT() asm volatile("s_waitcnt lgkmcnt(0)" ::: "memory")
#define VM_WAIT() asm volatile("s_waitcnt vmcnt(0)" ::: "memory")
typedef GAS unsigned gu32;

__device__ __forceinline__ unsigned f2bf(float f) { unsigned u = __builtin_bit_cast(unsigned, f); return (u + 0x7fffu + ((u >> 16) & 1u)) >> 16; }
typedef __bf16 hbf16x2 __attribute__((ext_vector_type(2)));
__device__ __forceinline__ unsigned pk2(float lo, float hi) { const f32x2 v = {lo, hi}; return __builtin_bit_cast(unsigned, __builtin_convertvector(v, hbf16x2)); }
__device__ __forceinline__ float bf2f(unsigned short h) { return __builtin_bit_cast(float, (unsigned)h << 16); }
__device__ __forceinline__ float bflo(unsigned w) { return __builtin_bit_cast(float, w << 16); }
__device__ __forceinline__ float bfhi(unsigned w) { return __builtin_bit_cast(float, w & 0xffff0000u); }
__device__ __forceinline__ float sigm(float x) { return __builtin_amdgcn_rcpf(1.f + __builtin_amdgcn_exp2f(-LOG2E * x)); }
__device__ __forceinline__ float silu(float x) { return x * __builtin_amdgcn_rcpf(1.f + __builtin_amdgcn_exp2f(-LOG2E * x)); }
__device__ __forceinline__ float shx(float v, int m, int lane) { return __builtin_bit_cast(float, __builtin_amdgcn_ds_bpermute((lane ^ m) << 2, __builtin_bit_cast(int, v))); }
__device__ __forceinline__ float wave_sum(float v, int lane) {
#pragma unroll
    for (int o = 1; o < 64; o <<= 1) v += shx(v, o, lane);
    return v;
}
__device__ __forceinline__ float wave_max(float v, int lane) {
#pragma unroll
    for (int o = 1; o < 64; o <<= 1) v = fmaxf(v, shx(v, o, lane));
    return v;
}

__device__ __forceinline__ float gelu_tanh_f(float x) { const float u = 0.7978845608028654f * (x + 0.044715f * x * x * x); const float e = __builtin_amdgcn_exp2f(2.f * 1.4426950408889634f * u); return x * (1.f - __builtin_amdgcn_rcpf(e + 1.f)); }
__device__ __forceinline__ float xsum4e(float x) {
    float a = x, b = x;
    asm volatile("s_nop 1\n\tv_permlane16_swap_b32 %0, %1" : "+v"(a), "+v"(b));
    a = a + b; b = a;
    asm volatile("s_nop 1\n\tv_permlane32_swap_b32 %0, %1" : "+v"(a), "+v"(b));
    return a + b;
}
namespace epi {
using pg8::Unit;
__device__ __forceinline__ u32x4 pack8(const f32x4 a, const f32x4 b) { u32x4 w; w.x = pk2(a[0], a[1]); w.y = pk2(a[2], a[3]); w.z = pk2(b[0], b[1]); w.w = pk2(b[2], b[3]); return w; }
__device__ __forceinline__ void unpack8(const u32x4 w, f32x4& a, f32x4& b) { a = (f32x4){bflo(w.x), bfhi(w.x), bflo(w.y), bfhi(w.y)}; b = (f32x4){bflo(w.z), bfhi(w.z), bflo(w.w), bfhi(w.w)}; }

struct EpiInProj {
    static constexpr bool PERM = true, AFTER_DRAIN = false;
    bf16* O; const float* rot; bf16* XC; bf16* QKR; bf16* VR; bf16* KVX; const float* rstd;
    __device__ __forceinline__ void operator()(const f32x4 (&acc_)[2][2][4][2], const Unit& u, int wr, int wc, int fr, int fq) const {
        const int pn = u.pn, row0 = u.pm * 256 + wr * 64 + fr, colw = wc * 32 + 8 * fq;
        float rs_[2][4];
#pragma unroll
        for (int ai = 0; ai < 2; ++ai)
#pragma unroll
            for (int m = 0; m < 4; ++m) rs_[ai][m] = rstd[row0 + ai * 128 + m * 16];
#define acc(ai, bj, m, n) (acc_[ai][bj][m][n] * rs_[ai][m])
        bf16* base = O + (size_t)row0 * PPITCH + pn * 256 + colw;
        if (pn < 8) {
            const float sc = pn >= 4 ? 0.0625f : 1.f;
            const f32x4 fq8[2] = {*(const f32x4*)(rot + colw), *(const f32x4*)(rot + colw + 4)};
#pragma unroll
            for (int ai = 0; ai < 2; ++ai)
#pragma unroll
                for (int m = 0; m < 4; ++m) {
                    const int row = row0 + ai * 128 + m * 16, pos = row & (T_ - 1);
                    f32x4 y1[2], y2[2];
#pragma unroll
                    for (int n = 0; n < 2; ++n) { const f32x4 rev = fq8[n] * (float)pos; f32x4 c, s;
#pragma unroll
                        for (int i = 0; i < 4; ++i) { const float r_ = __builtin_amdgcn_fractf(rev[i]); c[i] = __builtin_amdgcn_cosf(r_); s[i] = __builtin_amdgcn_sinf(r_); }
                        const f32x4 x1 = acc(ai, 0, m, n), x2 = acc(ai, 1, m, n);
                        y1[n] = (x1 * c - x2 * s) * sc; y2[n] = (x1 * s + x2 * c) * sc; }
                    bf16* rp = QKR + ((size_t)(((pn >> 2) * NBC + (row >> 11)) * 4 + (pn & 3)) * T_ + pos) * 256 + colw;
                    *(u32x4*)(rp) = pack8(y1[0], y1[1]); *(u32x4*)(rp + 128) = pack8(y2[0], y2[1]);
                }
        } else if (pn < 16) {
            const int h2 = (pn - 8) >> 1, d0 = (wc & 1) * 32 + 8 * fq;
#pragma unroll
            for (int ai = 0; ai < 2; ++ai)
#pragma unroll
                for (int m = 0; m < 4; ++m) { const int row = row0 + ai * 128 + m * 16, bb = row >> 11, t = row & (T_ - 1);
#pragma unroll
                    for (int bj = 0; bj < 2; ++bj) { const int es = ((pn - 8) & 1) * 4 + 2 * bj + (wc >> 1);
                        *(u32x4*)(VR + ((size_t)((bb * 4 + h2) * 8 + es) * T_ + t) * 64 + d0) = pack8(acc(ai, bj, m, 0), acc(ai, bj, m, 1)); } }
        } else if (pn == 29 || pn == 30) {
            const int g2 = wc >> 1, d0 = (wc & 1) * 32 + 8 * fq;
#pragma unroll
            for (int ai = 0; ai < 2; ++ai)
#pragma unroll
                for (int m = 0; m < 4; ++m) { const int row = row0 + ai * 128 + m * 16, bb = row >> 11, t = row & (T_ - 1);
#pragma unroll
                    for (int bj = 0; bj < 2; ++bj) *(u32x4*)(KVX + ((size_t)((((pn - 29) * 2 + bj) * NBC + bb) * 2 + g2) * T_ + t) * 64 + d0) = pack8(acc(ai, bj, m, 0), acc(ai, bj, m, 1)); }
        } else if (pn == 28) {
            const int g2 = wc >> 1, d0 = (wc & 1) * 32 + 8 * fq;
#pragma unroll
            for (int ai = 0; ai < 2; ++ai)
#pragma unroll
                for (int m = 0; m < 4; ++m) { const int row = row0 + ai * 128 + m * 16, bb = row >> 11, t = row & (T_ - 1);
#pragma unroll
                    for (int bj = 0; bj < 2; ++bj) *(u32x4*)(XC + ((size_t)((bj * NBC + bb) * 2 + g2) * T_ + t) * 64 + d0) = pack8(acc(ai, bj, m, 0), acc(ai, bj, m, 1)); }
        } else {
            const int mode = (pn >= 24 && pn < 28) ? 2 : (pn >= 31) ? 3 : 0;
#pragma unroll
            for (int ai = 0; ai < 2; ++ai)
#pragma unroll
                for (int m = 0; m < 4; ++m) { bf16* rp = base + (size_t)(ai * 128 + m * 16) * PPITCH;
#pragma unroll
                    for (int bj = 0; bj < 2; ++bj) { f32x4 v0 = acc(ai, bj, m, 0), v1 = acc(ai, bj, m, 1);
                        if (mode == 1) {
#pragma unroll
                            for (int i = 0; i < 4; ++i) { v0[i] = silu(v0[i]); v1[i] = silu(v1[i]); } }
                        else if (mode == 2) { v0 = v0 * QSCALE; v1 = v1 * QSCALE; }
                        else if (mode == 3) {
#pragma unroll
                            for (int i = 0; i < 4; ++i) { v0[i] = sigm(v0[i]); v1[i] = sigm(v1[i]); } }
                        *(u32x4*)(rp + bj * 128) = pack8(v0, v1); } }
        }
    }
};
#undef acc
template <bool ADD> struct EpiGate {
    static constexpr bool PERM = true, AFTER_DRAIN = false;
    bf16* O; const bf16* P; const bf16* G; int ldo, ldg;
    __device__ __forceinline__ void operator()(const f32x4 (&acc)[2][2][4][2], const Unit& u, int wr, int wc, int fr, int fq) const {
        const int row0 = u.pm * 256 + wr * 64 + fr, col0 = u.pn * 256 + wc * 32 + 8 * fq;
#pragma unroll
        for (int ai = 0; ai < 2; ++ai)
#pragma unroll
            for (int m = 0; m < 4; ++m) { const size_t r = (size_t)(row0 + ai * 128 + m * 16);
#pragma unroll
                for (int bj = 0; bj < 2; ++bj) { const int c = col0 + bj * 128;
                    f32x4 g0, g1; unpack8(*(const u32x4*)(G + r * ldg + c), g0, g1);
                    f32x4 v0 = acc[ai][bj][m][0] * g0, v1 = acc[ai][bj][m][1] * g1;
                    if (ADD) { f32x4 p0, p1; unpack8(*(const u32x4*)(P + r * ldo + c), p0, p1); v0 += p0; v1 += p1; }
                    *(u32x4*)(O + r * ldo + c) = pack8(v0, v1); } }
    }
};
template <bool SRC_F32> struct EpiResid {
    static constexpr bool PERM = true, AFTER_DRAIN = false;
    const void* src; bf16* out; float* part;
    __device__ __forceinline__ void operator()(const f32x4 (&acc)[2][2][4][2], const Unit& u, int wr, int wc, int fr, int fq) const {
        const int row0 = u.pm * 256 + wr * 64 + fr, col0 = u.pn * 256 + wc * 32 + 8 * fq;
#pragma unroll
        for (int ai = 0; ai < 2; ++ai)
#pragma unroll
            for (int m = 0; m < 4; ++m) { const size_t off = (size_t)(row0 + ai * 128 + m * 16) * DM + col0; float ss = 0.f;
#pragma unroll
                for (int bj = 0; bj < 2; ++bj) { f32x4 s0, s1;
                    if (SRC_F32) { s0 = *(const f32x4*)((const float*)src + off + bj * 128); s1 = *(const f32x4*)((const float*)src + off + bj * 128 + 4); }
                    else unpack8(*(const u32x4*)((const bf16*)src + off + bj * 128), s0, s1);
                    s0 += acc[ai][bj][m][0]; s1 += acc[ai][bj][m][1];
                    ss += ((s0[0] * s0[0] + s0[1] * s0[1]) + (s0[2] * s0[2] + s0[3] * s0[3])) + ((s1[0] * s1[0] + s1[1] * s1[1]) + (s1[2] * s1[2] + s1[3] * s1[3]));
                    *(u32x4*)(out + off + bj * 128) = pack8(s0, s1); }
                ss = xsum4e(ss);
                if (fq == 0) part[(size_t)(row0 + ai * 128 + m * 16) * 16 + u.pn * 4 + wc] = ss; }
    }
};
struct EpiSwiGlu {
    static constexpr bool PERM = true, AFTER_DRAIN = false;
    bf16* O; const float* rstd;
    __device__ __forceinline__ void operator()(const f32x4 (&acc)[2][2][4][2], const Unit& u, int wr, int wc, int fr, int fq) const {
        const int row0 = u.pm * 256 + wr * 64 + fr, col0 = u.pn * 128 + wc * 32 + 8 * fq;
        float rs_[2][4];
#pragma unroll
        for (int ai = 0; ai < 2; ++ai)
#pragma unroll
            for (int m = 0; m < 4; ++m) rs_[ai][m] = rstd[row0 + ai * 128 + m * 16];
#pragma unroll
        for (int ai = 0; ai < 2; ++ai)
#pragma unroll
            for (int m = 0; m < 4; ++m) { f32x4 v[2];
#pragma unroll
                for (int n = 0; n < 2; ++n) { const f32x4 a = acc[ai][0][m][n] * rs_[ai][m], b = acc[ai][1][m][n] * rs_[ai][m];
#pragma unroll
                    for (int i = 0; i < 4; ++i) v[n][i] = silu(a[i]) * b[i]; }
                *(u32x4*)(O + (size_t)(row0 + ai * 128 + m * 16) * FFH_ + col0) = pack8(v[0], v[1]); }
    }
};
struct CmpOrder {
    int c, G;
    __device__ __forceinline__ bool next(int i, Unit& u) const { const int id = i * G + c; if (id >= 16 * NBC) return false; const int rt = (id >> 3) & (NBC - 1), kv = id / (8 * NBC); u.pm = kv * NBC + rt; u.pn = kv; return true; }
    __device__ __forceinline__ void a_ready(const Unit&) const {}
    __device__ __forceinline__ void done(const Unit&) const {}
};
struct EpiCmpPart {
    static constexpr bool PERM = false, AFTER_DRAIN = false;
    float* HIDP; int ks;
    __device__ __forceinline__ void operator()(const f32x4 (&acc)[2][2][4][2], const Unit& u, int wr, int wc, int fr, int fq) const {
        const int row0 = u.pm * 256 + wr * 64 + fr, col0 = wc * 32 + 4 * fq;
        float* base = HIDP + ((size_t)ks * (NBC * 512) + row0) * 256 + col0;
#pragma unroll
        for (int ai = 0; ai < 2; ++ai)
#pragma unroll
            for (int m = 0; m < 4; ++m)
#pragma unroll
                for (int bj = 0; bj < 2; ++bj)
#pragma unroll
                    for (int n = 0; n < 2; ++n) *(f32x4*)(base + (size_t)(ai * 128 + m * 16) * 256 + bj * 128 + n * 16) = acc[ai][bj][m][n];
    }
};
}
#define XB_TMO      128
#define XB_XCNT(j)  (256  + 64 * (j))
#define XB_XSUB(j)  (1280 + 64 * (j))
#define XB_XGEN(j)  (2304 + 64 * (j))
#define XB_TOP      3328
#define XB_TOPGEN   3392
#define XCD_BAR_WORDS 3456
#define XB_SPIN_CAP (1u << 18)

__device__ __forceinline__ unsigned xb_ld(unsigned* p)              { return __hip_atomic_load(p, __ATOMIC_RELAXED, __HIP_MEMORY_SCOPE_AGENT); }
__device__ __forceinline__ unsigned xb_add(unsigned* p, unsigned v) { return __hip_atomic_fetch_add(p, v, __ATOMIC_RELAXED, __HIP_MEMORY_SCOPE_AGENT); }
__device__ __forceinline__ unsigned xb_xcc_id() { return (unsigned)__builtin_amdgcn_s_getreg((3 << 11) | 20) & 0xFu; }
#define XB_SPIN(cond, bar) do { unsigned _sp = 0; while (cond) { __builtin_amdgcn_s_sleep(1); \
    if ((++_sp & 255u) == 0u) { if (xb_ld(&(bar)[XB_TMO])) break; if (_sp > XB_SPIN_CAP) { atomicAdd(&(bar)[XB_TMO], 1u); break; } } } } while (0)

struct XcdBarrier {
    unsigned* bar; unsigned x;
    volatile LAS unsigned* st;
};

__device__ __forceinline__ XcdBarrier xcd_barrier_post(unsigned* bar, volatile LAS unsigned* st) {
    XcdBarrier b; b.bar = bar; b.x = xb_xcc_id(); b.st = st;
    if (threadIdx.x == 0) (void)xb_add(&bar[XB_XCNT(b.x)], 1u);
    return b;
}
__device__ __forceinline__ void xcd_barrier_complete(unsigned* bar, unsigned x, unsigned& nloc, unsigned& nx) {
    const unsigned G = gridDim.x * gridDim.y * gridDim.z;
    unsigned sum, cnt, mine, sp = 0u;
    for (;;) {
        sum = 0u; cnt = 0u; mine = 0u;
#pragma unroll
        for (unsigned j = 0; j < 16; ++j) { const unsigned c = xb_ld(&bar[XB_XCNT(j)]); sum += c; cnt += (c > 0u) ? 1u : 0u; mine = (j == x) ? c : mine; }
        if (sum == G) break;
        __builtin_amdgcn_s_sleep(1);
        if ((++sp & 255u) == 0u) { if (xb_ld(&bar[XB_TMO])) break; if (sp > XB_SPIN_CAP) { atomicAdd(&bar[XB_TMO], 1u); break; } }
    }
    nloc = mine > 0u ? mine : 1u; nx = cnt > 0u ? cnt : 1u;
}

__device__ __forceinline__ void xcd_barrier(const XcdBarrier& b, const bool tid0) {
    asm volatile("s_waitcnt vmcnt(0)" ::: "memory");
    __syncthreads();
    if (tid0) {
        unsigned* bar = b.bar;
        __builtin_amdgcn_s_waitcnt(0);
        unsigned nloc = b.st[0], nx = b.st[1];
        if (nloc == 0u) { xcd_barrier_complete(bar, b.x, nloc, nx); b.st[0] = nloc; b.st[1] = nx; }
        const unsigned old = xb_add(&bar[XB_XSUB(b.x)], 1u);
        const unsigned gen = old / nloc;
        if (old + 1u == (gen + 1u) * nloc) {
            __builtin_amdgcn_fence(__ATOMIC_RELEASE, "agent");
            asm volatile("s_waitcnt vmcnt(0)" ::: "memory");
            const unsigned og = xb_add(&bar[XB_TOP], 1u);
            const unsigned tg = og / nx;
            if (og + 1u == (tg + 1u) * nx) xb_add(&bar[XB_TOPGEN], 1u);
            else XB_SPIN(xb_ld(&bar[XB_TOPGEN]) == tg, bar);
            __builtin_amdgcn_fence(__ATOMIC_ACQUIRE, "agent");
            xb_add(&bar[XB_XGEN(b.x)], 1u);
            asm volatile("s_waitcnt vmcnt(0)" ::: "memory");
        } else {
            XB_SPIN(xb_ld(&bar[XB_XGEN(b.x)]) == gen, bar);
            __builtin_amdgcn_fence(__ATOMIC_ACQUIRE, "agent");
            asm volatile("s_waitcnt vmcnt(0)" ::: "memory");
        }
    }
    __syncthreads();
}

struct Args { const float* in[17]; float* out; unsigned char* ws; int it_lo, it_hi, ph_lo, ph_hi, flags, pad; };

struct Ctx { LAS unsigned char* lds; int tid, lane, wave, G, bid; };
typedef const __attribute__((address_space(4))) Args* KArgs;
__device__ __forceinline__ KArgs kargs() { unsigned long long p = (unsigned long long)__builtin_amdgcn_kernarg_segment_ptr(); asm volatile("" : "+s"(p)); return (KArgs)p; }
#define AP (kargs())

template <class Map>
__device__ __forceinline__ void p0_transpose_item(const float* W, int K, int Nsrc, bf16* WT, int ngrp, LAS float* scr, int item, int lane, const Map& map, const float* gk = nullptr) {
    const int kb = item / ngrp, nb = item % ngrp, k0 = 64 * kb, n0 = 32 * nb;
    const int sc = map(n0 + (lane & 31));
#pragma unroll
    for (int i = 0; i < 32; ++i) { const int kk = 2 * i + (lane >> 5); scr[kk * 33 + (lane & 31)] = sc >= 0 ? W[(size_t)(k0 + kk) * Nsrc + sc] * (gk ? gk[k0 + kk] : 1.f) : 0.f; }
    LDS_WAIT(); asm volatile("" ::: "memory");
    const int c = lane & 7;
#pragma unroll
    for (int j = 0; j < 4; ++j) { const int n = (lane >> 3) + 8 * j; const LAS float* s = scr + (8 * c) * 33 + n;
        u32x4 o; o.x = pk2(s[0 * 33], s[1 * 33]); o.y = pk2(s[2 * 33], s[3 * 33]); o.z = pk2(s[4 * 33], s[5 * 33]); o.w = pk2(s[6 * 33], s[7 * 33]);
        *(u32x4*)(WT + (size_t)(n0 + n) * K + k0 + 8 * c) = o; }
    LDS_WAIT(); asm volatile("" ::: "memory");
}
struct MapId { __device__ __forceinline__ int operator()(int n) const { return n; } };
struct MapWin { __device__ __forceinline__ int operator()(int n) const { return n < 7936 ? n : (n < 9984 ? n + 48 : (n < 10032 ? n - 2048 : -1)); } };
struct MapFfi { __device__ __forceinline__ int operator()(int n) const { const int pn = n >> 8, j = n & 255; return j < 128 ? 128 * pn + j : FFH_ + 128 * pn + (j - 128); } };

__device__ __forceinline__ void p0_prologue(const Ctx& C) {
    unsigned char* ws = AP->ws;
    LAS float* scr = (LAS float*)(C.lds + C.wave * 16384);
    const int gw = C.bid * NWAVES + C.wave, NGW = C.G * NWAVES;
    constexpr int I_IN = 16 * 320, I_OR = 32 * 32, I_ON = 16 * 32, I_OUT = 16 * 32, I_FI = 16 * 176, I_FO = 44 * 32, I_C1 = 32 * 8, I_L = I_IN + I_OR + I_ON + I_OUT + I_FI + I_FO + 2 * I_C1;
    for (int it = gw; it < NLAYER * I_L; it += NGW) {
        const int L = it / I_L; int r = it % I_L;
        if (r < I_IN) { p0_transpose_item(AP->in[2] + (size_t)L * DM * CIN, DM, CIN, (bf16*)(ws + WS_WIN) + (size_t)L * CPAD * DM, 320, scr, r, C.lane, MapWin(), L > 0 ? AP->in[1] + L * DM : nullptr); continue; } r -= I_IN;
        if (r < I_OR) { p0_transpose_item(AP->in[9] + (size_t)L * 2048 * DM, 2048, DM, (bf16*)(ws + WS_WORET) + (size_t)L * DM * 2048, 32, scr, r, C.lane, MapId()); continue; } r -= I_OR;
        if (r < I_ON) { p0_transpose_item(AP->in[10] + (size_t)L * DM * DM, DM, DM, (bf16*)(ws + WS_WONSA) + (size_t)L * DM * DM, 32, scr, r, C.lane, MapId()); continue; } r -= I_ON;
        if (r < I_OUT) { p0_transpose_item(AP->in[11] + (size_t)L * DM * DM, DM, DM, (bf16*)(ws + WS_WOUT) + (size_t)L * DM * DM, 32, scr, r, C.lane, MapId()); continue; } r -= I_OUT;
        if (r < I_FI) { p0_transpose_item(AP->in[13] + (size_t)L * DM * 2 * FFH_, DM, 2 * FFH_, (bf16*)(ws + WS_WFFI) + (size_t)L * 2 * FFH_ * DM, 176, scr, r, C.lane, MapFfi(), AP->in[12] + L * DM); continue; } r -= I_FI;
        if (r < I_FO) { p0_transpose_item(AP->in[14] + (size_t)L * FFH_ * DM, FFH_, DM, (bf16*)(ws + WS_WFFO) + (size_t)L * DM * FFH_, 32, scr, r, C.lane, MapId()); continue; } r -= I_FO;
        if (r < I_C1) { p0_transpose_item(AP->in[5] + (size_t)L * 2048 * 256, 2048, 256, (bf16*)(ws + WS_WC1) + (size_t)(L * 2 + 0) * 256 * 2048, 8, scr, r, C.lane, MapId()); continue; } r -= I_C1;
        p0_transpose_item(AP->in[7] + (size_t)L * 2048 * 256, 2048, 256, (bf16*)(ws + WS_WC1) + (size_t)(L * 2 + 1) * 256 * 2048, 8, scr, r, C.lane, MapId());
    }
    const int gt = C.bid * 512 + C.tid, NGT = C.G * 512;
    float* rot = (float*)(ws + WS_ROT);
    for (int i = gt; i < 128; i += NGT) rot[i] = (float)(pow(10000.0, -(double)i / 128.0) / 6.283185307179586476925);
    { float* ones = (float*)(ws + WS_ONES); for (int i = gt; i < NTOK; i += NGT) ones[i] = 1.f; }
    float* cbp = (float*)(ws + WS_CB);
    for (int i = gt; i < NLAYER * 2 * 256; i += NGT) { const int hid = i & 255, kv = (i >> 8) & 1, L = i >> 9; const float* pe = (kv ? AP->in[4] : AP->in[3]) + L * 2048; const float* w1 = (kv ? AP->in[7] : AP->in[5]) + (size_t)L * 2048 * 256 + hid;
        float s_ = 0.f; for (int k = 0; k < 2048; ++k) s_ += pe[k] * w1[(size_t)k * 256]; cbp[i] = s_; }
    float* t5 = (float*)(ws + WS_T5);
    for (int i = gt; i < 16 * 128; i += NGT) { const int hd = i >> 7, dist = i & 127; int bk = dist;
        if (dist >= 16) { bk = 16 + (int)(log((double)dist / 16.0) / log(8.0) * 16.0); if (bk > 31) bk = 31; }
        t5[i] = AP->in[15][bk * 16 + hd] * LOG2E; }
}

template <int NR>
__device__ __forceinline__ void rms_rows_to_bf16(const float* x, const float* g, bf16* o, int m, int stride, int lane) {
    f32x4 v[NR][4];
#pragma unroll
    for (int r = 0; r < NR; ++r) { const f32x4* xr = (const f32x4*)(x + (size_t)(m + r * stride) * DM) + lane;
#pragma unroll
        for (int j = 0; j < 4; ++j) v[r][j] = xr[64 * j]; }
    f32x4 gg[4];
#pragma unroll
    for (int j = 0; j < 4; ++j) gg[j] = ((const f32x4*)g + lane)[64 * j];
#pragma unroll
    for (int r = 0; r < NR; ++r) { float s = 0.f;
#pragma unroll
        for (int j = 0; j < 4; ++j) s += (v[r][j].x * v[r][j].x + v[r][j].y * v[r][j].y) + (v[r][j].z * v[r][j].z + v[r][j].w * v[r][j].w);
        const float rs = 1.f / sqrtf(wave_sum(s, lane) * (1.f / DM) + 1e-6f);
        u32x2* o8 = (u32x2*)(o + (size_t)(m + r * stride) * DM) + lane;
#pragma unroll
        for (int j = 0; j < 4; ++j) { u32x2 w; w.x = pk2(v[r][j].x * rs * gg[j].x, v[r][j].y * rs * gg[j].y); w.y = pk2(v[r][j].z * rs * gg[j].z, v[r][j].w * rs * gg[j].w); o8[64 * j] = w; } }
}
template <int NR>
__device__ __forceinline__ void rms_rows_bf16_to_bf16(const bf16* x, const float* g, bf16* o, int m, int stride, int lane) {
    u32x4 v[NR][2];
#pragma unroll
    for (int r = 0; r < NR; ++r) { const u32x4* xr = (const u32x4*)(x + (size_t)(m + r * stride) * DM) + 2 * lane; v[r][0] = xr[0]; v[r][1] = xr[1]; }
    f32x4 gg[4];
#pragma unroll
    for (int j = 0; j < 4; ++j) gg[j] = ((const f32x4*)g + 4 * lane)[j];
#pragma unroll
    for (int r = 0; r < NR; ++r) { f32x4 a[4]; epi::unpack8(v[r][0], a[0], a[1]); epi::unpack8(v[r][1], a[2], a[3]); float s = 0.f;
#pragma unroll
        for (int j = 0; j < 4; ++j) s += (a[j].x * a[j].x + a[j].y * a[j].y) + (a[j].z * a[j].z + a[j].w * a[j].w);
        const float rs = 1.f / sqrtf(wave_sum(s, lane) * (1.f / DM) + 1e-6f);
        u32x4* o8 = (u32x4*)(o + (size_t)(m + r * stride) * DM) + 2 * lane;
        o8[0] = epi::pack8(a[0] * rs * gg[0], a[1] * rs * gg[1]); o8[1] = epi::pack8(a[2] * rs * gg[2], a[3] * rs * gg[3]); }
}
__device__ __forceinline__ void rms_row_final(const bf16* xrow, const float* g, float* orow, int lane) {
    const u32x4* xr = (const u32x4*)xrow + 2 * lane; const u32x4 v0 = xr[0], v1 = xr[1]; f32x4 a[4]; epi::unpack8(v0, a[0], a[1]); epi::unpack8(v1, a[2], a[3]); float s = 0.f;
#pragma unroll
    for (int j = 0; j < 4; ++j) s += (a[j].x * a[j].x + a[j].y * a[j].y) + (a[j].z * a[j].z + a[j].w * a[j].w);
    const float rs = 1.f / sqrtf(wave_sum(s, lane) * (1.f / DM) + 1e-6f);
#pragma unroll
    for (int j = 0; j < 4; ++j) ((f32x4*)orow + 4 * lane)[j] = a[j] * rs * ((const f32x4*)g + 4 * lane)[j];
}
typedef short s16x4 __attribute__((ext_vector_type(4)));
typedef short bf16x8 __attribute__((ext_vector_type(8)));
#define MFMA16(a, b, c) __builtin_amdgcn_mfma_f32_16x16x32_bf16((a), (b), (c), 0, 0, 0)
constexpr int RK_PITCH = 528, RV_PITCH = 144, RR_PITCH = 528;
constexpr int RL_K = 0, RL_V = 128 * RK_PITCH, RL_R = RL_V + 128 * RV_PITCH, RL_END = RL_R + 64 * RR_PITCH;
static_assert(RL_END <= RING_BYTES, "retention LDS map");
__device__ __forceinline__ bf16x8 tr_frag(LAS unsigned char* tile, int pitch, int rowA, int rowB, int col0, int lane) {
    const int q = (lane & 15) >> 2, p = lane & 3;
    const s16x4 a = __builtin_amdgcn_ds_read_tr16_b64_v4i16((LAS s16x4*)(tile + (rowA + q) * pitch + (col0 + 4 * p) * 2));
    const s16x4 b = __builtin_amdgcn_ds_read_tr16_b64_v4i16((LAS s16x4*)(tile + (rowB + q) * pitch + (col0 + 4 * p) * 2));
    return __builtin_shufflevector(a, b, 0, 1, 2, 3, 4, 5, 6, 7);
}
__device__ __forceinline__ bf16x8 tr_frag2(LAS unsigned char* lb, int offA, int offB) {
    const s16x4 a = __builtin_amdgcn_ds_read_tr16_b64_v4i16((LAS s16x4*)(lb + offA));
    const s16x4 b = __builtin_amdgcn_ds_read_tr16_b64_v4i16((LAS s16x4*)(lb + offB));
    return __builtin_shufflevector(a, b, 0, 1, 2, 3, 4, 5, 6, 7);
}
__device__ __forceinline__ void tr_read16(unsigned a0, unsigned a1, unsigned a2, unsigned a3, s16x4 (&r)[16]) {
    asm volatile("ds_read_b64_tr_b16 %0, %16\n\tds_read_b64_tr_b16 %1, %16 offset:2048\n\tds_read_b64_tr_b16 %2, %16 offset:4096\n\tds_read_b64_tr_b16 %3, %16 offset:6144\n\t"
                 "ds_read_b64_tr_b16 %4, %17\n\tds_read_b64_tr_b16 %5, %17 offset:2048\n\tds_read_b64_tr_b16 %6, %17 offset:4096\n\tds_read_b64_tr_b16 %7, %17 offset:6144\n\t"
                 "ds_read_b64_tr_b16 %8, %18\n\tds_read_b64_tr_b16 %9, %18 offset:2048\n\tds_read_b64_tr_b16 %10, %18 offset:4096\n\tds_read_b64_tr_b16 %11, %18 offset:6144\n\t"
                 "ds_read_b64_tr_b16 %12, %19\n\tds_read_b64_tr_b16 %13, %19 offset:2048\n\tds_read_b64_tr_b16 %14, %19 offset:4096\n\tds_read_b64_tr_b16 %15, %19 offset:6144\n\t"
                 "s_waitcnt lgkmcnt(0)"
                 : "=&v"(r[0]), "=&v"(r[1]), "=&v"(r[2]), "=&v"(r[3]), "=&v"(r[4]), "=&v"(r[5]), "=&v"(r[6]), "=&v"(r[7]),
                   "=&v"(r[8]), "=&v"(r[9]), "=&v"(r[10]), "=&v"(r[11]), "=&v"(r[12]), "=&v"(r[13]), "=&v"(r[14]), "=&v"(r[15])
                 : "v"(a0), "v"(a1), "v"(a2), "v"(a3) : "memory");
}
__device__ __forceinline__ bf16x8 pack_bf8(const f32x4 a, const f32x4 b) { u32x4 w; w.x = pk2(a[0], a[1]); w.y = pk2(a[2], a[3]); w.z = pk2(b[0], b[1]); w.w = pk2(b[2], b[3]); return __builtin_bit_cast(bf16x8, w); }

__device__ __forceinline__ void ret_unit(const Ctx& C, int u, const bf16* QKR, const bf16* VR, bf16* ORET, float* GNP) {
    const int es = u & 7, h = (u >> 3) & 3, b = u >> 5;
    const int lane = C.lane, w = C.wave, i16 = lane & 15, g = lane >> 4, tid = C.tid;
    LAS unsigned char* lds = C.lds;
    const size_t tok0 = (size_t)b * T_;
    const float l2g = log2f(1.f - exp2f(-5.f - (float)h));
    const float xi = exp2f(l2g * (float)(w * 16 + i16 + 1));
    const float gchunk = exp2f(l2g * 128.f);
    float dbase[4];
#pragma unroll
    for (int r = 0; r < 4; ++r) dbase[r] = exp2f(l2g * (float)(i16 - 4 * g - r));
    f32x4 racc[2][4];
#pragma unroll
    for (int dt = 0; dt < 2; ++dt)
#pragma unroll
        for (int et = 0; et < 4; ++et) racc[dt][et] = (f32x4){0.f, 0.f, 0.f, 0.f};
    u32x4 stK[8], stV[2]; bf16x8 qfrag[8];
    const unsigned kvo = (unsigned)(tid >> 5) * 512u + (unsigned)(tid & 31) * 16u, vvo = (unsigned)(tid >> 3) * 128u + (unsigned)(tid & 7) * 16u;
    const unsigned qvo = (unsigned)(w * 16 + i16) * 512u + (unsigned)g * 16u;
    const int klo = RL_K + (tid >> 5) * RK_PITCH + (tid & 31) * 16, vlo = RL_V + (tid >> 3) * RV_PITCH + (tid & 7) * 16;
    const char* kch = (const char*)(QKR + ((size_t)((1 * NBC + b) * 4 + h) * T_) * 256);
    const char* vch = (const char*)(VR + ((size_t)((b * 4 + h) * 8 + es) * T_) * 64);
    const char* qch = (const char*)(QKR + ((size_t)((0 * NBC + b) * 4 + h) * T_) * 256);
#pragma unroll
    for (int i = 0; i < 8; ++i) stK[i] = *(const u32x4*)(kch + (size_t)i * 16 * 512 + kvo);
#pragma unroll
    for (int i = 0; i < 2; ++i) stV[i] = *(const u32x4*)(vch + (size_t)i * 64 * 128 + vvo);
#pragma unroll
    for (int kb = 0; kb < 8; ++kb) qfrag[kb] = *(const bf16x8*)(qch + kb * 64 + qvo);
#pragma unroll
    for (int i = 0; i < 8; ++i) *(LAS u32x4*)(lds + klo + i * 16 * RK_PITCH) = stK[i];
#pragma unroll
    for (int i = 0; i < 2; ++i) *(LAS u32x4*)(lds + vlo + i * 64 * RV_PITCH) = stV[i];
    __syncthreads();
    for (int c = 0; c < 16; ++c) {
        const bool more = c + 1 < 16;
        int lane_c = lane; float l2c = l2g; asm volatile("" : "+v"(lane_c), "+v"(l2c));
        const int i16 = lane_c & 15, g = lane_c >> 4;
        const char* kn = kch + (size_t)(c + 1) * 128 * 512; const char* vn = vch + (size_t)(c + 1) * 128 * 128; const char* qn = qch + (size_t)(c + 1) * 128 * 512;
        if (more) {
#pragma unroll
            for (int i = 0; i < 8; ++i) stK[i] = *(const u32x4*)(kn + (size_t)i * 16 * 512 + kvo);
#pragma unroll
            for (int i = 0; i < 2; ++i) stV[i] = *(const u32x4*)(vn + (size_t)i * 64 * 128 + vvo);
        }
        f32x4 oacc[4];
#pragma unroll
        for (int et = 0; et < 4; ++et) oacc[et] = (f32x4){0.f, 0.f, 0.f, 0.f};
        if (c > 0) {
            LAS unsigned char* rl_ = lds + RL_R + i16 * RR_PITCH + g * 16;
#pragma unroll
            for (int hf = 0; hf < 2; ++hf) { bf16x8 rf[4][4];
#pragma unroll
                for (int k = 0; k < 4; ++k)
#pragma unroll
                    for (int et = 0; et < 4; ++et) rf[et][k] = *(const LAS bf16x8*)(rl_ + et * 16 * RR_PITCH + (hf * 4 + k) * 64);
                __builtin_amdgcn_sched_barrier(0);
#pragma unroll
                for (int k = 0; k < 4; ++k)
#pragma unroll
                    for (int et = 0; et < 4; ++et) oacc[et] = MFMA16(rf[et][k], qfrag[hf * 4 + k], oacc[et]); }
#pragma unroll
            for (int et = 0; et < 4; ++et) oacc[et] = oacc[et] * xi;
        }
        for (int i = 0; i <= (w >> 1); ++i) {
            const int mb0 = 2 * i, mb1 = 2 * i + 1;
            f32x4 sa0 = (f32x4){0.f, 0.f, 0.f, 0.f}, sa1 = sa0, sb0 = sa0, sb1 = sa0;
            LAS unsigned char* kl_ = lds + RL_K + (mb0 * 16 + i16) * RK_PITCH + g * 16;
            { bf16x8 kf[8];
#pragma unroll
              for (int kb = 0; kb < 8; ++kb) kf[kb] = *(const LAS bf16x8*)(kl_ + kb * 64);
              __builtin_amdgcn_sched_barrier(0);
#pragma unroll
              for (int kb = 0; kb < 8; kb += 2) { sa0 = MFMA16(kf[kb], qfrag[kb], sa0); sa1 = MFMA16(kf[kb + 1], qfrag[kb + 1], sa1); } }
            if (mb1 <= w) { bf16x8 kf[8];
#pragma unroll
                for (int kb = 0; kb < 8; ++kb) kf[kb] = *(const LAS bf16x8*)(kl_ + 16 * RK_PITCH + kb * 64);
                __builtin_amdgcn_sched_barrier(0);
#pragma unroll
                for (int kb = 0; kb < 8; kb += 2) { sb0 = MFMA16(kf[kb], qfrag[kb], sb0); sb1 = MFMA16(kf[kb + 1], qfrag[kb + 1], sb1); } }
            f32x4 sa = sa0 + sa1, sb = sb0 + sb1;
            const float ga = exp2f(l2c * (float)(16 * (w - mb0))), gb = exp2f(l2c * (float)(16 * (w - mb1)));
#pragma unroll
            for (int r = 0; r < 4; ++r) { const bool da = (mb0 < w) || (i16 - 4 * g - r >= 0), db = (mb1 < w) || (i16 - 4 * g - r >= 0);
                sa[r] = da ? sa[r] * (dbase[r] * ga) : 0.f; sb[r] = (mb1 <= w && db) ? sb[r] * (dbase[r] * gb) : 0.f; }
            const bf16x8 sf = pack_bf8(sa, sb);
            bf16x8 vf[4];
#pragma unroll
            for (int et = 0; et < 4; ++et) vf[et] = tr_frag(lds + RL_V, RV_PITCH, mb0 * 16 + 4 * g, mb1 * 16 + 4 * g, et * 16, lane_c);
            __builtin_amdgcn_sched_barrier(0);
#pragma unroll
            for (int et = 0; et < 4; ++et) oacc[et] = MFMA16(vf[et], sf, oacc[et]);
        }
        { const size_t tok = tok0 + (size_t)c * 128 + w * 16 + i16; float s1 = 0.f, s2 = 0.f;
#pragma unroll
          for (int et = 0; et < 4; ++et) { const f32x4 o = oacc[et]; s1 += (o[0] + o[1]) + (o[2] + o[3]); s2 += (o[0] * o[0] + o[1] * o[1]) + (o[2] * o[2] + o[3] * o[3]);
              u32x2 wv; wv.x = pk2(o[0], o[1]); wv.y = pk2(o[2], o[3]); *(u32x2*)(ORET + tok * 2048 + h * 512 + es * 64 + et * 16 + 4 * g) = wv; }
          s1 += shx(s1, 16, lane_c); s1 += shx(s1, 32, lane_c); s2 += shx(s2, 16, lane_c); s2 += shx(s2, 32, lane_c);
          if (g == 0) *(f32x2*)(GNP + ((tok * 4 + h) * 8 + es) * 2) = (f32x2){s1, s2}; }
        if (more) {
#pragma unroll
            for (int kb = 0; kb < 8; ++kb) qfrag[kb] = *(const bf16x8*)(qn + kb * 64 + qvo);
        }
#pragma unroll
        for (int dt = 0; dt < 2; ++dt)
#pragma unroll
            for (int et = 0; et < 4; ++et) racc[dt][et] = racc[dt][et] * gchunk;
#pragma unroll
        for (int kb = 0; kb < 4; ++kb) {
            float zl[8];
#pragma unroll
            for (int j = 0; j < 8; ++j) zl[j] = __builtin_amdgcn_exp2f(l2c * (float)(127 - 32 * kb - 8 * g - j));
            bf16x8 raw[2], vf[4];
#pragma unroll
            for (int dt = 0; dt < 2; ++dt) raw[dt] = tr_frag(lds + RL_K, RK_PITCH, kb * 32 + 8 * g, kb * 32 + 8 * g + 4, (2 * w + dt) * 16, lane_c);
#pragma unroll
            for (int et = 0; et < 4; ++et) vf[et] = tr_frag(lds + RL_V, RV_PITCH, kb * 32 + 8 * g, kb * 32 + 8 * g + 4, et * 16, lane_c);
            __builtin_amdgcn_sched_barrier(0);
            bf16x8 af[2];
#pragma unroll
            for (int dt = 0; dt < 2; ++dt) { const u32x4 rw = __builtin_bit_cast(u32x4, raw[dt]); u32x4 o;
                o.x = pk2(bflo(rw.x) * zl[0], bfhi(rw.x) * zl[1]); o.y = pk2(bflo(rw.y) * zl[2], bfhi(rw.y) * zl[3]);
                o.z = pk2(bflo(rw.z) * zl[4], bfhi(rw.z) * zl[5]); o.w = pk2(bflo(rw.w) * zl[6], bfhi(rw.w) * zl[7]);
                af[dt] = __builtin_bit_cast(bf16x8, o); }
#pragma unroll
            for (int et = 0; et < 4; ++et)
#pragma unroll
                for (int dt = 0; dt < 2; ++dt) racc[dt][et] = MFMA16(af[dt], vf[et], racc[dt][et]);
        }
        __syncthreads();
        if (more) {
#pragma unroll
            for (int dt = 0; dt < 2; ++dt)
#pragma unroll
                for (int et = 0; et < 4; ++et) { const f32x4 rv = racc[dt][et]; u32x2 wv; wv.x = pk2(rv[0], rv[1]); wv.y = pk2(rv[2], rv[3]);
                    *(LAS u32x2*)(lds + RL_R + (et * 16 + i16) * RR_PITCH + ((2 * w + dt) * 16 + 4 * g) * 2) = wv; }
#pragma unroll
            for (int i = 0; i < 8; ++i) *(LAS u32x4*)(lds + klo + i * 16 * RK_PITCH) = stK[i];
#pragma unroll
            for (int i = 0; i < 2; ++i) *(LAS u32x4*)(lds + vlo + i * 64 * RV_PITCH) = stV[i];
        }
        __syncthreads();
    }
}
template <int NR>
__device__ __forceinline__ void gn_gate_rows(const bf16* PROJ, bf16* ORET, const float* GNP, int m, int stride, int lane) {
    u32x4 ow[NR][4], gw[NR][4]; f32x4 st[NR][4];
#pragma unroll
    for (int r = 0; r < NR; ++r) { const size_t tok = (size_t)(m + r * stride);
#pragma unroll
        for (int h = 0; h < 4; ++h) { ow[r][h] = *(const u32x4*)(ORET + tok * 2048 + h * 512 + lane * 8); gw[r][h] = *(const u32x4*)(PROJ + tok * PPITCH + PC_GR + h * 512 + lane * 8);
            st[r][h] = *((const f32x4*)(GNP + (tok * 4 + h) * 16) + (lane & 3)); } }
#pragma unroll
    for (int r = 0; r < NR; ++r) { const size_t tok = (size_t)(m + r * stride);
#pragma unroll
        for (int h = 0; h < 4; ++h) { float s1 = st[r][h][0] + st[r][h][2], s2 = st[r][h][1] + st[r][h][3];
            s1 += shx(s1, 1, lane); s2 += shx(s2, 1, lane); s1 += shx(s1, 2, lane); s2 += shx(s2, 2, lane);
            const float mean = s1 * (1.f / 512.f), var = fmaxf(s2 * (1.f / 512.f) - mean * mean, 0.f), rstd = 1.f / sqrtf(var + 1e-5f);
            const u32x4 a = ow[r][h], g = gw[r][h]; u32x4 o;
            o.x = pk2((bflo(a.x) - mean) * rstd * silu(bflo(g.x)), (bfhi(a.x) - mean) * rstd * silu(bfhi(g.x))); o.y = pk2((bflo(a.y) - mean) * rstd * silu(bflo(g.y)), (bfhi(a.y) - mean) * rstd * silu(bfhi(g.y)));
            o.z = pk2((bflo(a.z) - mean) * rstd * silu(bflo(g.z)), (bfhi(a.z) - mean) * rstd * silu(bfhi(g.z))); o.w = pk2((bflo(a.w) - mean) * rstd * silu(bflo(g.w)), (bfhi(a.w) - mean) * rstd * silu(bfhi(g.w)));
            *(u32x4*)(ORET + tok * 2048 + h * 512 + lane * 8) = o; } }
}


constexpr int NL_T5 = 0, NL_T5H = 384, NL_TILE = 64 * 144, NL_K0 = 8 * NL_T5H * 4, NL_V0 = NL_K0 + 2 * NL_TILE, NL_IMP = NL_K0 + 4 * NL_TILE, NL_XCH = NL_IMP + 8 * 64 * 33 * 4, NL_SEL = NL_XCH + 8 * 512 * 4, NL_GATE = NL_SEL + 512, NL_END = NL_GATE + 3 * 8 * 64 * 4;
constexpr int NL_RING = NL_K0, NL_SLOT = 16384, NL_Q = NL_RING + 3 * NL_SLOT;
static_assert(NL_Q + 8 * 8192 <= NL_SEL && NL_END <= LDSCTL_OFF, "NSA LDS map");
__device__ __forceinline__ float xmax4(float x) {
    float a = x, b = x;
    asm volatile("s_nop 1\n\tv_permlane16_swap_b32 %0, %1" : "+v"(a), "+v"(b));
    a = fmaxf(a, b); b = a;
    asm volatile("s_nop 1\n\tv_permlane32_swap_b32 %0, %1" : "+v"(a), "+v"(b));
    return fmaxf(a, b);
}
__device__ __forceinline__ float xsum4(float x) {
    float a = x, b = x;
    asm volatile("s_nop 1\n\tv_permlane16_swap_b32 %0, %1" : "+v"(a), "+v"(b));
    a = a + b; b = a;
    asm volatile("s_nop 1\n\tv_permlane32_swap_b32 %0, %1" : "+v"(a), "+v"(b));
    return a + b;
}
__device__ __forceinline__ int ishx(int v, int m, int lane) { return __builtin_amdgcn_ds_bpermute((lane ^ m) << 2, v); }

__device__ __forceinline__ void nsa_unit(const Ctx& C, int u, const bf16* PROJ, const bf16* KVX, const bf16* KCV, const float* t5, bf16* ON) {
    const int j_ = u >> 5, k_ = j_ & 7, r_ = j_ >> 3, qb = r_ == 0 ? 31 - k_ : r_ == 1 ? k_ : r_ == 2 ? 23 - k_ : 8 + k_, bg = u & 31, g_ = bg & 1, b = bg >> 1;
    int tid_u = C.tid; asm volatile("" : "+v"(tid_u));
    const int w = C.wave, tid = tid_u, lane = tid & 63, head = g_ * 8 + w, s0 = qb * 64, i16 = lane & 15, g = lane >> 4;
    LAS unsigned char* lds = C.lds;
    const size_t tok0 = (size_t)b * T_;
    LAS float* T5L = (LAS float*)(lds + NL_T5) + w * NL_T5H;
    LAS float* impH = (LAS float*)(lds + NL_IMP);
    LAS unsigned* selm = (LAS unsigned*)(lds + NL_SEL);
    for (int i = tid; i < 8 * NL_T5H; i += 512) { const int hh = i / NL_T5H, k = i - hh * NL_T5H; const float* th_ = t5 + (g_ * 8 + hh) * 128; float v;
        if (k < 256) { const int d = k - 64; v = d < 0 ? -1e30f : th_[d > 127 ? 127 : d]; } else v = (k - 256) < 64 ? th_[127] : -1e30f;
        ((LAS float*)(lds + NL_T5))[i] = v; }
    for (int i = tid; i < 64 * 24; i += 512) { const int tk = i / 24, c = i - tk * 24, hh = c / 3, br = c - hh * 3;
        ((LAS float*)(lds + NL_GATE))[(br * 8 + hh) * 64 + tk] = bf2f(PROJ[(tok0 + s0 + tk) * PPITCH + PC_GATE + g_ * 24 + c]); }
    { const bf16* kc = KCV + ((size_t)((0 * NBC + b) * 2 + g_) * NCMP_PAD) * 64; const bf16* vc = KCV + ((size_t)((1 * NBC + b) * 2 + g_) * NCMP_PAD) * 64;
#pragma unroll
      for (int i = 0; i < 2; ++i) { const int p = tid + 512 * i, row = p >> 3, c16 = p & 7;
          *(LAS u32x4*)(lds + NL_K0 + row * 144 + c16 * 16) = *(const u32x4*)(kc + row * 64 + c16 * 8);
          *(LAS u32x4*)(lds + NL_V0 + row * 144 + c16 * 16) = *(const u32x4*)(vc + row * 64 + c16 * 8); } }
    bf16x8 qf[4][2];
#pragma unroll
    for (int tt = 0; tt < 4; ++tt)
#pragma unroll
        for (int kb = 0; kb < 2; ++kb) qf[tt][kb] = *(const bf16x8*)(PROJ + (tok0 + s0 + tt * 16 + i16) * PPITCH + PC_QN + head * 64 + kb * 32 + 8 * g);
    __syncthreads();
    u32x2 fpk[4][4];
    const int ktmax = (4 * qb + 2) >> 4;
#pragma unroll
    for (int tt = 0; tt < 4; ++tt) {
        int lane_b = lane; asm volatile("" : "+v"(lane_b));
        const int i16 = lane_b & 15, g = lane_b >> 4;
        LAS unsigned char* kl = lds + NL_K0 + i16 * 144 + g * 16; LAS unsigned char* vl = lds + NL_V0 + (4 * g + ((lane_b & 15) >> 2)) * 144 + (lane_b & 3) * 8;
        const int pos = s0 + tt * 16 + i16;
        f32x4 st[8];
#pragma unroll
        for (int hf = 0; hf < 2; ++hf) {
            if (4 * hf <= ktmax) { bf16x8 kf[4][2];
#pragma unroll
                for (int k = 0; k < 4; ++k) { kf[k][0] = *(const LAS bf16x8*)(kl + (4 * hf + k) * 16 * 144); kf[k][1] = *(const LAS bf16x8*)(kl + (4 * hf + k) * 16 * 144 + 64); }
                __builtin_amdgcn_sched_barrier(0);
#pragma unroll
                for (int k = 0; k < 4; ++k) { st[4 * hf + k] = MFMA16(kf[k][0], qf[tt][0], ((f32x4){0.f, 0.f, 0.f, 0.f})); st[4 * hf + k] = MFMA16(kf[k][1], qf[tt][1], st[4 * hf + k]); }
            } else {
#pragma unroll
                for (int k = 0; k < 4; ++k) st[4 * hf + k] = (f32x4){-1e30f, -1e30f, -1e30f, -1e30f};
            } }
        float mx = -1e30f;
#pragma unroll
        for (int hf = 0; hf < 2; ++hf)
            if (4 * hf <= ktmax) { float tbv[4][4];
#pragma unroll
                for (int k = 0; k < 4; ++k)
#pragma unroll
                    for (int r = 0; r < 4; ++r) { const int dk = pos - 16 * ((4 * hf + k) * 16 + 4 * g + r) - 31 + 64; tbv[k][r] = T5L[dk < 0 ? 0 : (dk > 255 ? 255 : dk)]; }
#pragma unroll
                for (int k = 0; k < 4; ++k) { asm volatile("" : "+v"(tbv[k][0]), "+v"(tbv[k][1]), "+v"(tbv[k][2]), "+v"(tbv[k][3]));
#pragma unroll
                    for (int r = 0; r < 4; ++r) { const float l = fmaxf(st[4 * hf + k][r] + tbv[k][r], -1e30f); st[4 * hf + k][r] = l; mx = fmaxf(mx, l); } } }
        mx = xmax4(mx);
        float sum = 0.f;
#pragma unroll
        for (int kt = 0; kt < 8; ++kt)
#pragma unroll
            for (int r = 0; r < 4; ++r) { const float p = st[kt][r] > -1e29f ? __builtin_amdgcn_exp2f(st[kt][r] - mx) : 0.f; st[kt][r] = p; sum += p; }
        sum = xsum4(sum);
        const float inv = __builtin_amdgcn_rcpf(fmaxf(sum, 1e-30f));
        float rv[8];
#pragma unroll
        for (int kt = 0; kt < 8; ++kt) st[kt] = st[kt] * inv;
        { LAS float* xs = (LAS float*)(lds + NL_XCH) + w * 512;
#pragma unroll
          for (int kt = 0; kt < 8; ++kt) xs[kt * 64 + lane_b] = st[kt][3];
#pragma unroll
          for (int kt = 0; kt < 8; ++kt) rv[kt] = xs[kt * 64 + ((lane_b - 16) & 63)]; }
#pragma unroll
        for (int kt = 0; kt < 8; ++kt) { const float prev = g > 0 ? rv[kt] : (kt > 0 ? rv[kt > 0 ? kt - 1 : 0] : 0.f);
            impH[(w * 64 + tt * 16 + i16) * 33 + 4 * kt + g] = (st[kt][0] + st[kt][1]) + (st[kt][2] + st[kt][3]) + prev; }
        f32x4 o[4];
#pragma unroll
        for (int dt = 0; dt < 4; ++dt) o[dt] = (f32x4){0.f, 0.f, 0.f, 0.f};
#pragma unroll
        for (int i = 0; i < 4; ++i)
            if (2 * i <= ktmax) { const bf16x8 pf = pack_bf8(st[2 * i], st[2 * i + 1]); bf16x8 vf[4];
#pragma unroll
                for (int dt = 0; dt < 4; ++dt) vf[dt] = tr_frag2(vl, (2 * i) * 16 * 144 + dt * 32, (2 * i + 1) * 16 * 144 + dt * 32);
                __builtin_amdgcn_sched_barrier(0);
#pragma unroll
                for (int dt = 0; dt < 4; ++dt) o[dt] = MFMA16(vf[dt], pf, o[dt]); }
        const float g0 = ((LAS float*)(lds + NL_GATE))[(0 * 8 + w) * 64 + tt * 16 + i16];
#pragma unroll
        for (int dt = 0; dt < 4; ++dt) { const f32x4 v = o[dt] * g0; fpk[dt][tt].x = pk2(v[0], v[1]); fpk[dt][tt].y = pk2(v[2], v[3]); }
        __builtin_amdgcn_sched_barrier(0);
    }
    __syncthreads();
    int tid_s = C.tid; asm volatile("" : "+v"(tid_s));
    if (tid_s < 256) {
        const int tk = tid_s >> 2, part = tid_s & 3, lane = tid_s & 63;
        float im[8];
#pragma unroll
        for (int jj = 0; jj < 8; ++jj) { const int j = part * 8 + jj; float v = impH[tk * 33 + j];
#pragma unroll
            for (int hh = 1; hh < 8; ++hh) v += impH[(hh * 64 + tk) * 33 + j];
            im[jj] = v; }
        unsigned m = 1u | (1u << qb) | (qb > 0 ? (1u << (qb - 1)) : 0u);
        int cnt = __builtin_popcount(m);
        const int want = (qb + 1) < 8 ? (qb + 1) : 8;
        for (; cnt < want; ++cnt) {
            int best = 64; float bv = -1.f;
#pragma unroll
            for (int jj = 0; jj < 8; ++jj) { const int j = part * 8 + jj; const bool cand = j <= qb && !((m >> j) & 1u); if (cand && im[jj] > bv) { bv = im[jj]; best = j; } }
#pragma unroll
            for (int o = 1; o < 4; o <<= 1) { const float ov = shx(bv, o, lane); const int oi = ishx(best, o, lane); if (ov > bv || (ov == bv && oi < best)) { bv = ov; best = oi; } }
            if (best < 32) m |= 1u << best; }
        if (part == 0) selm[tk] = m;
        unsigned um = m;
#pragma unroll
        for (int o = 4; o < 64; o <<= 1) um |= (unsigned)ishx((int)um, o, lane);
        if (lane == 0) selm[64 + (tid_s >> 6)] = um;
    }
    __syncthreads();
    int tid_t = C.tid; asm volatile("" : "+v"(tid_t));
    const int lane2 = tid_t & 63;
    const unsigned umask = selm[64] | selm[65] | selm[66] | selm[67];
    unsigned selw[4];
#pragma unroll
    for (int tt = 0; tt < 4; ++tt) selw[tt] = selm[tt * 16 + (lane2 & 15)];
    const int nw = (qb < 8 ? qb : 8) + 1, ntile = nw + __builtin_popcount(umask);
    const float bfar = T5L[64 + 127];
    LAS unsigned char* qls = lds + NL_Q + w * 8192 + lane2 * 16;
#pragma unroll
    for (int tt = 0; tt < 4; ++tt)
#pragma unroll
        for (int kb = 0; kb < 2; ++kb) *(LAS bf16x8*)(qls + (tt * 2 + kb) * 1024) = qf[tt][kb];
    float mrun[4], lrun[4]; f32x4 oacc[4][4];
#pragma unroll
    for (int tt = 0; tt < 4; ++tt) { mrun[tt] = 0.f; lrun[tt] = 0.f;
#pragma unroll
        for (int dt = 0; dt < 4; ++dt) oacc[dt][tt] = (f32x4){0.f, 0.f, 0.f, 0.f}; }
    const unsigned dvo = (unsigned)(w * 8 + (lane2 >> 3)) * 128u + (unsigned)((lane2 & 7) ^ ((w * 4 + (lane2 >> 4)) & 7)) * 16u;
    const char* kvb = (const char*)(KVX + ((size_t)(b * 2 + g_) * T_) * 64);
#define NSA_DMA(blk_, br_, slot_) do { const char* sp_ = kvb + (size_t)((br_) ? 0 : 2) * (NBC * 2 * T_ * 64 * 2) + (size_t)(blk_) * 64 * 128 + dvo; \
        __builtin_amdgcn_global_load_lds((const unsigned*)sp_, (LAS unsigned*)(lds + NL_RING + (slot_) * NL_SLOT + w * 1024), 16, 0, 0); \
        __builtin_amdgcn_global_load_lds((const unsigned*)(sp_ + (size_t)NBC * 2 * T_ * 64 * 2), (LAS unsigned*)(lds + NL_RING + (slot_) * NL_SLOT + 8192 + w * 1024), 16, 0, 0); } while (0)
    unsigned remg = umask; int kgen = 0;
#define NSA_GEN(blk_, br_) do { if (kgen < nw) { blk_ = qb - kgen; br_ = 0; } else { br_ = 1; blk_ = remg ? __builtin_ctz(remg) : 0; remg &= remg - 1; } ++kgen; } while (0)
    int cur_blk, cur_br, n1_blk = 0, n1_br = 0, n2_blk = 0, n2_br = 0;
    NSA_GEN(cur_blk, cur_br); NSA_DMA(cur_blk, cur_br, 0);
    if (ntile > 1) { NSA_GEN(n1_blk, n1_br); NSA_DMA(n1_blk, n1_br, 1); }
    bool fresh = true;
    for (int it = 0; it < ntile; ++it) {
        int lane_c = lane2; asm volatile("" : "+v"(lane_c));
        const int i16c = lane_c & 15, gc = lane_c >> 4;
        const int slot = it % 3;
        if (it + 1 < ntile) asm volatile("s_waitcnt vmcnt(2)" ::: "memory"); else asm volatile("s_waitcnt vmcnt(0)" ::: "memory");
        __builtin_amdgcn_s_barrier(); asm volatile("" ::: "memory");
        if (it + 2 < ntile) { NSA_GEN(n2_blk, n2_br); NSA_DMA(n2_blk, n2_br, (it + 2) % 3); }
        LAS unsigned char* kt_ = lds + NL_RING + slot * NL_SLOT + i16c * 128; LAS unsigned char* vt_ = kt_ - i16c * 128 + 8192 + (4 * gc + (i16c >> 2)) * 128 + (lane_c & 1) * 8;
        const int kx0 = ((gc ^ ((i16c >> 1) & 7)) << 4), kx1 = kx0 ^ 64;
        const int vx = (2 * gc + ((i16c >> 3) & 1)) & 7, vph = (lane_c >> 1) & 1;
        const int dl = qb - cur_blk;
#pragma unroll
        for (int th = 0; th < 2; ++th) {
            bf16x8 kfr[4][2], qh[2][2];
            { LAS unsigned char* ql_ = lds + NL_Q + w * 8192 + lane_c * 16;
#pragma unroll
              for (int tx = 0; tx < 2; ++tx)
#pragma unroll
                  for (int kb = 0; kb < 2; ++kb) qh[tx][kb] = *(const LAS bf16x8*)(ql_ + ((2 * th + tx) * 2 + kb) * 1024); }
#pragma unroll
            for (int kt = 0; kt < 4; ++kt) { kfr[kt][0] = *(const LAS bf16x8*)(kt_ + kt * 2048 + kx0); kfr[kt][1] = *(const LAS bf16x8*)(kt_ + kt * 2048 + kx1); }
            __builtin_amdgcn_sched_barrier(0);
            f32x4 st[4][2];
#pragma unroll
            for (int kt = 0; kt < 4; ++kt)
#pragma unroll
                for (int tx = 0; tx < 2; ++tx) { st[kt][tx] = MFMA16(kfr[kt][0], qh[tx][0], ((f32x4){0.f, 0.f, 0.f, 0.f})); st[kt][tx] = MFMA16(kfr[kt][1], qh[tx][1], st[kt][tx]); }
            if (dl >= 3 && !(cur_br == 0 && dl == 8)) {
#pragma unroll
                for (int tx = 0; tx < 2; ++tx) { const float off = ((cur_br == 0 || ((selw[2 * th + tx] >> cur_blk) & 1u)) ? bfar : -1e30f) - mrun[2 * th + tx];
#pragma unroll
                    for (int kt = 0; kt < 4; ++kt) st[kt][tx] = st[kt][tx] + off; }
            } else {
                const bool wedge = cur_br == 0 && dl == 8;
#pragma unroll
                for (int tx = 0; tx < 2; ++tx) { const bool sel = cur_br == 0 || ((selw[2 * th + tx] >> cur_blk) & 1u);
                    LAS float* tb_ = T5L + (wedge ? 256 : 64 * dl) + 13 + (2 * th + tx) * 16 + i16c - 4 * gc;
                    float tbv[4][4];
#pragma unroll
                    for (int kt = 0; kt < 4; ++kt)
#pragma unroll
                        for (int r = 0; r < 4; ++r) tbv[kt][r] = tb_[51 - 16 * kt - r];
                    const float ad = sel ? -mrun[2 * th + tx] : -1e30f;
#pragma unroll
                    for (int kt = 0; kt < 4; ++kt) { asm volatile("" : "+v"(tbv[kt][0]), "+v"(tbv[kt][1]), "+v"(tbv[kt][2]), "+v"(tbv[kt][3]));
                        st[kt][tx] = (st[kt][tx] + (f32x4){tbv[kt][0], tbv[kt][1], tbv[kt][2], tbv[kt][3]}) + ad; } }
            }
            bf16x8 pf[2][2];
#pragma unroll
            for (int tx = 0; tx < 2; ++tx) { const int tt = 2 * th + tx;
                float mx = fmaxf(fmaxf(fmaxf(st[0][tx][0], st[0][tx][1]), fmaxf(st[0][tx][2], st[0][tx][3])), fmaxf(fmaxf(st[1][tx][0], st[1][tx][1]), fmaxf(st[1][tx][2], st[1][tx][3])));
                mx = fmaxf(mx, fmaxf(fmaxf(fmaxf(st[2][tx][0], st[2][tx][1]), fmaxf(st[2][tx][2], st[2][tx][3])), fmaxf(fmaxf(st[3][tx][0], st[3][tx][1]), fmaxf(st[3][tx][2], st[3][tx][3]))));
                mx = xmax4(mx);
                if (fresh || __builtin_amdgcn_ballot_w64(mx > 10.f) != 0ull) {
                    const float d = fresh ? mx : (mx > 10.f ? mx : 0.f), al = fresh ? 0.f : __builtin_amdgcn_exp2f(-d);
                    mrun[tt] += d; lrun[tt] *= al;
#pragma unroll
                    for (int dt = 0; dt < 4; ++dt) oacc[dt][tt] = oacc[dt][tt] * al;
#pragma unroll
                    for (int kt = 0; kt < 4; ++kt) st[kt][tx] = st[kt][tx] - d;
                }
#pragma unroll
                for (int kt = 0; kt < 4; ++kt)
#pragma unroll
                    for (int r = 0; r < 4; ++r) st[kt][tx][r] = __builtin_amdgcn_exp2f(st[kt][tx][r]);
                const f32x4 s4 = (st[0][tx] + st[1][tx]) + (st[2][tx] + st[3][tx]);
                lrun[tt] += (s4[0] + s4[1]) + (s4[2] + s4[3]);
                pf[0][tx] = pack_bf8(st[0][tx], st[1][tx]); pf[1][tx] = pack_bf8(st[2][tx], st[3][tx]);
            }
            { s16x4 vr[16]; const unsigned vb_ = (unsigned)(size_t)vt_;
              tr_read16(vb_ + (((0 + vph) ^ vx) << 4), vb_ + (((2 + vph) ^ vx) << 4), vb_ + (((4 + vph) ^ vx) << 4), vb_ + (((6 + vph) ^ vx) << 4), vr);
#pragma unroll
              for (int i = 0; i < 2; ++i)
#pragma unroll
                  for (int dt = 0; dt < 4; ++dt) { const bf16x8 vf = __builtin_shufflevector(vr[4 * dt + 2 * i], vr[4 * dt + 2 * i + 1], 0, 1, 2, 3, 4, 5, 6, 7);
#pragma unroll
                      for (int tx = 0; tx < 2; ++tx) oacc[dt][2 * th + tx] = MFMA16(vf, pf[i][tx], oacc[dt][2 * th + tx]); } }
        }
        fresh = false;
        const bool last = it + 1 >= ntile;
        if (last || (cur_br == 0 && n1_br == 1)) {
#pragma unroll
            for (int tt = 0; tt < 4; ++tt) { float l = lrun[tt]; l += shx(l, 16, lane_c); l += shx(l, 32, lane_c);
                const size_t tok = tok0 + s0 + tt * 16 + i16c;
                const float gt = ((LAS float*)(lds + NL_GATE))[((cur_br == 0 ? 2 : 1) * 8 + w) * 64 + tt * 16 + i16c] / fmaxf(l, 1e-30f);
#pragma unroll
                for (int dt = 0; dt < 4; ++dt) { const f32x4 v = (f32x4){bflo(fpk[dt][tt].x), bfhi(fpk[dt][tt].x), bflo(fpk[dt][tt].y), bfhi(fpk[dt][tt].y)} + oacc[dt][tt] * gt;
                    u32x2 wv; wv.x = pk2(v[0], v[1]); wv.y = pk2(v[2], v[3]);
                    if (last) *(u32x2*)(ON + tok * DM + head * 64 + dt * 16 + 4 * gc) = wv; else fpk[dt][tt] = wv;
                    oacc[dt][tt] = (f32x4){0.f, 0.f, 0.f, 0.f}; }
                mrun[tt] = 0.f; lrun[tt] = 0.f; }
            fresh = true;
        }
        cur_blk = n1_blk; cur_br = n1_br; n1_blk = n2_blk; n1_br = n2_br;
    }
    asm volatile("s_waitcnt vmcnt(0)" ::: "memory"); __syncthreads();
#undef NSA_DMA
#undef NSA_GEN
}

__global__ void __launch_bounds__(NWAVES * 64, 2) fwd(Args a_unused) {
    extern __shared__ __attribute__((aligned(16))) unsigned char lds_raw[];
    Ctx C; C.lds = (LAS unsigned char*)lds_raw; C.tid = threadIdx.x; C.lane = C.tid & 63; C.wave = __builtin_amdgcn_readfirstlane(C.tid >> 6); C.G = gridDim.x; C.bid = blockIdx.x;
    const int wave0 = C.wave;
#define ws (AP->ws)
#define ctl ((gu32*)(ws + WS_CTL))
    volatile LAS unsigned* MISC = (volatile LAS unsigned*)(C.lds + MISC_OFF);
    for (int u = C.tid; u < (LDS_BYTES - LDSCTL_OFF) / 4; u += NWAVES * 64) ((LAS unsigned*)(C.lds + LDSCTL_OFF))[u] = 0u;
    __syncthreads();
    const bool one = (AP->flags & 1) != 0;
    XcdBarrier bar; bar.bar = (unsigned*)(ctl + CW_BAR); bar.x = 0; bar.st = nullptr;
    if (one) bar = xcd_barrier_post((unsigned*)(ctl + CW_BAR), MISC + 8);
#define SEAM() do { if (AP->flags & 1) { XcdBarrier bl_ = bar; bl_.bar = (unsigned*)(ws + WS_CTL) + CW_BAR; xcd_barrier(bl_, wave0 == 0 && lane_now() == 0); } } while (0)
#define PH(k) (plo_ <= (k) && (k) < phi_)
#if TIMED_MASK
#define TS(id) do { const int z_ = (wave0 << 6) | lane_now(); if (((TIMED_MASK >> (id)) & 1) && blockIdx.x == 0 && z_ == 0) MISC[16] = (unsigned)__builtin_amdgcn_s_memrealtime(); } while (0)
#define TE(id) do { const int z_ = (wave0 << 6) | lane_now(); if (((TIMED_MASK >> (id)) & 1) && blockIdx.x == 0 && z_ == 0) MISC[17] += (unsigned)__builtin_amdgcn_s_memrealtime() - MISC[16]; } while (0)
#else
#define TS(id) do {} while (0)
#define TE(id) do {} while (0)
#endif
#define RELOAD() do { int t_ = (wave0 << 6) | lane_now(); asm volatile("" : "+v"(t_)); C.tid = t_; C.lane = t_ & 63; C.wave = __builtin_amdgcn_readfirstlane(t_ >> 6); gw = C.bid * NWAVES + C.wave; } while (0)
    int gw = C.bid * NWAVES + C.wave; const int NGW = C.G * NWAVES;
#define H ((bf16*)AP->out)
#define XR ((bf16*)(ws + WS_H))
#define PROJ ((bf16*)(ws + WS_BIG) - 4096)
#define FFH ((bf16*)(ws + WS_BIG))
#define ORET ((bf16*)AP->out + (size_t)NTOK * DM)
#define ON ((bf16*)(ws + WS_ON))
#define TMP ((bf16*)(ws + WS_TMP))
#define MERGED ((bf16*)(ws + WS_MERGED))
#define KCV ((bf16*)(ws + WS_KC))
#define GNP ((float*)(ws + WS_GNS))
#define XC ((bf16*)(ws + WS_XC))
#define QKR ((bf16*)(ws + WS_QKR))
#define VR ((bf16*)(ws + WS_VR))
#define KVX ((bf16*)(ws + WS_KVX))
#define rot ((const float*)(ws + WS_ROT))
#define RSTD ((float*)(ws + WS_RSTD))
#define PART ((float*)(ws + WS_PART))
#define RSTD_PASS() do { for (int r_ = C.bid * 512 + C.tid; r_ < NTOK; r_ += C.G * 512) { const f32x4* p_ = (const f32x4*)(PART + (size_t)r_ * 16); const f32x4 a_ = (p_[0] + p_[1]) + (p_[2] + p_[3]); \
        RSTD[r_] = 1.f / sqrtf(((a_[0] + a_[1]) + (a_[2] + a_[3])) * (1.f / DM) + 1e-6f); } } while (0)
#define t5 ((const float*)(ws + WS_T5))
    TS(11);
    if (AP->it_lo < 0) { RELOAD(); p0_prologue(C); SEAM(); }
    TE(11);
    const int it0 = AP->it_lo < 0 ? 0 : AP->it_lo, it1 = AP->it_hi > NIT ? NIT : AP->it_hi;
    for (int it = it0; it < it1; ++it) {
        int itv = it, plo_ = AP->ph_lo, phi_ = AP->ph_hi; asm volatile("" : "+s"(itv), "+s"(plo_), "+s"(phi_)); const int L = itv / NSUB, sub = itv % NSUB;
        if (sub < NCHUNK) {
            const size_t row0 = (size_t)sub * MC;
            TS(0);
            if (PH(0) && sub == 0) { RELOAD(); const float* g = AP->in[1] + L * DM;
                if (L == 0) { for (int m = gw; m < NTOK; m += 4 * NGW) rms_rows_to_bf16<4>(AP->in[0], g, H, m, NGW, C.lane); }
                else RSTD_PASS();
                SEAM(); }
            TE(0);
            TS(1);
            if (PH(1)) { pg8::Gemm g{(L == 0 ? H : XR) + row0 * DM, (const bf16*)(ws + WS_WIN) + (size_t)L * CPAD * DM, MC, CPAD, DM}; pg8::StaticOrder S; S.init(MC, CPAD, C.G, C.bid);
                epi::EpiInProj E{PROJ, rot, XC, QKR, VR, KVX, (L == 0 ? (const float*)(ws + WS_ONES) : (const float*)RSTD) + row0}; pg8::gemm_phase<epi::EpiInProj, pg8::StaticOrder, true, true>(C.lds, g, S, E, wave0); SEAM(); }
            TE(1);
            TS(2);
            if (PH(2)) {
                TS(13); RELOAD(); for (int u = C.bid; u < NBC * 4 * 8; u += C.G) ret_unit(C, (C.G == 256) ? ((u & ~255) + (u & 7) * 32 + ((u >> 3) & 31)) : u, QKR, VR, ORET, GNP); TE(13);
                { const int ks = C.bid & 7; int kc = 256; asm volatile("" : "+s"(kc));
                  pg8::Gemm g{XC + ks * 256, (const bf16*)(ws + WS_WC1) + (size_t)L * 2 * 256 * 2048 + ks * 256, NBC * 512, 512, kc, 1024, 2048}; epi::CmpOrder S{C.bid, C.G};
                  epi::EpiCmpPart E{(float*)(ws + WS_HIDP), ks}; pg8::gemm_phase<epi::EpiCmpPart, epi::CmpOrder, true, true>(C.lds, g, S, E, wave0); }
                SEAM(); }
            TE(2);
            TS(3);
            if (PH(3)) {
                RELOAD(); LAS float* hs = (LAS float*)C.lds + C.wave * 256; const float* cb = (const float*)(ws + WS_CB) + L * 512; const float* hp = (const float*)(ws + WS_HIDP);
                if (NGW == 2048) {
                  LAS float* w2s = (LAS float*)(C.lds + 8192);
                  { const f32x4* wk = (const f32x4*)(AP->in[6] + (size_t)L * 256 * 64); const f32x4* wv = (const f32x4*)(AP->in[8] + (size_t)L * 256 * 64);
#pragma unroll
                    for (int i = 0; i < 8; ++i) { *(LAS f32x4*)(w2s + (C.tid + 512 * i) * 4) = wk[C.tid + 512 * i]; *(LAS f32x4*)(w2s + 16384 + (C.tid + 512 * i) * 4) = wv[C.tid + 512 * i]; } }
                  if (C.tid == 0) MISC[32] = 0u;
                  __syncthreads();
                  if (C.wave < 4) {
                      int lz = C.lane; asm volatile("" : "+v"(lz));
                      const int rbase = C.bid * 4 + C.wave;
                      f32x4 part[8];
#pragma unroll
                      for (int ks = 0; ks < 8; ++ks) part[ks] = *(const f32x4*)(hp + ((size_t)ks * (NBC * 512) + rbase) * 256 + lz * 4);
#pragma unroll 1
                      for (int i = 0; i < NBC / 2; ++i) { const int r = i * 1024 + rbase, kv = r / (NBC * 256);
                          f32x4 h4 = *(const f32x4*)(cb + kv * 256 + lz * 4);
#pragma unroll
                          for (int ks = 0; ks < 8; ++ks) h4 += part[ks];
                          if (i + 1 < NBC / 2) {
#pragma unroll
                              for (int ks = 0; ks < 8; ++ks) part[ks] = *(const f32x4*)(hp + ((size_t)ks * (NBC * 512) + r + 1024) * 256 + lz * 4); }
#pragma unroll
                          for (int j = 0; j < 4; ++j) h4[j] = gelu_tanh_f(h4[j]);
                          *(LAS f32x4*)(hs + lz * 4) = h4;
                          const LAS float* w2 = w2s + kv * 16384;
                          float s_ = 0.f, s1_ = 0.f, s2_ = 0.f, s3_ = 0.f;
#pragma unroll 8
                          for (int k = 0; k < 256; k += 4) { s_ += hs[k] * w2[k * 64 + lz]; s1_ += hs[k + 1] * w2[(k + 1) * 64 + lz]; s2_ += hs[k + 2] * w2[(k + 2) * 64 + lz]; s3_ += hs[k + 3] * w2[(k + 3) * 64 + lz]; }
                          s_ = (s_ + s1_) + (s2_ + s3_);
                          KCV[(size_t)r * 64 + lz] = (r & 127) == 127 ? (bf16)0 : (bf16)f2bf(s_); }
                  }
                  for (;;) { unsigned p_ = 0u; if (C.lane == 0) p_ = __hip_atomic_fetch_add((LAS unsigned*)(C.lds + MISC_OFF) + 32, 1u, __ATOMIC_RELAXED, __HIP_MEMORY_SCOPE_WORKGROUP);
                      p_ = (unsigned)__builtin_amdgcn_readfirstlane((int)p_); if (p_ >= 64u) break;
                      gn_gate_rows<2>(PROJ, ORET, GNP, C.bid * 128 + 2 * (int)p_, 1, C.lane); }
                  __syncthreads();
                } else {
                  for (int r = gw; r < NBC * 512; r += NGW) { const int kv = r / (NBC * 256); f32x4 h4 = *(const f32x4*)(cb + kv * 256 + C.lane * 4);
#pragma unroll
                      for (int ks = 0; ks < 8; ++ks) h4 += *(const f32x4*)(hp + ((size_t)ks * (NBC * 512) + r) * 256 + C.lane * 4);
#pragma unroll
                      for (int i = 0; i < 4; ++i) h4[i] = gelu_tanh_f(h4[i]);
                      *(LAS f32x4*)(hs + C.lane * 4) = h4;
                      const float* w2 = (kv ? AP->in[8] : AP->in[6]) + (size_t)L * 256 * 64 + C.lane; float s_ = 0.f;
                      for (int k = 0; k < 256; ++k) s_ += hs[k] * w2[(size_t)k * 64];
                      KCV[(size_t)r * 64 + C.lane] = (r & 127) == 127 ? (bf16)0 : (bf16)f2bf(s_); }
                  __syncthreads();
                  RELOAD(); for (int m = gw; m < MC; m += 2 * NGW) gn_gate_rows<2>(PROJ, ORET, GNP, m, NGW, C.lane);
                }
                SEAM(); }
            TE(3);
            TS(4);
            if (PH(4)) {
                TS(14); RELOAD(); for (int u = C.bid; u < NBC * 2 * 32; u += C.G) nsa_unit(C, u, PROJ, KVX, KCV, t5, ON); TE(14);
                SEAM(); }
            TE(4);
            TS(5);
            if (PH(5)) { pg8::Gemm g{ORET, (const bf16*)(ws + WS_WORET) + (size_t)L * DM * 2048, MC, DM, 2048}; pg8::StaticOrder S; S.init(MC, DM, C.G, C.bid);
                epi::EpiGate<false> E{TMP, nullptr, PROJ + PC_MA, DM, PPITCH}; pg8::gemm_phase<epi::EpiGate<false>, pg8::StaticOrder, true, true>(C.lds, g, S, E, wave0);
                  }
            TE(5);
            TS(6);
            if (PH(6)) { pg8::Gemm g{ON, (const bf16*)(ws + WS_WONSA) + (size_t)L * DM * DM, MC, DM, DM}; pg8::StaticOrder S; S.init(MC, DM, C.G, C.bid);
                epi::EpiGate<true> E{MERGED, TMP, PROJ + PC_MB, DM, PPITCH}; pg8::gemm_phase<epi::EpiGate<true>, pg8::StaticOrder, true, true>(C.lds, g, S, E, wave0); SEAM(); }
            TE(6);
            TS(7);
            if (PH(7)) { pg8::Gemm g{MERGED, (const bf16*)(ws + WS_WOUT) + (size_t)L * DM * DM, MC, DM, DM}; pg8::StaticOrder S; S.init(MC, DM, C.G, C.bid);
                if (L == 0) { epi::EpiResid<true> E{AP->in[0] + row0 * DM, XR + row0 * DM, PART + row0 * 16}; pg8::gemm_phase<epi::EpiResid<true>, pg8::StaticOrder, true, true>(C.lds, g, S, E, wave0); }
                else { epi::EpiResid<false> E{XR + row0 * DM, XR + row0 * DM, PART + row0 * 16}; pg8::gemm_phase<epi::EpiResid<false>, pg8::StaticOrder, true, true>(C.lds, g, S, E, wave0); }
                if (sub == NCHUNK - 1) SEAM();     }
            TE(7);
        } else {
            TS(8);
            if (PH(0)) { RELOAD(); RSTD_PASS(); SEAM(); }
            TE(8); TS(9);
            if (PH(1)) { pg8::Gemm g{XR, (const bf16*)(ws + WS_WFFI) + (size_t)L * 2 * FFH_ * DM, NTOK, 2 * FFH_, DM}; pg8::StaticOrder S; S.init(NTOK, 2 * FFH_, C.G, C.bid);
                epi::EpiSwiGlu E{FFH, RSTD}; pg8::gemm_phase<epi::EpiSwiGlu, pg8::StaticOrder, true, true>(C.lds, g, S, E, wave0); SEAM(); }
            TE(9); TS(10);
            if (PH(2)) { pg8::Gemm g{FFH, (const bf16*)(ws + WS_WFFO) + (size_t)L * DM * FFH_, NTOK, DM, FFH_}; pg8::StaticOrder S; S.init(NTOK, DM, C.G, C.bid);
                epi::EpiResid<false> E{XR, XR, PART}; pg8::gemm_phase<epi::EpiResid<false>, pg8::StaticOrder, true, true>(C.lds, g, S, E, wave0); SEAM(); }
            TE(10);
        }
    }
    TS(12);
    if (AP->it_hi > NIT) { RELOAD(); const float* g = AP->in[16]; for (int m = gw; m < NTOK; m += NGW) rms_row_final(XR + (size_t)m * DM, g, AP->out + (size_t)m * DM, C.lane);
    }
    TE(12);
#if TIMED_MASK
    { const int z_ = (wave0 << 6) | lane_now(); if (blockIdx.x == 0 && z_ == 0) { const unsigned long long t0 = __builtin_amdgcn_s_memrealtime(); const unsigned long long want = 4ull * MISC[17]; while (__builtin_amdgcn_s_memrealtime() - t0 < want) __builtin_amdgcn_s_sleep(8); } }
#endif
#undef SEAM
#undef PH
#undef ctl
#undef ws
#undef H
#undef XR
#undef PROJ
#undef FFH
#undef ORET
#undef ON
#undef TMP
#undef MERGED
#undef KCV
#undef GNP
#undef XC
#undef QKR
#undef VR
#undef KVX
#undef rot
#undef RSTD
#undef PART
#undef RSTD_PASS
#undef t5
}

extern "C" void kernel_launch(void* const* d_in, const int* in_sizes, int n_in, void* d_out, int out_size, void* d_ws, size_t ws_size, hipStream_t stream) {
    static int grid = 0;
    if (grid == 0) {
        if (n_in != 17 || in_sizes[0] != NTOK * DM || out_size != NTOK * DM || ws_size < WS_END) { fprintf(stderr, "kernel_launch: unexpected shapes (n_in %d, in0 %d, out %d, ws %zu); nothing launched\n", n_in, n_in > 0 ? in_sizes[0] : -1, out_size, ws_size); grid = -1; return; }
        int dev = 0, cus = 0, per_cu = 0;
        if (hipGetDevice(&dev) != hipSuccess || hipDeviceGetAttribute(&cus, hipDeviceAttributeMultiprocessorCount, dev) != hipSuccess) { grid = -1; return; }
        if (hipFuncSetAttribute((const void*)fwd, hipFuncAttributeMaxDynamicSharedMemorySize, LDS_BYTES) != hipSuccess) { fprintf(stderr, "kernel_launch: hipFuncSetAttribute failed\n"); grid = -1; return; }
        if (hipOccupancyMaxActiveBlocksPerMultiprocessor(&per_cu, (const void*)fwd, NWAVES * 64, LDS_BYTES) != hipSuccess || per_cu < 1) { fprintf(stderr, "kernel_launch: occupancy query says %d\n", per_cu); }
        (void)hipGetLastError();
        grid = cus;
    }
    if (grid < 0) return;
    (void)hipMemsetAsync((char*)d_ws + WS_CTL, 0, CTL_ZERO_BYTES, stream);
    Args a{};
    for (int i = 0; i < 17; ++i) a.in[i] = (const float*)d_in[i];
    a.out = (float*)d_out; a.ws = (unsigned char*)d_ws;
    a.it_lo = -1; a.it_hi = NIT + 1; a.ph_lo = 0; a.ph_hi = 99; a.flags = 1;
    hipLaunchKernelGGL(fwd, dim3(grid), dim3(NWAVES * 64), LDS_BYTES, stream, a);
}
```

```cpp
#include <hip/hip_runtime.h>
#include <cstdio>
#include <cstdint>
#ifndef TIMED_MASK
#define TIMED_MASK 0
#endif
__device__ __forceinline__ int lane_now() { int z = 0; asm volatile("" : "+v"(z)); return __builtin_amdgcn_mbcnt_hi(-1, __builtin_amdgcn_mbcnt_lo(-1, z)); }
namespace pg8 {
#define PG8_LAS __attribute__((address_space(3)))
typedef unsigned short bf16_t;
typedef short bf16x8 __attribute__((ext_vector_type(8)));
typedef float f32x4 __attribute__((ext_vector_type(4)));
typedef unsigned u32x4 __attribute__((ext_vector_type(4)));
constexpr int BM = 256, BK = 64, HALF = 128, HTB = HALF * BK * 2  , STAGE_BYTES = 8 * HTB, NXCD = 8, WGM = 8;

__host__ __device__ __forceinline__ int lds_byte(int r, int c) { const int st = (r >> 4) * 2 + (c >> 5), rr = r & 15, cc = c & 31, ob = rr * 64 + cc * 2; return st * 1024 + (ob ^ (((ob >> 9) & 1) << 5)); }
__host__ __device__ __forceinline__ void stage_rc(int b, int& R, int& C) { const int st = b / 1024, sb = b % 1024, swz = sb ^ (((sb >> 9) & 1) << 5); R = (st >> 1) * 16 + swz / 64; C = (st & 1) * 32 + (swz % 64) / 2; }
__host__ __device__ __forceinline__ int perm32(int rho) { const int n = rho >> 4, i = rho & 15; return 8 * (i >> 2) + 4 * n + (i & 3); }

struct Unit { int pm, pn; };
struct Gemm { const bf16_t* A; const bf16_t* Bt; int M, N, K; int lda = 0, ldb = 0; };

struct StaticOrder {
    int nM, nN, nwg, G, c;
    __host__ __device__ void init(int M, int N, int G_, int c_) { nM = M / BM; nN = N / BM; nwg = nM * nN; G = G_; c = c_; }
    __host__ __device__ bool next(int i, Unit& u) const {
        const long L = (long)i * G + c; if (L >= nwg) return false;
        int wgid = (int)L; { const int q = nwg / NXCD, r = nwg % NXCD, xcd = wgid % NXCD, off = wgid / NXCD; wgid = (xcd < r ? xcd * (q + 1) : r * (q + 1) + (xcd - r) * q) + off; }
        const int nig = WGM * nN, gid = wgid / nig, fm = gid * WGM, gsz = (nM - fm) < WGM ? (nM - fm) : WGM;
        u.pm = fm + ((wgid % nig) % gsz); u.pn = (wgid % nig) / gsz; return true;
    }
    __device__ __forceinline__ void a_ready(const Unit&) const {}
    __device__ __forceinline__ void done(const Unit&) const {}
};

template <class Epi, class Sched, bool ALIGN_EPI = false, bool SP2 = false>
__device__ __forceinline__ void gemm_phase(PG8_LAS unsigned char* lds, const Gemm g, const Sched& S, const Epi& E, int wave0) {
    int tid_ = (wave0 << 6) | lane_now(); asm volatile("" : "+v"(tid_));
    const int tid = tid_, wid = __builtin_amdgcn_readfirstlane(tid >> 6), lane = tid & 63, wr = wid >> 2, wc = wid & 3, fr = lane & 15, fq = lane >> 4;
    const int K = g.K, nt = K / BK, LDA = g.lda ? g.lda : g.K, LDB = g.ldb ? g.ldb : g.K;
    unsigned voffA[2], voffB[2];
#pragma unroll
    for (int i = 0; i < 2; ++i) { int R, C; stage_rc(tid * 16 + i * 8192, R, C); const int Rb = Epi::PERM ? ((R & ~31) + perm32(R & 31)) : R;
        voffA[i] = (unsigned)(R * LDA + C) * 2u; voffB[i] = (unsigned)(Rb * LDB + C) * 2u; }
    const size_t kstep = (size_t)(BK * 2);
    const size_t hstep = (size_t)HALF * LDB * 2;
    const size_t tstep = 2 * hstep;
    const size_t hstepA = (size_t)HALF * LDA * 2, tstepA = 2 * hstepA;
    const unsigned ldsw = (unsigned)wid * 1024u;
    const int aoff = lds_byte(wr * 64 + fr, fq * 8), boff = lds_byte(wc * 32 + fr, fq * 8);
#define PG8_SA(b, h) (((b) * 2 + (h)) * HTB)
#define PG8_SB(b, h) ((4 + (b) * 2 + (h)) * HTB)
#define PG8_STAGE(bufoff, gbase, voff) do { _Pragma("unroll") for (int _i = 0; _i < 2; ++_i) \
        __builtin_amdgcn_global_load_lds((const unsigned*)((const char*)(gbase) + (voff)[_i]), (PG8_LAS unsigned*)(lds + (bufoff) + ldsw + _i * 8192), 16, 0, 0); } while (0)
#define PG8_LDA(dst, b, h) do { _Pragma("unroll") for (int m = 0; m < 4; ++m) _Pragma("unroll") for (int k = 0; k < 2; ++k) dst[m][k] = *(const PG8_LAS bf16x8*)(lds + PG8_SA(b, h) + aoff + m * 2048 + k * 1024); } while (0)
#define PG8_LDB(dst, b, h) do { _Pragma("unroll") for (int n = 0; n < 2; ++n) _Pragma("unroll") for (int k = 0; k < 2; ++k) dst[n][k] = *(const PG8_LAS bf16x8*)(lds + PG8_SB(b, h) + boff + n * 2048 + k * 1024); } while (0)
#define PG8_MMA(ai, bj, At, Bt) do { __builtin_amdgcn_s_setprio(1); _Pragma("unroll") for (int m = 0; m < 4; ++m) _Pragma("unroll") for (int n = 0; n < 2; ++n) _Pragma("unroll") for (int k = 0; k < 2; ++k) \
        acc[ai][bj][m][n] = __builtin_amdgcn_mfma_f32_16x16x32_bf16(Bt[n][k], At[m][k], acc[ai][bj][m][n], 0, 0, 0); __builtin_amdgcn_s_setprio(0); } while (0)
#define PG8_WAIT_V(n) asm volatile("s_waitcnt vmcnt(" #n ")" ::: "memory")
#define PG8_WAIT_L(n) asm volatile("s_waitcnt lgkmcnt(" #n ")" ::: "memory")
#define PG8_BAR __builtin_amdgcn_s_barrier()
#define PG8_SCHED __builtin_amdgcn_sched_barrier(0)
    Unit cur, nxt; int ui = 0;
    if (!S.next(0, cur)) return;
    f32x4 acc[2][2][4][2];
#pragma unroll
    for (int a = 0; a < 2; ++a)
#pragma unroll
        for (int b = 0; b < 2; ++b)
#pragma unroll
            for (int m = 0; m < 4; ++m)
#pragma unroll
                for (int n = 0; n < 2; ++n) acc[a][b][m][n] = (f32x4){0.f, 0.f, 0.f, 0.f};
    bf16x8 At[4][2], B0[2][2], B1[2][2];
    const char* cA = (const char*)g.A + (size_t)cur.pm * tstepA; const char* cB = (const char*)g.Bt + (size_t)cur.pn * tstep;
    S.a_ready(cur);
    if constexpr (SP2) {
        PG8_STAGE(PG8_SB(0, 0), cB, voffB); PG8_STAGE(PG8_SB(0, 1), cB + hstep, voffB); PG8_STAGE(PG8_SA(0, 0), cA, voffA); PG8_STAGE(PG8_SA(0, 1), cA + hstepA, voffA);
        if (wr == 1) PG8_BAR;
        PG8_WAIT_V(2); PG8_BAR;
        PG8_STAGE(PG8_SB(1, 0), cB + kstep, voffB); PG8_STAGE(PG8_SA(1, 0), cA + kstep, voffA); PG8_STAGE(PG8_SB(1, 1), cB + hstep + kstep, voffB);
        PG8_WAIT_V(6); PG8_BAR;
    } else {
        PG8_STAGE(PG8_SB(0, 0), cB, voffB); PG8_STAGE(PG8_SA(0, 0), cA, voffA); PG8_STAGE(PG8_SB(0, 1), cB + hstep, voffB); PG8_STAGE(PG8_SA(0, 1), cA + hstepA, voffA);
        if (wr == 1) PG8_BAR;
        PG8_WAIT_V(4); PG8_BAR;
        PG8_STAGE(PG8_SB(1, 0), cB + kstep, voffB); PG8_STAGE(PG8_SA(1, 0), cA + kstep, voffA); PG8_STAGE(PG8_SB(1, 1), cB + hstep + kstep, voffB);
        PG8_WAIT_V(6); PG8_BAR;
    }
    for (;;) {
        const bool has_next = S.next(ui + 1, nxt);
        const char* nA = has_next ? (const char*)g.A + (size_t)nxt.pm * tstepA : cA; const char* nB = has_next ? (const char*)g.Bt + (size_t)nxt.pn * tstep : cB;
        for (int t = 0; t < nt; t += 2) {
            const bool last = (t == nt - 2);
            const char* a1 = cA + (size_t)(t + 1) * kstep;
            const char* a2 = last ? nA : cA + (size_t)(t + 2) * kstep; const char* b2 = last ? nB : cB + (size_t)(t + 2) * kstep;
            const char* a3 = a2 + kstep; const char* b3 = b2 + kstep;
            if (last && has_next) S.a_ready(nxt);
            if constexpr (SP2) {
            PG8_LDB(B0, 0, 0); PG8_LDB(B1, 0, 1); PG8_SCHED; PG8_LDA(At, 0, 0); PG8_STAGE(PG8_SA(1, 1), a1 + hstepA, voffA);
            PG8_WAIT_V(8); PG8_WAIT_L(0); PG8_BAR; PG8_MMA(0, 0, At, B0); PG8_MMA(0, 1, At, B1); PG8_BAR; PG8_SCHED;
            PG8_LDA(At, 0, 1); PG8_STAGE(PG8_SB(0, 0), b2, voffB); PG8_STAGE(PG8_SB(0, 1), b2 + hstep, voffB); PG8_STAGE(PG8_SA(0, 0), a2, voffA);
            PG8_WAIT_V(8); PG8_WAIT_L(0); PG8_BAR; PG8_MMA(1, 0, At, B0); PG8_MMA(1, 1, At, B1); PG8_BAR; PG8_SCHED;
            PG8_LDB(B0, 1, 0); PG8_LDB(B1, 1, 1); PG8_SCHED; PG8_LDA(At, 1, 0); PG8_STAGE(PG8_SA(0, 1), a2 + hstepA, voffA);
            PG8_WAIT_V(8); PG8_WAIT_L(0); PG8_BAR; PG8_MMA(0, 0, At, B0); PG8_MMA(0, 1, At, B1); PG8_BAR; PG8_SCHED;
            PG8_LDA(At, 1, 1); PG8_STAGE(PG8_SB(1, 0), b3, voffB); PG8_STAGE(PG8_SB(1, 1), b3 + hstep, voffB); PG8_STAGE(PG8_SA(1, 0), a3, voffA);
            PG8_WAIT_V(8); PG8_WAIT_L(0); PG8_BAR; PG8_MMA(1, 0, At, B0); PG8_MMA(1, 1, At, B1); PG8_BAR; PG8_SCHED;
            } else {
            PG8_LDB(B0, 0, 0); PG8_SCHED; PG8_LDA(At, 0, 0); PG8_STAGE(PG8_SA(1, 1), a1 + hstepA, voffA);
            PG8_WAIT_L(8); PG8_BAR; PG8_WAIT_L(0); PG8_MMA(0, 0, At, B0); PG8_BAR; PG8_SCHED;
            PG8_LDB(B1, 0, 1); PG8_STAGE(PG8_SB(0, 0), b2, voffB);
            PG8_BAR; PG8_WAIT_L(0); PG8_MMA(0, 1, At, B1); PG8_BAR;
            PG8_LDA(At, 0, 1); PG8_STAGE(PG8_SA(0, 0), a2, voffA);
            PG8_BAR; PG8_WAIT_L(0); PG8_MMA(1, 0, At, B0); PG8_BAR; PG8_SCHED;
            PG8_STAGE(PG8_SB(0, 1), b2 + hstep, voffB);
            PG8_WAIT_V(6); PG8_BAR; PG8_MMA(1, 1, At, B1); PG8_BAR;
            PG8_LDB(B0, 1, 0); PG8_SCHED; PG8_LDA(At, 1, 0); PG8_STAGE(PG8_SA(0, 1), a2 + hstepA, voffA);
            PG8_WAIT_L(8); PG8_BAR; PG8_WAIT_L(0); PG8_MMA(0, 0, At, B0); PG8_BAR; PG8_SCHED;
            PG8_LDB(B1, 1, 1); PG8_STAGE(PG8_SB(1, 0), b3, voffB);
            PG8_BAR; PG8_WAIT_L(0); PG8_MMA(0, 1, At, B1); PG8_BAR;
            PG8_LDA(At, 1, 1); PG8_STAGE(PG8_SA(1, 0), a3, voffA);
            PG8_BAR; PG8_WAIT_L(0); PG8_MMA(1, 0, At, B0); PG8_BAR; PG8_SCHED;
            PG8_STAGE(PG8_SB(1, 1), b3 + hstep, voffB);
            PG8_WAIT_V(6); PG8_BAR; PG8_MMA(1, 1, At, B1); PG8_BAR;
            }
        }
        if constexpr (ALIGN_EPI) { if (wr == 0) PG8_BAR; }
        if constexpr (!Epi::AFTER_DRAIN) { E(acc, cur, wr, wc, fr, fq); S.done(cur); }
        if (!has_next) break;
#pragma unroll
        for (int a = 0; a < 2; ++a)
#pragma unroll
            for (int b = 0; b < 2; ++b)
#pragma unroll
                for (int m = 0; m < 4; ++m)
#pragma unroll
                    for (int n = 0; n < 2; ++n) acc[a][b][m][n] = (f32x4){0.f, 0.f, 0.f, 0.f};
        cur = nxt; cA = nA; cB = nB; ++ui;
        if constexpr (ALIGN_EPI) { if (wr == 1) PG8_BAR; }
    }
    PG8_WAIT_V(0);
    if constexpr (!ALIGN_EPI) { if (wr == 0) PG8_BAR; }
    PG8_BAR;
    if constexpr (Epi::AFTER_DRAIN) { E.fused(acc, cur, wr, wc, fr, fq, lds, wid, lane); S.done(cur); }
#undef PG8_SA
#undef PG8_SB
#undef PG8_STAGE
#undef PG8_LDA
#undef PG8_LDB
#undef PG8_MMA
#undef PG8_WAIT_V
#undef PG8_WAIT_L
#undef PG8_BAR
#undef PG8_SCHED
}
}

constexpr int NB = 32, T_ = 2048, DM = 1024, NTOK = NB * T_;
constexpr int NLAYER = 2;
constexpr int CIN = 10032, CPAD = 10240;
constexpr int FFH_ = 2816;
constexpr int NBC = 16, MC = NBC * T_, NCHUNK = NB / NBC, NSUB = NCHUNK + 1, NIT = NLAYER * NSUB;
constexpr int PPITCH = 6144;
static_assert(NBC == 16, "unit decodes below assume 16-batch chunks");
constexpr int PC_QR = 0, PC_KR = 1024, PC_VR = 2048, PC_GR = 4096, PC_QN = 6144, PC_KV = 7168, PC_MA = 7936, PC_MB = 8960, PC_GATE = 9984;
constexpr int NCMP = 127, NCMP_PAD = 128;
constexpr float LOG2E = 1.4426950408889634f;
constexpr float QSCALE = 0.125f * LOG2E;

constexpr size_t MiB = 1u << 20;
constexpr size_t WS_CTL = 0, CTL_ZERO_BYTES = 1 * MiB;
constexpr size_t WS_ROT = 1 * MiB;
constexpr size_t WS_T5 = 3 * MiB;
constexpr size_t WS_CB = 3 * MiB + 64 * 1024;
constexpr size_t WS_WIN = 4 * MiB;
constexpr size_t WS_WORET = 44 * MiB;
constexpr size_t WS_WONSA = 52 * MiB;
constexpr size_t WS_WOUT = 56 * MiB;
constexpr size_t WS_WFFI = 60 * MiB;
constexpr size_t WS_WFFO = 82 * MiB;
constexpr size_t WS_WC1 = 93 * MiB;
constexpr size_t WS_WC2 = 97 * MiB;
constexpr size_t WS_H = 100 * MiB;
constexpr size_t WS_BIG = 228 * MiB;
constexpr size_t WS_QKR = 612 * MiB;
constexpr size_t WS_ON = 612 * MiB;
constexpr size_t WS_TMP = 676 * MiB;
constexpr size_t WS_VR = 740 * MiB;
constexpr size_t WS_MERGED = 868 * MiB;
constexpr size_t WS_HIDP = 868 * MiB;
constexpr size_t WS_KC = 932 * MiB;
constexpr size_t WS_GNS = 934 * MiB;
constexpr size_t WS_XC = 942 * MiB;
constexpr size_t WS_KVX = 966 * MiB;
constexpr size_t WS_END = 998 * MiB;
constexpr int CW_TMO = 0, CW_BAR = 4096, CW_Q = 16384;

constexpr int NWAVES = 8;
constexpr int RING_BYTES = 131072, LDS_BYTES = 147456, LDSCTL_OFF = LDS_BYTES - 1024, MISC_OFF = LDSCTL_OFF + 320;

typedef pg8::bf16_t bf16;
typedef float f32x4 __attribute__((ext_vector_type(4)));
typedef float f32x2 __attribute__((ext_vector_type(2)));
typedef unsigned u32x4 __attribute__((ext_vector_type(4)));
typedef unsigned u32x2 __attribute__((ext_vector_type(2)));
#define LAS __attribute__((address_space(3)))
#define GAS __attribute__((address_space(1)))
#define RLX_AGENT __ATOMIC_RELAXED, __HIP_MEMORY_SCOPE_AGENT
#define LDS_WAIT() asm volatile("s_waitcnt lgkmcnt(0)" ::: "memory")
#define VM_WAIT() asm volatile("s_waitcnt vmcnt(0)" ::: "memory")
typedef GAS unsigned gu32;

__device__ __forceinline__ unsigned f2bf(float f) { unsigned u = __builtin_bit_cast(unsigned, f); return (u + 0x7fffu + ((u >> 16) & 1u)) >> 16; }
typedef __bf16 hbf16x2 __attribute__((ext_vector_type(2)));
__device__ __forceinline__ unsigned pk2(float lo, float hi) { const f32x2 v = {lo, hi}; return __builtin_bit_cast(unsigned, __builtin_convertvector(v, hbf16x2)); }
__device__ __forceinline__ float bf2f(unsigned short h) { return __builtin_bit_cast(float, (unsigned)h << 16); }
__device__ __forceinline__ float bflo(unsigned w) { return __builtin_bit_cast(float, w << 16); }
__device__ __forceinline__ float bfhi(unsigned w) { return __builtin_bit_cast(float, w & 0xffff0000u); }
__device__ __forceinline__ float sigm(float x) { return __builtin_amdgcn_rcpf(1.f + __builtin_amdgcn_exp2f(-LOG2E * x)); }
__device__ __forceinline__ float silu(float x) { return x * __builtin_amdgcn_rcpf(1.f + __builtin_amdgcn_exp2f(-LOG2E * x)); }
__device__ __forceinline__ float shx(float v, int m, int lane) { return __builtin_bit_cast(float, __builtin_amdgcn_ds_bpermute((lane ^ m) << 2, __builtin_bit_cast(int, v))); }
__device__ __forceinline__ float wave_sum(float v, int lane) {
#pragma unroll
    for (int o = 1; o < 64; o <<= 1) v += shx(v, o, lane);
    return v;
}
__device__ __forceinline__ float wave_max(float v, int lane) {
#pragma unroll
    for (int o = 1; o < 64; o <<= 1) v = fmaxf(v, shx(v, o, lane));
    return v;
}

__device__ __forceinline__ float gelu_tanh_f(float x) { const float u = 0.7978845608028654f * (x + 0.044715f * x * x * x); const float e = __builtin_amdgcn_exp2f(2.f * 1.4426950408889634f * u); return x * (1.f - __builtin_amdgcn_rcpf(e + 1.f)); }
namespace epi {
using pg8::Unit;
__device__ __forceinline__ u32x4 pack8(const f32x4 a, const f32x4 b) { u32x4 w; w.x = pk2(a[0], a[1]); w.y = pk2(a[2], a[3]); w.z = pk2(b[0], b[1]); w.w = pk2(b[2], b[3]); return w; }
__device__ __forceinline__ void unpack8(const u32x4 w, f32x4& a, f32x4& b) { a = (f32x4){bflo(w.x), bfhi(w.x), bflo(w.y), bfhi(w.y)}; b = (f32x4){bflo(w.z), bfhi(w.z), bflo(w.w), bfhi(w.w)}; }

struct EpiInProj {
    static constexpr bool PERM = true, AFTER_DRAIN = false;
    bf16* O; const float* rot; bf16* XC; bf16* QKR; bf16* VR; bf16* KVX;
    __device__ __forceinline__ void operator()(const f32x4 (&acc)[2][2][4][2], const Unit& u, int wr, int wc, int fr, int fq) const {
        const int pn = u.pn, row0 = u.pm * 256 + wr * 64 + fr, colw = wc * 32 + 8 * fq;
        bf16* base = O + (size_t)row0 * PPITCH + pn * 256 + colw;
        if (pn < 8) {
            const float sc = pn >= 4 ? 0.0625f : 1.f;
            const f32x4 fq8[2] = {*(const f32x4*)(rot + colw), *(const f32x4*)(rot + colw + 4)};
#pragma unroll
            for (int ai = 0; ai < 2; ++ai)
#pragma unroll
                for (int m = 0; m < 4; ++m) {
                    const int row = row0 + ai * 128 + m * 16, pos = row & (T_ - 1);
                    f32x4 y1[2], y2[2];
#pragma unroll
                    for (int n = 0; n < 2; ++n) { const f32x4 rev = fq8[n] * (float)pos; f32x4 c, s;
#pragma unroll
                        for (int i = 0; i < 4; ++i) { const float r_ = __builtin_amdgcn_fractf(rev[i]); c[i] = __builtin_amdgcn_cosf(r_); s[i] = __builtin_amdgcn_sinf(r_); }
                        const f32x4 x1 = acc[ai][0][m][n], x2 = acc[ai][1][m][n];
                        y1[n] = (x1 * c - x2 * s) * sc; y2[n] = (x1 * s + x2 * c) * sc; }
                    bf16* rp = QKR + ((size_t)(((pn >> 2) * NBC + (row >> 11)) * 4 + (pn & 3)) * T_ + pos) * 256 + colw;
                    *(u32x4*)(rp) = pack8(y1[0], y1[1]); *(u32x4*)(rp + 128) = pack8(y2[0], y2[1]);
                }
        } else if (pn < 16) {
            const int h2 = (pn - 8) >> 1, d0 = (wc & 1) * 32 + 8 * fq;
#pragma unroll
            for (int ai = 0; ai < 2; ++ai)
#pragma unroll
                for (int m = 0; m < 4; ++m) { const int row = row0 + ai * 128 + m * 16, bb = row >> 11, t = row & (T_ - 1);
#pragma unroll
                    for (int bj = 0; bj < 2; ++bj) { const int es = ((pn - 8) & 1) * 4 + 2 * bj + (wc >> 1);
                        *(u32x4*)(VR + ((size_t)((bb * 4 + h2) * 8 + es) * T_ + t) * 64 + d0) = pack8(acc[ai][bj][m][0], acc[ai][bj][m][1]); } }
        } else if (pn == 29 || pn == 30) {
            const int g2 = wc >> 1, d0 = (wc & 1) * 32 + 8 * fq;
#pragma unroll
            for (int ai = 0; ai < 2; ++ai)
#pragma unroll
                for (int m = 0; m < 4; ++m) { const int row = row0 + ai * 128 + m * 16, bb = row >> 11, t = row & (T_ - 1);
#pragma unroll
                    for (int bj = 0; bj < 2; ++bj) *(u32x4*)(KVX + ((size_t)((((pn - 29) * 2 + bj) * NBC + bb) * 2 + g2) * T_ + t) * 64 + d0) = pack8(acc[ai][bj][m][0], acc[ai][bj][m][1]); }
        } else if (pn == 28) {
            const int g2 = wc >> 1, d0 = (wc & 1) * 32 + 8 * fq;
#pragma unroll
            for (int ai = 0; ai < 2; ++ai)
#pragma unroll
                for (int m = 0; m < 4; ++m) { const int row = row0 + ai * 128 + m * 16, bb = row >> 11, t = row & (T_ - 1);
#pragma unroll
                    for (int bj = 0; bj < 2; ++bj) *(u32x4*)(XC + ((size_t)((bj * NBC + bb) * 2 + g2) * T_ + t) * 64 + d0) = pack8(acc[ai][bj][m][0], acc[ai][bj][m][1]); }
        } else {
            const int mode = (pn >= 24 && pn < 28) ? 2 : (pn >= 31) ? 3 : 0;
#pragma unroll
            for (int ai = 0; ai < 2; ++ai)
#pragma unroll
                for (int m = 0; m < 4; ++m) { bf16* rp = base + (size_t)(ai * 128 + m * 16) * PPITCH;
#pragma unroll
                    for (int bj = 0; bj < 2; ++bj) { f32x4 v0 = acc[ai][bj][m][0], v1 = acc[ai][bj][m][1];
                        if (mode == 1) {
#pragma unroll
                            for (int i = 0; i < 4; ++i) { v0[i] = silu(v0[i]); v1[i] = silu(v1[i]); } }
                        else if (mode == 2) { v0 = v0 * QSCALE; v1 = v1 * QSCALE; }
                        else if (mode == 3) {
#pragma unroll
                            for (int i = 0; i < 4; ++i) { v0[i] = sigm(v0[i]); v1[i] = sigm(v1[i]); } }
                        *(u32x4*)(rp + bj * 128) = pack8(v0, v1); } }
        }
    }
};
template <bool ADD> struct EpiGate {
    static constexpr bool PERM = true, AFTER_DRAIN = false;
    bf16* O; const bf16* P; const bf16* G; int ldo, ldg;
    __device__ __forceinline__ void operator()(const f32x4 (&acc)[2][2][4][2], const Unit& u, int wr, int wc, int fr, int fq) const {
        const int row0 = u.pm * 256 + wr * 64 + fr, col0 = u.pn * 256 + wc * 32 + 8 * fq;
#pragma unroll
        for (int ai = 0; ai < 2; ++ai)
#pragma unroll
            for (int m = 0; m < 4; ++m) { const size_t r = (size_t)(row0 + ai * 128 + m * 16);
#pragma unroll
                for (int bj = 0; bj < 2; ++bj) { const int c = col0 + bj * 128;
                    f32x4 g0, g1; unpack8(*(const u32x4*)(G + r * ldg + c), g0, g1);
                    f32x4 v0 = acc[ai][bj][m][0] * g0, v1 = acc[ai][bj][m][1] * g1;
                    if (ADD) { f32x4 p0, p1; unpack8(*(const u32x4*)(P + r * ldo + c), p0, p1); v0 += p0; v1 += p1; }
                    *(u32x4*)(O + r * ldo + c) = pack8(v0, v1); } }
    }
};
template <bool SRC_F32> struct EpiResid {
    static constexpr bool PERM = true, AFTER_DRAIN = false;
    const void* src; bf16* out;
    __device__ __forceinline__ void operator()(const f32x4 (&acc)[2][2][4][2], const Unit& u, int wr, int wc, int fr, int fq) const {
        const int row0 = u.pm * 256 + wr * 64 + fr, col0 = u.pn * 256 + wc * 32 + 8 * fq;
#pragma unroll
        for (int ai = 0; ai < 2; ++ai)
#pragma unroll
            for (int m = 0; m < 4; ++m) { const size_t off = (size_t)(row0 + ai * 128 + m * 16) * DM + col0;
#pragma unroll
                for (int bj = 0; bj < 2; ++bj) { f32x4 s0, s1;
                    if (SRC_F32) { s0 = *(const f32x4*)((const float*)src + off + bj * 128); s1 = *(const f32x4*)((const float*)src + off + bj * 128 + 4); }
                    else unpack8(*(const u32x4*)((const bf16*)src + off + bj * 128), s0, s1);
                    *(u32x4*)(out + off + bj * 128) = pack8(s0 + acc[ai][bj][m][0], s1 + acc[ai][bj][m][1]); } }
    }
};
struct EpiSwiGlu {
    static constexpr bool PERM = true, AFTER_DRAIN = false;
    bf16* O;
    __device__ __forceinline__ void operator()(const f32x4 (&acc)[2][2][4][2], const Unit& u, int wr, int wc, int fr, int fq) const {
        const int row0 = u.pm * 256 + wr * 64 + fr, col0 = u.pn * 128 + wc * 32 + 8 * fq;
#pragma unroll
        for (int ai = 0; ai < 2; ++ai)
#pragma unroll
            for (int m = 0; m < 4; ++m) { f32x4 v[2];
#pragma unroll
                for (int n = 0; n < 2; ++n) { const f32x4 a = acc[ai][0][m][n], b = acc[ai][1][m][n];
#pragma unroll
                    for (int i = 0; i < 4; ++i) v[n][i] = silu(a[i]) * b[i]; }
                *(u32x4*)(O + (size_t)(row0 + ai * 128 + m * 16) * FFH_ + col0) = pack8(v[0], v[1]); }
    }
};
struct CmpOrder {
    int c, G;
    __device__ __forceinline__ bool next(int i, Unit& u) const { const int id = i * G + c; if (id >= 16 * NBC) return false; const int rt = (id >> 3) & (NBC - 1), kv = id / (8 * NBC); u.pm = kv * NBC + rt; u.pn = kv; return true; }
    __device__ __forceinline__ void a_ready(const Unit&) const {}
    __device__ __forceinline__ void done(const Unit&) const {}
};
struct EpiCmpPart {
    static constexpr bool PERM = false, AFTER_DRAIN = false;
    float* HIDP; int ks;
    __device__ __forceinline__ void operator()(const f32x4 (&acc)[2][2][4][2], const Unit& u, int wr, int wc, int fr, int fq) const {
        const int row0 = u.pm * 256 + wr * 64 + fr, col0 = wc * 32 + 4 * fq;
        float* base = HIDP + ((size_t)ks * (NBC * 512) + row0) * 256 + col0;
#pragma unroll
        for (int ai = 0; ai < 2; ++ai)
#pragma unroll
            for (int m = 0; m < 4; ++m)
#pragma unroll
                for (int bj = 0; bj < 2; ++bj)
#pragma unroll
                    for (int n = 0; n < 2; ++n) *(f32x4*)(base + (size_t)(ai * 128 + m * 16) * 256 + bj * 128 + n * 16) = acc[ai][bj][m][n];
    }
};
}
#define XB_TMO      128
#define XB_XCNT(j)  (256  + 64 * (j))
#define XB_XSUB(j)  (1280 + 64 * (j))
#define XB_XGEN(j)  (2304 + 64 * (j))
#define XB_TOP      3328
#define XB_TOPGEN   3392
#define XCD_BAR_WORDS 3456
#define XB_SPIN_CAP (1u << 18)

__device__ __forceinline__ unsigned xb_ld(unsigned* p)              { return __hip_atomic_load(p, __ATOMIC_RELAXED, __HIP_MEMORY_SCOPE_AGENT); }
__device__ __forceinline__ unsigned xb_add(unsigned* p, unsigned v) { return __hip_atomic_fetch_add(p, v, __ATOMIC_RELAXED, __HIP_MEMORY_SCOPE_AGENT); }
__device__ __forceinline__ unsigned xb_xcc_id() { return (unsigned)__builtin_amdgcn_s_getreg((3 << 11) | 20) & 0xFu; }
#define XB_SPIN(cond, bar) do { unsigned _sp = 0; while (cond) { __builtin_amdgcn_s_sleep(1); \
    if ((++_sp & 255u) == 0u) { if (xb_ld(&(bar)[XB_TMO])) break; if (_sp > XB_SPIN_CAP) { atomicAdd(&(bar)[XB_TMO], 1u); break; } } } } while (0)

struct XcdBarrier {
    unsigned* bar; unsigned x;
    volatile LAS unsigned* st;
};

__device__ __forceinline__ XcdBarrier xcd_barrier_post(unsigned* bar, volatile LAS unsigned* st) {
    XcdBarrier b; b.bar = bar; b.x = xb_xcc_id(); b.st = st;
    if (threadIdx.x == 0) (void)xb_add(&bar[XB_XCNT(b.x)], 1u);
    return b;
}
__device__ __forceinline__ void xcd_barrier_complete(unsigned* bar, unsigned x, unsigned& nloc, unsigned& nx) {
    const unsigned G = gridDim.x * gridDim.y * gridDim.z;
    unsigned sum, cnt, mine, sp = 0u;
    for (;;) {
        sum = 0u; cnt = 0u; mine = 0u;
#pragma unroll
        for (unsigned j = 0; j < 16; ++j) { const unsigned c = xb_ld(&bar[XB_XCNT(j)]); sum += c; cnt += (c > 0u) ? 1u : 0u; mine = (j == x) ? c : mine; }
        if (sum == G) break;
        __builtin_amdgcn_s_sleep(1);
        if ((++sp & 255u) == 0u) { if (xb_ld(&bar[XB_TMO])) break; if (sp > XB_SPIN_CAP) { atomicAdd(&bar[XB_TMO], 1u); break; } }
    }
    nloc = mine > 0u ? mine : 1u; nx = cnt > 0u ? cnt : 1u;
}

__device__ __forceinline__ void xcd_barrier(const XcdBarrier& b, const bool tid0) {
    asm volatile("s_waitcnt vmcnt(0)" ::: "memory");
    __syncthreads();
    if (tid0) {
        unsigned* bar = b.bar;
        __builtin_amdgcn_s_waitcnt(0);
        unsigned nloc = b.st[0], nx = b.st[1];
        if (nloc == 0u) { xcd_barrier_complete(bar, b.x, nloc, nx); b.st[0] = nloc; b.st[1] = nx; }
        const unsigned old = xb_add(&bar[XB_XSUB(b.x)], 1u);
        const unsigned gen = old / nloc;
        if (old + 1u == (gen + 1u) * nloc) {
            __builtin_amdgcn_fence(__ATOMIC_RELEASE, "agent");
            asm volatile("s_waitcnt vmcnt(0)" ::: "memory");
            const unsigned og = xb_add(&bar[XB_TOP], 1u);
            const unsigned tg = og / nx;
            if (og + 1u == (tg + 1u) * nx) xb_add(&bar[XB_TOPGEN], 1u);
            else XB_SPIN(xb_ld(&bar[XB_TOPGEN]) == tg, bar);
            __builtin_amdgcn_fence(__ATOMIC_ACQUIRE, "agent");
            xb_add(&bar[XB_XGEN(b.x)], 1u);
            asm volatile("s_waitcnt vmcnt(0)" ::: "memory");
        } else {
            XB_SPIN(xb_ld(&bar[XB_XGEN(b.x)]) == gen, bar);
            __builtin_amdgcn_fence(__ATOMIC_ACQUIRE, "agent");
            asm volatile("s_waitcnt vmcnt(0)" ::: "memory");
        }
    }
    __syncthreads();
}

struct Args { const float* in[17]; float* out; unsigned char* ws; int it_lo, it_hi, ph_lo, ph_hi, flags, pad; };

struct Ctx { LAS unsigned char* lds; int tid, lane, wave, G, bid; };
typedef const __attribute__((address_space(4))) Args* KArgs;
__device__ __forceinline__ KArgs kargs() { unsigned long long p = (unsigned long long)__builtin_amdgcn_kernarg_segment_ptr(); asm volatile("" : "+s"(p)); return (KArgs)p; }
#define AP (kargs())

template <class Map>
__device__ __forceinline__ void p0_transpose_item(const float* W, int K, int Nsrc, bf16* WT, int ngrp, LAS float* scr, int item, int lane, const Map& map) {
    const int kb = item / ngrp, nb = item % ngrp, k0 = 64 * kb, n0 = 32 * nb;
    const int sc = map(n0 + (lane & 31));
#pragma unroll
    for (int i = 0; i < 32; ++i) { const int kk = 2 * i + (lane >> 5); scr[kk * 33 + (lane & 31)] = sc >= 0 ? W[(size_t)(k0 + kk) * Nsrc + sc] : 0.f; }
    LDS_WAIT(); asm volatile("" ::: "memory");
    const int c = lane & 7;
#pragma unroll
    for (int j = 0; j < 4; ++j) { const int n = (lane >> 3) + 8 * j; const LAS float* s = scr + (8 * c) * 33 + n;
        u32x4 o; o.x = pk2(s[0 * 33], s[1 * 33]); o.y = pk2(s[2 * 33], s[3 * 33]); o.z = pk2(s[4 * 33], s[5 * 33]); o.w = pk2(s[6 * 33], s[7 * 33]);
        *(u32x4*)(WT + (size_t)(n0 + n) * K + k0 + 8 * c) = o; }
    LDS_WAIT(); asm volatile("" ::: "memory");
}
struct MapId { __device__ __forceinline__ int operator()(int n) const { return n; } };
struct MapWin { __device__ __forceinline__ int operator()(int n) const { return n < 7936 ? n : (n < 9984 ? n + 48 : (n < 10032 ? n - 2048 : -1)); } };
struct MapFfi { __device__ __forceinline__ int operator()(int n) const { const int pn = n >> 8, j = n & 255; return j < 128 ? 128 * pn + j : FFH_ + 128 * pn + (j - 128); } };

__device__ __forceinline__ void p0_prologue(const Ctx& C) {
    unsigned char* ws = AP->ws;
    LAS float* scr = (LAS float*)(C.lds + C.wave * 16384);
    const int gw = C.bid * NWAVES + C.wave, NGW = C.G * NWAVES;
    constexpr int I_IN = 16 * 320, I_OR = 32 * 32, I_ON = 16 * 32, I_OUT = 16 * 32, I_FI = 16 * 176, I_FO = 44 * 32, I_C1 = 32 * 8, I_L = I_IN + I_OR + I_ON + I_OUT + I_FI + I_FO + 2 * I_C1;
    for (int it = gw; it < NLAYER * I_L; it += NGW) {
        const int L = it / I_L; int r = it % I_L;
        if (r < I_IN) { p0_transpose_item(AP->in[2] + (size_t)L * DM * CIN, DM, CIN, (bf16*)(ws + WS_WIN) + (size_t)L * CPAD * DM, 320, scr, r, C.lane, MapWin()); continue; } r -= I_IN;
        if (r < I_OR) { p0_transpose_item(AP->in[9] + (size_t)L * 2048 * DM, 2048, DM, (bf16*)(ws + WS_WORET) + (size_t)L * DM * 2048, 32, scr, r, C.lane, MapId()); continue; } r -= I_OR;
        if (r < I_ON) { p0_transpose_item(AP->in[10] + (size_t)L * DM * DM, DM, DM, (bf16*)(ws + WS_WONSA) + (size_t)L * DM * DM, 32, scr, r, C.lane, MapId()); continue; } r -= I_ON;
        if (r < I_OUT) { p0_transpose_item(AP->in[11] + (size_t)L * DM * DM, DM, DM, (bf16*)(ws + WS_WOUT) + (size_t)L * DM * DM, 32, scr, r, C.lane, MapId()); continue; } r -= I_OUT;
        if (r < I_FI) { p0_transpose_item(AP->in[13] + (size_t)L * DM * 2 * FFH_, DM, 2 * FFH_, (bf16*)(ws + WS_WFFI) + (size_t)L * 2 * FFH_ * DM, 176, scr, r, C.lane, MapFfi()); continue; } r -= I_FI;
        if (r < I_FO) { p0_transpose_item(AP->in[14] + (size_t)L * FFH_ * DM, FFH_, DM, (bf16*)(ws + WS_WFFO) + (size_t)L * DM * FFH_, 32, scr, r, C.lane, MapId()); continue; } r -= I_FO;
        if (r < I_C1) { p0_transpose_item(AP->in[5] + (size_t)L * 2048 * 256, 2048, 256, (bf16*)(ws + WS_WC1) + (size_t)(L * 2 + 0) * 256 * 2048, 8, scr, r, C.lane, MapId()); continue; } r -= I_C1;
        p0_transpose_item(AP->in[7] + (size_t)L * 2048 * 256, 2048, 256, (bf16*)(ws + WS_WC1) + (size_t)(L * 2 + 1) * 256 * 2048, 8, scr, r, C.lane, MapId());
    }
    const int gt = C.bid * 512 + C.tid, NGT = C.G * 512;
    float* rot = (float*)(ws + WS_ROT);
    for (int i = gt; i < 128; i += NGT) rot[i] = (float)(pow(10000.0, -(double)i / 128.0) / 6.283185307179586476925);
    float* cbp = (float*)(ws + WS_CB);
    for (int i = gt; i < NLAYER * 2 * 256; i += NGT) { const int hid = i & 255, kv = (i >> 8) & 1, L = i >> 9; const float* pe = (kv ? AP->in[4] : AP->in[3]) + L * 2048; const float* w1 = (kv ? AP->in[7] : AP->in[5]) + (size_t)L * 2048 * 256 + hid;
        float s_ = 0.f; for (int k = 0; k < 2048; ++k) s_ += pe[k] * w1[(size_t)k * 256]; cbp[i] = s_; }
    float* t5 = (float*)(ws + WS_T5);
    for (int i = gt; i < 16 * 128; i += NGT) { const int hd = i >> 7, dist = i & 127; int bk = dist;
        if (dist >= 16) { bk = 16 + (int)(log((double)dist / 16.0) / log(8.0) * 16.0); if (bk > 31) bk = 31; }
        t5[i] = AP->in[15][bk * 16 + hd] * LOG2E; }
}

template <int NR>
__device__ __forceinline__ void rms_rows_to_bf16(const float* x, const float* g, bf16* o, int m, int stride, int lane) {
    f32x4 v[NR][4];
#pragma unroll
    for (int r = 0; r < NR; ++r) { const f32x4* xr = (const f32x4*)(x + (size_t)(m + r * stride) * DM) + lane;
#pragma unroll
        for (int j = 0; j < 4; ++j) v[r][j] = xr[64 * j]; }
    f32x4 gg[4];
#pragma unroll
    for (int j = 0; j < 4; ++j) gg[j] = ((const f32x4*)g + lane)[64 * j];
#pragma unroll
    for (int r = 0; r < NR; ++r) { float s = 0.f;
#pragma unroll
        for (int j = 0; j < 4; ++j) s += (v[r][j].x * v[r][j].x + v[r][j].y * v[r][j].y) + (v[r][j].z * v[r][j].z + v[r][j].w * v[r][j].w);
        const float rs = 1.f / sqrtf(wave_sum(s, lane) * (1.f / DM) + 1e-6f);
        u32x2* o8 = (u32x2*)(o + (size_t)(m + r * stride) * DM) + lane;
#pragma unroll
        for (int j = 0; j < 4; ++j) { u32x2 w; w.x = pk2(v[r][j].x * rs * gg[j].x, v[r][j].y * rs * gg[j].y); w.y = pk2(v[r][j].z * rs * gg[j].z, v[r][j].w * rs * gg[j].w); o8[64 * j] = w; } }
}
template <int NR>
__device__ __forceinline__ void rms_rows_bf16_to_bf16(const bf16* x, const float* g, bf16* o, int m, int stride, int lane) {
    u32x4 v[NR][2];
#pragma unroll
    for (int r = 0; r < NR; ++r) { const u32x4* xr = (const u32x4*)(x + (size_t)(m + r * stride) * DM) + 2 * lane; v[r][0] = xr[0]; v[r][1] = xr[1]; }
    f32x4 gg[4];
#pragma unroll
    for (int j = 0; j < 4; ++j) gg[j] = ((const f32x4*)g + 4 * lane)[j];
#pragma unroll
    for (int r = 0; r < NR; ++r) { f32x4 a[4]; epi::unpack8(v[r][0], a[0], a[1]); epi::unpack8(v[r][1], a[2], a[3]); float s = 0.f;
#pragma unroll
        for (int j = 0; j < 4; ++j) s += (a[j].x * a[j].x + a[j].y * a[j].y) + (a[j].z * a[j].z + a[j].w * a[j].w);
        const float rs = 1.f / sqrtf(wave_sum(s, lane) * (1.f / DM) + 1e-6f);
        u32x4* o8 = (u32x4*)(o + (size_t)(m + r * stride) * DM) + 2 * lane;
        o8[0] = epi::pack8(a[0] * rs * gg[0], a[1] * rs * gg[1]); o8[1] = epi::pack8(a[2] * rs * gg[2], a[3] * rs * gg[3]); }
}
__device__ __forceinline__ void rms_row_final(const bf16* xrow, const float* g, float* orow, int lane) {
    const u32x4* xr = (const u32x4*)xrow + 2 * lane; const u32x4 v0 = xr[0], v1 = xr[1]; f32x4 a[4]; epi::unpack8(v0, a[0], a[1]); epi::unpack8(v1, a[2], a[3]); float s = 0.f;
#pragma unroll
    for (int j = 0; j < 4; ++j) s += (a[j].x * a[j].x + a[j].y * a[j].y) + (a[j].z * a[j].z + a[j].w * a[j].w);
    const float rs = 1.f / sqrtf(wave_sum(s, lane) * (1.f / DM) + 1e-6f);
#pragma unroll
    for (int j = 0; j < 4; ++j) ((f32x4*)orow + 4 * lane)[j] = a[j] * rs * ((const f32x4*)g + 4 * lane)[j];
}
typedef short s16x4 __attribute__((ext_vector_type(4)));
typedef short bf16x8 __attribute__((ext_vector_type(8)));
#define MFMA16(a, b, c) __builtin_amdgcn_mfma_f32_16x16x32_bf16((a), (b), (c), 0, 0, 0)
constexpr int RK_PITCH = 528, RV_PITCH = 144, RR_PITCH = 528;
constexpr int RL_K = 0, RL_V = 128 * RK_PITCH, RL_R = RL_V + 128 * RV_PITCH, RL_END = RL_R + 64 * RR_PITCH;
static_assert(RL_END <= RING_BYTES, "retention LDS map");
__device__ __forceinline__ bf16x8 tr_frag(LAS unsigned char* tile, int pitch, int rowA, int rowB, int col0, int lane) {
    const int q = (lane & 15) >> 2, p = lane & 3;
    const s16x4 a = __builtin_amdgcn_ds_read_tr16_b64_v4i16((LAS s16x4*)(tile + (rowA + q) * pitch + (col0 + 4 * p) * 2));
    const s16x4 b = __builtin_amdgcn_ds_read_tr16_b64_v4i16((LAS s16x4*)(tile + (rowB + q) * pitch + (col0 + 4 * p) * 2));
    return __builtin_shufflevector(a, b, 0, 1, 2, 3, 4, 5, 6, 7);
}
__device__ __forceinline__ bf16x8 tr_frag2(LAS unsigned char* lb, int offA, int offB) {
    const s16x4 a = __builtin_amdgcn_ds_read_tr16_b64_v4i16((LAS s16x4*)(lb + offA));
    const s16x4 b = __builtin_amdgcn_ds_read_tr16_b64_v4i16((LAS s16x4*)(lb + offB));
    return __builtin_shufflevector(a, b, 0, 1, 2, 3, 4, 5, 6, 7);
}
__device__ __forceinline__ void tr_read16(unsigned a0, unsigned a1, unsigned a2, unsigned a3, s16x4 (&r)[16]) {
    asm volatile("ds_read_b64_tr_b16 %0, %16\n\tds_read_b64_tr_b16 %1, %16 offset:2048\n\tds_read_b64_tr_b16 %2, %16 offset:4096\n\tds_read_b64_tr_b16 %3, %16 offset:6144\n\t"
                 "ds_read_b64_tr_b16 %4, %17\n\tds_read_b64_tr_b16 %5, %17 offset:2048\n\tds_read_b64_tr_b16 %6, %17 offset:4096\n\tds_read_b64_tr_b16 %7, %17 offset:6144\n\t"
                 "ds_read_b64_tr_b16 %8, %18\n\tds_read_b64_tr_b16 %9, %18 offset:2048\n\tds_read_b64_tr_b16 %10, %18 offset:4096\n\tds_read_b64_tr_b16 %11, %18 offset:6144\n\t"
                 "ds_read_b64_tr_b16 %12, %19\n\tds_read_b64_tr_b16 %13, %19 offset:2048\n\tds_read_b64_tr_b16 %14, %19 offset:4096\n\tds_read_b64_tr_b16 %15, %19 offset:6144\n\t"
                 "s_waitcnt lgkmcnt(0)"
                 : "=&v"(r[0]), "=&v"(r[1]), "=&v"(r[2]), "=&v"(r[3]), "=&v"(r[4]), "=&v"(r[5]), "=&v"(r[6]), "=&v"(r[7]),
                   "=&v"(r[8]), "=&v"(r[9]), "=&v"(r[10]), "=&v"(r[11]), "=&v"(r[12]), "=&v"(r[13]), "=&v"(r[14]), "=&v"(r[15])
                 : "v"(a0), "v"(a1), "v"(a2), "v"(a3) : "memory");
}
__device__ __forceinline__ bf16x8 pack_bf8(const f32x4 a, const f32x4 b) { u32x4 w; w.x = pk2(a[0], a[1]); w.y = pk2(a[2], a[3]); w.z = pk2(b[0], b[1]); w.w = pk2(b[2], b[3]); return __builtin_bit_cast(bf16x8, w); }

__device__ __forceinline__ void ret_unit(const Ctx& C, int u, const bf16* QKR, const bf16* VR, bf16* ORET, float* GNP) {
    const int es = u & 7, h = (u >> 3) & 3, b = u >> 5;
    const int lane = C.lane, w = C.wave, i16 = lane & 15, g = lane >> 4, tid = C.tid;
    LAS unsigned char* lds = C.lds;
    const size_t tok0 = (size_t)b * T_;
    const float l2g = log2f(1.f - exp2f(-5.f - (float)h));
    const float xi = exp2f(l2g * (float)(w * 16 + i16 + 1));
    const float gchunk = exp2f(l2g * 128.f);
    float dbase[4];
#pragma unroll
    for (int r = 0; r < 4; ++r) dbase[r] = exp2f(l2g * (float)(i16 - 4 * g - r));
    f32x4 racc[2][4];
#pragma unroll
    for (int dt = 0; dt < 2; ++dt)
#pragma unroll
        for (int et = 0; et < 4; ++et) racc[dt][et] = (f32x4){0.f, 0.f, 0.f, 0.f};
    u32x4 stK[8], stV[2]; bf16x8 qfrag[8];
    const unsigned kvo = (unsigned)(tid >> 5) * 512u + (unsigned)(tid & 31) * 16u, vvo = (unsigned)(tid >> 3) * 128u + (unsigned)(tid & 7) * 16u;
    const unsigned qvo = (unsigned)(w * 16 + i16) * 512u + (unsigned)g * 16u;
    const int klo = RL_K + (tid >> 5) * RK_PITCH + (tid & 31) * 16, vlo = RL_V + (tid >> 3) * RV_PITCH + (tid & 7) * 16;
    const char* kch = (const char*)(QKR + ((size_t)((1 * NBC + b) * 4 + h) * T_) * 256);
    const char* vch = (const char*)(VR + ((size_t)((b * 4 + h) * 8 + es) * T_) * 64);
    const char* qch = (const char*)(QKR + ((size_t)((0 * NBC + b) * 4 + h) * T_) * 256);
#pragma unroll
    for (int i = 0; i < 8; ++i) stK[i] = *(const u32x4*)(kch + (size_t)i * 16 * 512 + kvo);
#pragma unroll
    for (int i = 0; i < 2; ++i) stV[i] = *(const u32x4*)(vch + (size_t)i * 64 * 128 + vvo);
#pragma unroll
    for (int kb = 0; kb < 8; ++kb) qfrag[kb] = *(const bf16x8*)(qch + kb * 64 + qvo);
#pragma unroll
    for (int i = 0; i < 8; ++i) *(LAS u32x4*)(lds + klo + i * 16 * RK_PITCH) = stK[i];
#pragma unroll
    for (int i = 0; i < 2; ++i) *(LAS u32x4*)(lds + vlo + i * 64 * RV_PITCH) = stV[i];
    __syncthreads();
    for (int c = 0; c < 16; ++c) {
        const bool more = c + 1 < 16;
        int lane_c = lane; float l2c = l2g; asm volatile("" : "+v"(lane_c), "+v"(l2c));
        const int i16 = lane_c & 15, g = lane_c >> 4;
        const char* kn = kch + (size_t)(c + 1) * 128 * 512; const char* vn = vch + (size_t)(c + 1) * 128 * 128; const char* qn = qch + (size_t)(c + 1) * 128 * 512;
        if (more) {
#pragma unroll
            for (int i = 0; i < 8; ++i) stK[i] = *(const u32x4*)(kn + (size_t)i * 16 * 512 + kvo);
#pragma unroll
            for (int i = 0; i < 2; ++i) stV[i] = *(const u32x4*)(vn + (size_t)i * 64 * 128 + vvo);
        }
        f32x4 oacc[4];
#pragma unroll
        for (int et = 0; et < 4; ++et) oacc[et] = (f32x4){0.f, 0.f, 0.f, 0.f};
        if (c > 0) {
            LAS unsigned char* rl_ = lds + RL_R + i16 * RR_PITCH + g * 16;
#pragma unroll
            for (int hf = 0; hf < 2; ++hf) { bf16x8 rf[4][4];
#pragma unroll
                for (int k = 0; k < 4; ++k)
#pragma unroll
                    for (int et = 0; et < 4; ++et) rf[et][k] = *(const LAS bf16x8*)(rl_ + et * 16 * RR_PITCH + (hf * 4 + k) * 64);
                __builtin_amdgcn_sched_barrier(0);
#pragma unroll
                for (int k = 0; k < 4; ++k)
#pragma unroll
                    for (int et = 0; et < 4; ++et) oacc[et] = MFMA16(rf[et][k], qfrag[hf * 4 + k], oacc[et]); }
#pragma unroll
            for (int et = 0; et < 4; ++et) oacc[et] = oacc[et] * xi;
        }
        for (int i = 0; i <= (w >> 1); ++i) {
            const int mb0 = 2 * i, mb1 = 2 * i + 1;
            f32x4 sa0 = (f32x4){0.f, 0.f, 0.f, 0.f}, sa1 = sa0, sb0 = sa0, sb1 = sa0;
            LAS unsigned char* kl_ = lds + RL_K + (mb0 * 16 + i16) * RK_PITCH + g * 16;
            { bf16x8 kf[8];
#pragma unroll
              for (int kb = 0; kb < 8; ++kb) kf[kb] = *(const LAS bf16x8*)(kl_ + kb * 64);
              __builtin_amdgcn_sched_barrier(0);
#pragma unroll
              for (int kb = 0; kb < 8; kb += 2) { sa0 = MFMA16(kf[kb], qfrag[kb], sa0); sa1 = MFMA16(kf[kb + 1], qfrag[kb + 1], sa1); } }
            if (mb1 <= w) { bf16x8 kf[8];
#pragma unroll
                for (int kb = 0; kb < 8; ++kb) kf[kb] = *(const LAS bf16x8*)(kl_ + 16 * RK_PITCH + kb * 64);
                __builtin_amdgcn_sched_barrier(0);
#pragma unroll
                for (int kb = 0; kb < 8; kb += 2) { sb0 = MFMA16(kf[kb], qfrag[kb], sb0); sb1 = MFMA16(kf[kb + 1], qfrag[kb + 1], sb1); } }
            f32x4 sa = sa0 + sa1, sb = sb0 + sb1;
            const float ga = exp2f(l2c * (float)(16 * (w - mb0))), gb = exp2f(l2c * (float)(16 * (w - mb1)));
#pragma unroll
            for (int r = 0; r < 4; ++r) { const bool da = (mb0 < w) || (i16 - 4 * g - r >= 0), db = (mb1 < w) || (i16 - 4 * g - r >= 0);
                sa[r] = da ? sa[r] * (dbase[r] * ga) : 0.f; sb[r] = (mb1 <= w && db) ? sb[r] * (dbase[r] * gb) : 0.f; }
            const bf16x8 sf = pack_bf8(sa, sb);
            bf16x8 vf[4];
#pragma unroll
            for (int et = 0; et < 4; ++et) vf[et] = tr_frag(lds + RL_V, RV_PITCH, mb0 * 16 + 4 * g, mb1 * 16 + 4 * g, et * 16, lane_c);
            __builtin_amdgcn_sched_barrier(0);
#pragma unroll
            for (int et = 0; et < 4; ++et) oacc[et] = MFMA16(vf[et], sf, oacc[et]);
        }
        { const size_t tok = tok0 + (size_t)c * 128 + w * 16 + i16; float s1 = 0.f, s2 = 0.f;
#pragma unroll
          for (int et = 0; et < 4; ++et) { const f32x4 o = oacc[et]; s1 += (o[0] + o[1]) + (o[2] + o[3]); s2 += (o[0] * o[0] + o[1] * o[1]) + (o[2] * o[2] + o[3] * o[3]);
              u32x2 wv; wv.x = pk2(o[0], o[1]); wv.y = pk2(o[2], o[3]); *(u32x2*)(ORET + tok * 2048 + h * 512 + es * 64 + et * 16 + 4 * g) = wv; }
          s1 += shx(s1, 16, lane_c); s1 += shx(s1, 32, lane_c); s2 += shx(s2, 16, lane_c); s2 += shx(s2, 32, lane_c);
          if (g == 0) *(f32x2*)(GNP + ((tok * 4 + h) * 8 + es) * 2) = (f32x2){s1, s2}; }
        if (more) {
#pragma unroll
            for (int kb = 0; kb < 8; ++kb) qfrag[kb] = *(const bf16x8*)(qn + kb * 64 + qvo);
        }
#pragma unroll
        for (int dt = 0; dt < 2; ++dt)
#pragma unroll
            for (int et = 0; et < 4; ++et) racc[dt][et] = racc[dt][et] * gchunk;
#pragma unroll
        for (int kb = 0; kb < 4; ++kb) {
            float zl[8];
#pragma unroll
            for (int j = 0; j < 8; ++j) zl[j] = __builtin_amdgcn_exp2f(l2c * (float)(127 - 32 * kb - 8 * g - j));
            bf16x8 raw[2], vf[4];
#pragma unroll
            for (int dt = 0; dt < 2; ++dt) raw[dt] = tr_frag(lds + RL_K, RK_PITCH, kb * 32 + 8 * g, kb * 32 + 8 * g + 4, (2 * w + dt) * 16, lane_c);
#pragma unroll
            for (int et = 0; et < 4; ++et) vf[et] = tr_frag(lds + RL_V, RV_PITCH, kb * 32 + 8 * g, kb * 32 + 8 * g + 4, et * 16, lane_c);
            __builtin_amdgcn_sched_barrier(0);
            bf16x8 af[2];
#pragma unroll
            for (int dt = 0; dt < 2; ++dt) { const u32x4 rw = __builtin_bit_cast(u32x4, raw[dt]); u32x4 o;
                o.x = pk2(bflo(rw.x) * zl[0], bfhi(rw.x) * zl[1]); o.y = pk2(bflo(rw.y) * zl[2], bfhi(rw.y) * zl[3]);
                o.z = pk2(bflo(rw.z) * zl[4], bfhi(rw.z) * zl[5]); o.w = pk2(bflo(rw.w) * zl[6], bfhi(rw.w) * zl[7]);
                af[dt] = __builtin_bit_cast(bf16x8, o); }
#pragma unroll
            for (int et = 0; et < 4; ++et)
#pragma unroll
                for (int dt = 0; dt < 2; ++dt) racc[dt][et] = MFMA16(af[dt], vf[et], racc[dt][et]);
        }
        __syncthreads();
        if (more) {
#pragma unroll
            for (int dt = 0; dt < 2; ++dt)
#pragma unroll
                for (int et = 0; et < 4; ++et) { const f32x4 rv = racc[dt][et]; u32x2 wv; wv.x = pk2(rv[0], rv[1]); wv.y = pk2(rv[2], rv[3]);
                    *(LAS u32x2*)(lds + RL_R + (et * 16 + i16) * RR_PITCH + ((2 * w + dt) * 16 + 4 * g) * 2) = wv; }
#pragma unroll
            for (int i = 0; i < 8; ++i) *(LAS u32x4*)(lds + klo + i * 16 * RK_PITCH) = stK[i];
#pragma unroll
            for (int i = 0; i < 2; ++i) *(LAS u32x4*)(lds + vlo + i * 64 * RV_PITCH) = stV[i];
        }
        __syncthreads();
    }
}
template <int NR>
__device__ __forceinline__ void gn_gate_rows(const bf16* PROJ, bf16* ORET, const float* GNP, int m, int stride, int lane) {
    u32x4 ow[NR][4], gw[NR][4]; f32x4 st[NR][4];
#pragma unroll
    for (int r = 0; r < NR; ++r) { const size_t tok = (size_t)(m + r * stride);
#pragma unroll
        for (int h = 0; h < 4; ++h) { ow[r][h] = *(const u32x4*)(ORET + tok * 2048 + h * 512 + lane * 8); gw[r][h] = *(const u32x4*)(PROJ + tok * PPITCH + PC_GR + h * 512 + lane * 8);
            st[r][h] = *((const f32x4*)(GNP + (tok * 4 + h) * 16) + (lane & 3)); } }
#pragma unroll
    for (int r = 0; r < NR; ++r) { const size_t tok = (size_t)(m + r * stride);
#pragma unroll
        for (int h = 0; h < 4; ++h) { float s1 = st[r][h][0] + st[r][h][2], s2 = st[r][h][1] + st[r][h][3];
            s1 += shx(s1, 1, lane); s2 += shx(s2, 1, lane); s1 += shx(s1, 2, lane); s2 += shx(s2, 2, lane);
            const float mean = s1 * (1.f / 512.f), var = fmaxf(s2 * (1.f / 512.f) - mean * mean, 0.f), rstd = 1.f / sqrtf(var + 1e-5f);
            const u32x4 a = ow[r][h], g = gw[r][h]; u32x4 o;
            o.x = pk2((bflo(a.x) - mean) * rstd * silu(bflo(g.x)), (bfhi(a.x) - mean) * rstd * silu(bfhi(g.x))); o.y = pk2((bflo(a.y) - mean) * rstd * silu(bflo(g.y)), (bfhi(a.y) - mean) * rstd * silu(bfhi(g.y)));
            o.z = pk2((bflo(a.z) - mean) * rstd * silu(bflo(g.z)), (bfhi(a.z) - mean) * rstd * silu(bfhi(g.z))); o.w = pk2((bflo(a.w) - mean) * rstd * silu(bflo(g.w)), (bfhi(a.w) - mean) * rstd * silu(bfhi(g.w)));
            *(u32x4*)(ORET + tok * 2048 + h * 512 + lane * 8) = o; } }
}


constexpr int NL_T5 = 0, NL_T5H = 384, NL_TILE = 64 * 144, NL_K0 = 8 * NL_T5H * 4, NL_V0 = NL_K0 + 2 * NL_TILE, NL_IMP = NL_K0 + 4 * NL_TILE, NL_XCH = NL_IMP + 8 * 64 * 33 * 4, NL_SEL = NL_XCH + 8 * 512 * 4, NL_GATE = NL_SEL + 512, NL_END = NL_GATE + 3 * 8 * 64 * 4;
constexpr int NL_RING = NL_K0, NL_SLOT = 16384, NL_Q = NL_RING + 3 * NL_SLOT;
static_assert(NL_Q + 8 * 8192 <= NL_SEL && NL_END <= LDSCTL_OFF, "NSA LDS map");
__device__ __forceinline__ float xmax4(float x) {
    float a = x, b = x;
    asm volatile("s_nop 1\n\tv_permlane16_swap_b32 %0, %1" : "+v"(a), "+v"(b));
    a = fmaxf(a, b); b = a;
    asm volatile("s_nop 1\n\tv_permlane32_swap_b32 %0, %1" : "+v"(a), "+v"(b));
    return fmaxf(a, b);
}
__device__ __forceinline__ float xsum4(float x) {
    float a = x, b = x;
    asm volatile("s_nop 1\n\tv_permlane16_swap_b32 %0, %1" : "+v"(a), "+v"(b));
    a = a + b; b = a;
    asm volatile("s_nop 1\n\tv_permlane32_swap_b32 %0, %1" : "+v"(a), "+v"(b));
    return a + b;
}
__device__ __forceinline__ int ishx(int v, int m, int lane) { return __builtin_amdgcn_ds_bpermute((lane ^ m) << 2, v); }

__device__ __forceinline__ void nsa_unit(const Ctx& C, int u, const bf16* PROJ, const bf16* KVX, const bf16* KCV, const float* t5, bf16* ON) {
    const int j_ = u >> 5, k_ = j_ & 7, r_ = j_ >> 3, qb = r_ == 0 ? 31 - k_ : r_ == 1 ? k_ : r_ == 2 ? 23 - k_ : 8 + k_, bg = u & 31, g_ = bg & 1, b = bg >> 1;
    int tid_u = C.tid; asm volatile("" : "+v"(tid_u));
    const int w = C.wave, tid = tid_u, lane = tid & 63, head = g_ * 8 + w, s0 = qb * 64, i16 = lane & 15, g = lane >> 4;
    LAS unsigned char* lds = C.lds;
    const size_t tok0 = (size_t)b * T_;
    LAS float* T5L = (LAS float*)(lds + NL_T5) + w * NL_T5H;
    LAS float* impH = (LAS float*)(lds + NL_IMP);
    LAS unsigned* selm = (LAS unsigned*)(lds + NL_SEL);
    for (int i = tid; i < 8 * NL_T5H; i += 512) { const int hh = i / NL_T5H, k = i - hh * NL_T5H; const float* th_ = t5 + (g_ * 8 + hh) * 128; float v;
        if (k < 256) { const int d = k - 64; v = d < 0 ? -1e30f : th_[d > 127 ? 127 : d]; } else v = (k - 256) < 64 ? th_[127] : -1e30f;
        ((LAS float*)(lds + NL_T5))[i] = v; }
    for (int i = tid; i < 64 * 24; i += 512) { const int tk = i / 24, c = i - tk * 24, hh = c / 3, br = c - hh * 3;
        ((LAS float*)(lds + NL_GATE))[(br * 8 + hh) * 64 + tk] = bf2f(PROJ[(tok0 + s0 + tk) * PPITCH + PC_GATE + g_ * 24 + c]); }
    { const bf16* kc = KCV + ((size_t)((0 * NBC + b) * 2 + g_) * NCMP_PAD) * 64; const bf16* vc = KCV + ((size_t)((1 * NBC + b) * 2 + g_) * NCMP_PAD) * 64;
#pragma unroll
      for (int i = 0; i < 2; ++i) { const int p = tid + 512 * i, row = p >> 3, c16 = p & 7;
          *(LAS u32x4*)(lds + NL_K0 + row * 144 + c16 * 16) = *(const u32x4*)(kc + row * 64 + c16 * 8);
          *(LAS u32x4*)(lds + NL_V0 + row * 144 + c16 * 16) = *(const u32x4*)(vc + row * 64 + c16 * 8); } }
    bf16x8 qf[4][2];
#pragma unroll
    for (int tt = 0; tt < 4; ++tt)
#pragma unroll
        for (int kb = 0; kb < 2; ++kb) qf[tt][kb] = *(const bf16x8*)(PROJ + (tok0 + s0 + tt * 16 + i16) * PPITCH + PC_QN + head * 64 + kb * 32 + 8 * g);
    __syncthreads();
    u32x2 fpk[4][4];
    const int ktmax = (4 * qb + 2) >> 4;
#pragma unroll
    for (int tt = 0; tt < 4; ++tt) {
        int lane_b = lane; asm volatile("" : "+v"(lane_b));
        const int i16 = lane_b & 15, g = lane_b >> 4;
        LAS unsigned char* kl = lds + NL_K0 + i16 * 144 + g * 16; LAS unsigned char* vl = lds + NL_V0 + (4 * g + ((lane_b & 15) >> 2)) * 144 + (lane_b & 3) * 8;
        const int pos = s0 + tt * 16 + i16;
        f32x4 st[8];
#pragma unroll
        for (int hf = 0; hf < 2; ++hf) {
            if (4 * hf <= ktmax) { bf16x8 kf[4][2];
#pragma unroll
                for (int k = 0; k < 4; ++k) { kf[k][0] = *(const LAS bf16x8*)(kl + (4 * hf + k) * 16 * 144); kf[k][1] = *(const LAS bf16x8*)(kl + (4 * hf + k) * 16 * 144 + 64); }
                __builtin_amdgcn_sched_barrier(0);
#pragma unroll
                for (int k = 0; k < 4; ++k) { st[4 * hf + k] = MFMA16(kf[k][0], qf[tt][0], ((f32x4){0.f, 0.f, 0.f, 0.f})); st[4 * hf + k] = MFMA16(kf[k][1], qf[tt][1], st[4 * hf + k]); }
            } else {
#pragma unroll
                for (int k = 0; k < 4; ++k) st[4 * hf + k] = (f32x4){-1e30f, -1e30f, -1e30f, -1e30f};
            } }
        float mx = -1e30f;
#pragma unroll
        for (int hf = 0; hf < 2; ++hf)
            if (4 * hf <= ktmax) { float tbv[4][4];
#pragma unroll
                for (int k = 0; k < 4; ++k)
#pragma unroll
                    for (int r = 0; r < 4; ++r) { const int dk = pos - 16 * ((4 * hf + k) * 16 + 4 * g + r) - 31 + 64; tbv[k][r] = T5L[dk < 0 ? 0 : (dk > 255 ? 255 : dk)]; }
#pragma unroll
                for (int k = 0; k < 4; ++k) { asm volatile("" : "+v"(tbv[k][0]), "+v"(tbv[k][1]), "+v"(tbv[k][2]), "+v"(tbv[k][3]));
#pragma unroll
                    for (int r = 0; r < 4; ++r) { const float l = fmaxf(st[4 * hf + k][r] + tbv[k][r], -1e30f); st[4 * hf + k][r] = l; mx = fmaxf(mx, l); } } }
        mx = xmax4(mx);
        float sum = 0.f;
#pragma unroll
        for (int kt = 0; kt < 8; ++kt)
#pragma unroll
            for (int r = 0; r < 4; ++r) { const float p = st[kt][r] > -1e29f ? __builtin_amdgcn_exp2f(st[kt][r] - mx) : 0.f; st[kt][r] = p; sum += p; }
        sum = xsum4(sum);
        const float inv = __builtin_amdgcn_rcpf(fmaxf(sum, 1e-30f));
        float rv[8];
#pragma unroll
        for (int kt = 0; kt < 8; ++kt) st[kt] = st[kt] * inv;
        { LAS float* xs = (LAS float*)(lds + NL_XCH) + w * 512;
#pragma unroll
          for (int kt = 0; kt < 8; ++kt) xs[kt * 64 + lane_b] = st[kt][3];
#pragma unroll
          for (int kt = 0; kt < 8; ++kt) rv[kt] = xs[kt * 64 + ((lane_b - 16) & 63)]; }
#pragma unroll
        for (int kt = 0; kt < 8; ++kt) { const float prev = g > 0 ? rv[kt] : (kt > 0 ? rv[kt > 0 ? kt - 1 : 0] : 0.f);
            impH[(w * 64 + tt * 16 + i16) * 33 + 4 * kt + g] = (st[kt][0] + st[kt][1]) + (st[kt][2] + st[kt][3]) + prev; }
        f32x4 o[4];
#pragma unroll
        for (int dt = 0; dt < 4; ++dt) o[dt] = (f32x4){0.f, 0.f, 0.f, 0.f};
#pragma unroll
        for (int i = 0; i < 4; ++i)
            if (2 * i <= ktmax) { const bf16x8 pf = pack_bf8(st[2 * i], st[2 * i + 1]); bf16x8 vf[4];
#pragma unroll
                for (int dt = 0; dt < 4; ++dt) vf[dt] = tr_frag2(vl, (2 * i) * 16 * 144 + dt * 32, (2 * i + 1) * 16 * 144 + dt * 32);
                __builtin_amdgcn_sched_barrier(0);
#pragma unroll
                for (int dt = 0; dt < 4; ++dt) o[dt] = MFMA16(vf[dt], pf, o[dt]); }
        const float g0 = ((LAS float*)(lds + NL_GATE))[(0 * 8 + w) * 64 + tt * 16 + i16];
#pragma unroll
        for (int dt = 0; dt < 4; ++dt) { const f32x4 v = o[dt] * g0; fpk[dt][tt].x = pk2(v[0], v[1]); fpk[dt][tt].y = pk2(v[2], v[3]); }
        __builtin_amdgcn_sched_barrier(0);
    }
    __syncthreads();
    int tid_s = C.tid; asm volatile("" : "+v"(tid_s));
    if (tid_s < 256) {
        const int tk = tid_s >> 2, part = tid_s & 3, lane = tid_s & 63;
        float im[8];
#pragma unroll
        for (int jj = 0; jj < 8; ++jj) { const int j = part * 8 + jj; float v = impH[tk * 33 + j];
#pragma unroll
            for (int hh = 1; hh < 8; ++hh) v += impH[(hh * 64 + tk) * 33 + j];
            im[jj] = v; }
        unsigned m = 1u | (1u << qb) | (qb > 0 ? (1u << (qb - 1)) : 0u);
        int cnt = __builtin_popcount(m);
        const int want = (qb + 1) < 8 ? (qb + 1) : 8;
        for (; cnt < want; ++cnt) {
            int best = 64; float bv = -1.f;
#pragma unroll
            for (int jj = 0; jj < 8; ++jj) { const int j = part * 8 + jj; const bool cand = j <= qb && !((m >> j) & 1u); if (cand && im[jj] > bv) { bv = im[jj]; best = j; } }
#pragma unroll
            for (int o = 1; o < 4; o <<= 1) { const float ov = shx(bv, o, lane); const int oi = ishx(best, o, lane); if (ov > bv || (ov == bv && oi < best)) { bv = ov; best = oi; } }
            if (best < 32) m |= 1u << best; }
        if (part == 0) selm[tk] = m;
        unsigned um = m;
#pragma unroll
        for (int o = 4; o < 64; o <<= 1) um |= (unsigned)ishx((int)um, o, lane);
        if (lane == 0) selm[64 + (tid_s >> 6)] = um;
    }
    __syncthreads();
    int tid_t = C.tid; asm volatile("" : "+v"(tid_t));
    const int lane2 = tid_t & 63;
    const unsigned umask = selm[64] | selm[65] | selm[66] | selm[67];
    unsigned selw[4];
#pragma unroll
    for (int tt = 0; tt < 4; ++tt) selw[tt] = selm[tt * 16 + (lane2 & 15)];
    const int nw = (qb < 8 ? qb : 8) + 1, ntile = nw + __builtin_popcount(umask);
    const float bfar = T5L[64 + 127];
    LAS unsigned char* qls = lds + NL_Q + w * 8192 + lane2 * 16;
#pragma unroll
    for (int tt = 0; tt < 4; ++tt)
#pragma unroll
        for (int kb = 0; kb < 2; ++kb) *(LAS bf16x8*)(qls + (tt * 2 + kb) * 1024) = qf[tt][kb];
    float mrun[4], lrun[4]; f32x4 oacc[4][4];
#pragma unroll
    for (int tt = 0; tt < 4; ++tt) { mrun[tt] = 0.f; lrun[tt] = 0.f;
#pragma unroll
        for (int dt = 0; dt < 4; ++dt) oacc[dt][tt] = (f32x4){0.f, 0.f, 0.f, 0.f}; }
    const unsigned dvo = (unsigned)(w * 8 + (lane2 >> 3)) * 128u + (unsigned)((lane2 & 7) ^ ((w * 4 + (lane2 >> 4)) & 7)) * 16u;
    const char* kvb = (const char*)(KVX + ((size_t)(b * 2 + g_) * T_) * 64);
#define NSA_DMA(blk_, br_, slot_) do { const char* sp_ = kvb + (size_t)((br_) ? 0 : 2) * (NBC * 2 * T_ * 64 * 2) + (size_t)(blk_) * 64 * 128 + dvo; \
        __builtin_amdgcn_global_load_lds((const unsigned*)sp_, (LAS unsigned*)(lds + NL_RING + (slot_) * NL_SLOT + w * 1024), 16, 0, 0); \
        __builtin_amdgcn_global_load_lds((const unsigned*)(sp_ + (size_t)NBC * 2 * T_ * 64 * 2), (LAS unsigned*)(lds + NL_RING + (slot_) * NL_SLOT + 8192 + w * 1024), 16, 0, 0); } while (0)
    unsigned remg = umask; int kgen = 0;
#define NSA_GEN(blk_, br_) do { if (kgen < nw) { blk_ = qb - kgen; br_ = 0; } else { br_ = 1; blk_ = remg ? __builtin_ctz(remg) : 0; remg &= remg - 1; } ++kgen; } while (0)
    int cur_blk, cur_br, n1_blk = 0, n1_br = 0, n2_blk = 0, n2_br = 0;
    NSA_GEN(cur_blk, cur_br); NSA_DMA(cur_blk, cur_br, 0);
    if (ntile > 1) { NSA_GEN(n1_blk, n1_br); NSA_DMA(n1_blk, n1_br, 1); }
    bool fresh = true;
    for (int it = 0; it < ntile; ++it) {
        int lane_c = lane2; asm volatile("" : "+v"(lane_c));
        const int i16c = lane_c & 15, gc = lane_c >> 4;
        const int slot = it % 3;
        if (it + 1 < ntile) asm volatile("s_waitcnt vmcnt(2)" ::: "memory"); else asm volatile("s_waitcnt vmcnt(0)" ::: "memory");
        __builtin_amdgcn_s_barrier(); asm volatile("" ::: "memory");
        if (it + 2 < ntile) { NSA_GEN(n2_blk, n2_br); NSA_DMA(n2_blk, n2_br, (it + 2) % 3); }
        LAS unsigned char* kt_ = lds + NL_RING + slot * NL_SLOT + i16c * 128; LAS unsigned char* vt_ = kt_ - i16c * 128 + 8192 + (4 * gc + (i16c >> 2)) * 128 + (lane_c & 1) * 8;
        const int kx0 = ((gc ^ ((i16c >> 1) & 7)) << 4), kx1 = kx0 ^ 64;
        const int vx = (2 * gc + ((i16c >> 3) & 1)) & 7, vph = (lane_c >> 1) & 1;
        const int dl = qb - cur_blk;
#pragma unroll
        for (int th = 0; th < 2; ++th) {
            bf16x8 kfr[4][2], qh[2][2];
            { LAS unsigned char* ql_ = lds + NL_Q + w * 8192 + lane_c * 16;
#pragma unroll
              for (int tx = 0; tx < 2; ++tx)
#pragma unroll
                  for (int kb = 0; kb < 2; ++kb) qh[tx][kb] = *(const LAS bf16x8*)(ql_ + ((2 * th + tx) * 2 + kb) * 1024); }
#pragma unroll
            for (int kt = 0; kt < 4; ++kt) { kfr[kt][0] = *(const LAS bf16x8*)(kt_ + kt * 2048 + kx0); kfr[kt][1] = *(const LAS bf16x8*)(kt_ + kt * 2048 + kx1); }
            __builtin_amdgcn_sched_barrier(0);
            f32x4 st[4][2];
            if (dl >= 3 && !(cur_br == 0 && dl == 8)) {
#pragma unroll
                for (int tx = 0; tx < 2; ++tx) { const float off = ((cur_br == 0 || ((selw[2 * th + tx] >> cur_blk) & 1u)) ? bfar : -1e30f) - mrun[2 * th + tx];
#pragma unroll
                    for (int kt = 0; kt < 4; ++kt) { st[kt][tx] = MFMA16(kfr[kt][0], qh[tx][0], ((f32x4){off, off, off, off})); st[kt][tx] = MFMA16(kfr[kt][1], qh[tx][1], st[kt][tx]); } }
            } else {
#pragma unroll
                for (int kt = 0; kt < 4; ++kt)
#pragma unroll
                    for (int tx = 0; tx < 2; ++tx) { st[kt][tx] = MFMA16(kfr[kt][0], qh[tx][0], ((f32x4){0.f, 0.f, 0.f, 0.f})); st[kt][tx] = MFMA16(kfr[kt][1], qh[tx][1], st[kt][tx]); }
                const bool wedge = cur_br == 0 && dl == 8;
#pragma unroll
                for (int tx = 0; tx < 2; ++tx) { const bool sel = cur_br == 0 || ((selw[2 * th + tx] >> cur_blk) & 1u);
                    LAS float* tb_ = T5L + (wedge ? 256 : 64 * dl) + 13 + (2 * th + tx) * 16 + i16c - 4 * gc;
                    float tbv[4][4];
#pragma unroll
                    for (int kt = 0; kt < 4; ++kt)
#pragma unroll
                        for (int r = 0; r < 4; ++r) tbv[kt][r] = tb_[51 - 16 * kt - r];
                    const float ad = sel ? -mrun[2 * th + tx] : -1e30f;
#pragma unroll
                    for (int kt = 0; kt < 4; ++kt) { asm volatile("" : "+v"(tbv[kt][0]), "+v"(tbv[kt][1]), "+v"(tbv[kt][2]), "+v"(tbv[kt][3]));
                        st[kt][tx] = (st[kt][tx] + (f32x4){tbv[kt][0], tbv[kt][1], tbv[kt][2], tbv[kt][3]}) + ad; } }
            }
            bf16x8 pf[2][2];
#pragma unroll
            for (int tx = 0; tx < 2; ++tx) { const int tt = 2 * th + tx;
                float mx = fmaxf(fmaxf(fmaxf(st[0][tx][0], st[0][tx][1]), fmaxf(st[0][tx][2], st[0][tx][3])), fmaxf(fmaxf(st[1][tx][0], st[1][tx][1]), fmaxf(st[1][tx][2], st[1][tx][3])));
                mx = fmaxf(mx, fmaxf(fmaxf(fmaxf(st[2][tx][0], st[2][tx][1]), fmaxf(st[2][tx][2], st[2][tx][3])), fmaxf(fmaxf(st[3][tx][0], st[3][tx][1]), fmaxf(st[3][tx][2], st[3][tx][3]))));
                mx = xmax4(mx);
                if (fresh || __builtin_amdgcn_ballot_w64(mx > 10.f) != 0ull) {
                    const float d = fresh ? mx : (mx > 10.f ? mx : 0.f), al = fresh ? 0.f : __builtin_amdgcn_exp2f(-d);
                    mrun[tt] += d; lrun[tt] *= al;
#pragma unroll
                    for (int dt = 0; dt < 4; ++dt) oacc[dt][tt] = oacc[dt][tt] * al;
#pragma unroll
                    for (int kt = 0; kt < 4; ++kt) st[kt][tx] = st[kt][tx] - d;
                }
#pragma unroll
                for (int kt = 0; kt < 4; ++kt)
#pragma unroll
                    for (int r = 0; r < 4; ++r) st[kt][tx][r] = __builtin_amdgcn_exp2f(st[kt][tx][r]);
                const f32x4 s4 = (st[0][tx] + st[1][tx]) + (st[2][tx] + st[3][tx]);
                lrun[tt] += (s4[0] + s4[1]) + (s4[2] + s4[3]);
                pf[0][tx] = pack_bf8(st[0][tx], st[1][tx]); pf[1][tx] = pack_bf8(st[2][tx], st[3][tx]);
            }
            { s16x4 vr[16]; const unsigned vb_ = (unsigned)(size_t)vt_;
              tr_read16(vb_ + (((0 + vph) ^ vx) << 4), vb_ + (((2 + vph) ^ vx) << 4), vb_ + (((4 + vph) ^ vx) << 4), vb_ + (((6 + vph) ^ vx) << 4), vr);
#pragma unroll
              for (int i = 0; i < 2; ++i)
#pragma unroll
                  for (int dt = 0; dt < 4; ++dt) { const bf16x8 vf = __builtin_shufflevector(vr[4 * dt + 2 * i], vr[4 * dt + 2 * i + 1], 0, 1, 2, 3, 4, 5, 6, 7);
#pragma unroll
                      for (int tx = 0; tx < 2; ++tx) oacc[dt][2 * th + tx] = MFMA16(vf, pf[i][tx], oacc[dt][2 * th + tx]); } }
        }
        fresh = false;
        const bool last = it + 1 >= ntile;
        if (last || (cur_br == 0 && n1_br == 1)) {
#pragma unroll
            for (int tt = 0; tt < 4; ++tt) { float l = lrun[tt]; l += shx(l, 16, lane_c); l += shx(l, 32, lane_c);
                const size_t tok = tok0 + s0 + tt * 16 + i16c;
                const float gt = ((LAS float*)(lds + NL_GATE))[((cur_br == 0 ? 2 : 1) * 8 + w) * 64 + tt * 16 + i16c] / fmaxf(l, 1e-30f);
#pragma unroll
                for (int dt = 0; dt < 4; ++dt) { const f32x4 v = (f32x4){bflo(fpk[dt][tt].x), bfhi(fpk[dt][tt].x), bflo(fpk[dt][tt].y), bfhi(fpk[dt][tt].y)} + oacc[dt][tt] * gt;
                    u32x2 wv; wv.x = pk2(v[0], v[1]); wv.y = pk2(v[2], v[3]);
                    if (last) *(u32x2*)(ON + tok * DM + head * 64 + dt * 16 + 4 * gc) = wv; else fpk[dt][tt] = wv;
                    oacc[dt][tt] = (f32x4){0.f, 0.f, 0.f, 0.f}; }
                mrun[tt] = 0.f; lrun[tt] = 0.f; }
            fresh = true;
        }
        cur_blk = n1_blk; cur_br = n1_br; n1_blk = n2_blk; n1_br = n2_br;
    }
    asm volatile("s_waitcnt vmcnt(0)" ::: "memory"); __syncthreads();
#undef NSA_DMA
#undef NSA_GEN
}

__global__ void __launch_bounds__(NWAVES * 64, 2) fwd(Args a_unused) {
    extern __shared__ __attribute__((aligned(16))) unsigned char lds_raw[];
    Ctx C; C.lds = (LAS unsigned char*)lds_raw; C.tid = threadIdx.x; C.lane = C.tid & 63; C.wave = __builtin_amdgcn_readfirstlane(C.tid >> 6); C.G = gridDim.x; C.bid = blockIdx.x;
    const int wave0 = C.wave;
#define ws (AP->ws)
#define ctl ((gu32*)(ws + WS_CTL))
    volatile LAS unsigned* MISC = (volatile LAS unsigned*)(C.lds + MISC_OFF);
    for (int u = C.tid; u < (LDS_BYTES - LDSCTL_OFF) / 4; u += NWAVES * 64) ((LAS unsigned*)(C.lds + LDSCTL_OFF))[u] = 0u;
    __syncthreads();
    const bool one = (AP->flags & 1) != 0;
    XcdBarrier bar; bar.bar = (unsigned*)(ctl + CW_BAR); bar.x = 0; bar.st = nullptr;
    if (one) bar = xcd_barrier_post((unsigned*)(ctl + CW_BAR), MISC + 8);
#define SEAM() do { if (AP->flags & 1) { XcdBarrier bl_ = bar; bl_.bar = (unsigned*)(ws + WS_CTL) + CW_BAR; xcd_barrier(bl_, wave0 == 0 && lane_now() == 0); } } while (0)
#define PH(k) (plo_ <= (k) && (k) < phi_)
#if TIMED_MASK
#define TS(id) do { const int z_ = (wave0 << 6) | lane_now(); if (((TIMED_MASK >> (id)) & 1) && blockIdx.x == 0 && z_ == 0) MISC[16] = (unsigned)__builtin_amdgcn_s_memrealtime(); } while (0)
#define TE(id) do { const int z_ = (wave0 << 6) | lane_now(); if (((TIMED_MASK >> (id)) & 1) && blockIdx.x == 0 && z_ == 0) MISC[17] += (unsigned)__builtin_amdgcn_s_memrealtime() - MISC[16]; } while (0)
#else
#define TS(id) do {} while (0)
#define TE(id) do {} while (0)
#endif
#define RELOAD() do { int t_ = (wave0 << 6) | lane_now(); asm volatile("" : "+v"(t_)); C.tid = t_; C.lane = t_ & 63; C.wave = __builtin_amdgcn_readfirstlane(t_ >> 6); gw = C.bid * NWAVES + C.wave; } while (0)
    int gw = C.bid * NWAVES + C.wave; const int NGW = C.G * NWAVES;
#define H ((bf16*)AP->out)
#define XR ((bf16*)(ws + WS_H))
#define PROJ ((bf16*)(ws + WS_BIG) - 4096)
#define FFH ((bf16*)(ws + WS_BIG))
#define ORET ((bf16*)AP->out + (size_t)NTOK * DM)
#define ON ((bf16*)(ws + WS_ON))
#define TMP ((bf16*)(ws + WS_TMP))
#define MERGED ((bf16*)(ws + WS_MERGED))
#define KCV ((bf16*)(ws + WS_KC))
#define GNP ((float*)(ws + WS_GNS))
#define XC ((bf16*)(ws + WS_XC))
#define QKR ((bf16*)(ws + WS_QKR))
#define VR ((bf16*)(ws + WS_VR))
#define KVX ((bf16*)(ws + WS_KVX))
#define rot ((const float*)(ws + WS_ROT))
#define t5 ((const float*)(ws + WS_T5))
    TS(11);
    if (AP->it_lo < 0) { RELOAD(); p0_prologue(C); SEAM(); }
    TE(11);
    const int it0 = AP->it_lo < 0 ? 0 : AP->it_lo, it1 = AP->it_hi > NIT ? NIT : AP->it_hi;
    for (int it = it0; it < it1; ++it) {
        int itv = it, plo_ = AP->ph_lo, phi_ = AP->ph_hi; asm volatile("" : "+s"(itv), "+s"(plo_), "+s"(phi_)); const int L = itv / NSUB, sub = itv % NSUB;
        if (sub < NCHUNK) {
            const size_t row0 = (size_t)sub * MC;
            TS(0);
            if (PH(0) && sub == 0) { RELOAD(); const float* g = AP->in[1] + L * DM;
                if (L == 0) { for (int m = gw; m < NTOK; m += 4 * NGW) rms_rows_to_bf16<4>(AP->in[0], g, H, m, NGW, C.lane); }
                else { for (int m = gw; m < NTOK; m += 4 * NGW) rms_rows_bf16_to_bf16<4>(XR, g, H, m, NGW, C.lane); }
                SEAM(); }
            TE(0);
            TS(1);
            if (PH(1)) { pg8::Gemm g{H + row0 * DM, (const bf16*)(ws + WS_WIN) + (size_t)L * CPAD * DM, MC, CPAD, DM}; pg8::StaticOrder S; S.init(MC, CPAD, C.G, C.bid);
                epi::EpiInProj E{PROJ, rot, XC, QKR, VR, KVX}; pg8::gemm_phase<epi::EpiInProj, pg8::StaticOrder, true, true>(C.lds, g, S, E, wave0); SEAM(); }
            TE(1);
            TS(2);
            if (PH(2)) {
                TS(13); RELOAD(); for (int u = C.bid; u < NBC * 4 * 8; u += C.G) ret_unit(C, (C.G == 256) ? ((u & ~255) + (u & 7) * 32 + ((u >> 3) & 31)) : u, QKR, VR, ORET, GNP); TE(13);
                { const int ks = C.bid & 7; int kc = 256; asm volatile("" : "+s"(kc));
                  pg8::Gemm g{XC + ks * 256, (const bf16*)(ws + WS_WC1) + (size_t)L * 2 * 256 * 2048 + ks * 256, NBC * 512, 512, kc, 1024, 2048}; epi::CmpOrder S{C.bid, C.G};
                  epi::EpiCmpPart E{(float*)(ws + WS_HIDP), ks}; pg8::gemm_phase<epi::EpiCmpPart, epi::CmpOrder, true, true>(C.lds, g, S, E, wave0); }
                SEAM(); }
            TE(2);
            TS(3);
            if (PH(3)) {
                RELOAD(); LAS float* hs = (LAS float*)C.lds + C.wave * 256; const float* cb = (const float*)(ws + WS_CB) + L * 512; const float* hp = (const float*)(ws + WS_HIDP);
                if (NGW == 2048) {
                  LAS float* w2s = (LAS float*)(C.lds + 8192);
                  { const f32x4* wk = (const f32x4*)(AP->in[6] + (size_t)L * 256 * 64); const f32x4* wv = (const f32x4*)(AP->in[8] + (size_t)L * 256 * 64);
#pragma unroll
                    for (int i = 0; i < 8; ++i) { *(LAS f32x4*)(w2s + (C.tid + 512 * i) * 4) = wk[C.tid + 512 * i]; *(LAS f32x4*)(w2s + 16384 + (C.tid + 512 * i) * 4) = wv[C.tid + 512 * i]; } }
                  if (C.tid == 0) MISC[32] = 0u;
                  __syncthreads();
                  if (C.wave < 4) {
                      int lz = C.lane; asm volatile("" : "+v"(lz));
                      const int rbase = C.bid * 4 + C.wave;
                      f32x4 part[8];
#pragma unroll
                      for (int ks = 0; ks < 8; ++ks) part[ks] = *(const f32x4*)(hp + ((size_t)ks * (NBC * 512) + rbase) * 256 + lz * 4);
#pragma unroll 1
                      for (int i = 0; i < NBC / 2; ++i) { const int r = i * 1024 + rbase, kv = r / (NBC * 256);
                          f32x4 h4 = *(const f32x4*)(cb + kv * 256 + lz * 4);
#pragma unroll
                          for (int ks = 0; ks < 8; ++ks) h4 += part[ks];
                          if (i + 1 < NBC / 2) {
#pragma unroll
                              for (int ks = 0; ks < 8; ++ks) part[ks] = *(const f32x4*)(hp + ((size_t)ks * (NBC * 512) + r + 1024) * 256 + lz * 4); }
#pragma unroll
                          for (int j = 0; j < 4; ++j) h4[j] = gelu_tanh_f(h4[j]);
                          *(LAS f32x4*)(hs + lz * 4) = h4;
                          const LAS float* w2 = w2s + kv * 16384;
                          float s_ = 0.f, s1_ = 0.f, s2_ = 0.f, s3_ = 0.f;
#pragma unroll 8
                          for (int k = 0; k < 256; k += 4) { s_ += hs[k] * w2[k * 64 + lz]; s1_ += hs[k + 1] * w2[(k + 1) * 64 + lz]; s2_ += hs[k + 2] * w2[(k + 2) * 64 + lz]; s3_ += hs[k + 3] * w2[(k + 3) * 64 + lz]; }
                          s_ = (s_ + s1_) + (s2_ + s3_);
                          KCV[(size_t)r * 64 + lz] = (r & 127) == 127 ? (bf16)0 : (bf16)f2bf(s_); }
                  }
                  for (;;) { unsigned p_ = 0u; if (C.lane == 0) p_ = __hip_atomic_fetch_add((LAS unsigned*)(C.lds + MISC_OFF) + 32, 1u, __ATOMIC_RELAXED, __HIP_MEMORY_SCOPE_WORKGROUP);
                      p_ = (unsigned)__builtin_amdgcn_readfirstlane((int)p_); if (p_ >= 64u) break;
                      gn_gate_rows<2>(PROJ, ORET, GNP, C.bid * 128 + 2 * (int)p_, 1, C.lane); }
                  __syncthreads();
                } else {
                  for (int r = gw; r < NBC * 512; r += NGW) { const int kv = r / (NBC * 256); f32x4 h4 = *(const f32x4*)(cb + kv * 256 + C.lane * 4);
#pragma unroll
                      for (int ks = 0; ks < 8; ++ks) h4 += *(const f32x4*)(hp + ((size_t)ks * (NBC * 512) + r) * 256 + C.lane * 4);
#pragma unroll
                      for (int i = 0; i < 4; ++i) h4[i] = gelu_tanh_f(h4[i]);
                      *(LAS f32x4*)(hs + C.lane * 4) = h4;
                      const float* w2 = (kv ? AP->in[8] : AP->in[6]) + (size_t)L * 256 * 64 + C.lane; float s_ = 0.f;
                      for (int k = 0; k < 256; ++k) s_ += hs[k] * w2[(size_t)k * 64];
                      KCV[(size_t)r * 64 + C.lane] = (r & 127) == 127 ? (bf16)0 : (bf16)f2bf(s_); }
                  __syncthreads();
                  RELOAD(); for (int m = gw; m < MC; m += 2 * NGW) gn_gate_rows<2>(PROJ, ORET, GNP, m, NGW, C.lane);
                }
                SEAM(); }
            TE(3);
            TS(4);
            if (PH(4)) {
                TS(14); RELOAD(); for (int u = C.bid; u < NBC * 2 * 32; u += C.G) nsa_unit(C, u, PROJ, KVX, KCV, t5, ON); TE(14);
                SEAM(); }
            TE(4);
            TS(5);
            if (PH(5)) { pg8::Gemm g{ORET, (const bf16*)(ws + WS_WORET) + (size_t)L * DM * 2048, MC, DM, 2048}; pg8::StaticOrder S; S.init(MC, DM, C.G, C.bid);
                epi::EpiGate<false> E{TMP, nullptr, PROJ + PC_MA, DM, PPITCH}; pg8::gemm_phase<epi::EpiGate<false>, pg8::StaticOrder, true, true>(C.lds, g, S, E, wave0);
                  }
            TE(5);
            TS(6);
            if (PH(6)) { pg8::Gemm g{ON, (const bf16*)(ws + WS_WONSA) + (size_t)L * DM * DM, MC, DM, DM}; pg8::StaticOrder S; S.init(MC, DM, C.G, C.bid);
                epi::EpiGate<true> E{MERGED, TMP, PROJ + PC_MB, DM, PPITCH}; pg8::gemm_phase<epi::EpiGate<true>, pg8::StaticOrder, true, true>(C.lds, g, S, E, wave0); SEAM(); }
            TE(6);
            TS(7);
            if (PH(7)) { pg8::Gemm g{MERGED, (const bf16*)(ws + WS_WOUT) + (size_t)L * DM * DM, MC, DM, DM}; pg8::StaticOrder S; S.init(MC, DM, C.G, C.bid);
                if (L == 0) { epi::EpiResid<true> E{AP->in[0] + row0 * DM, XR + row0 * DM}; pg8::gemm_phase<epi::EpiResid<true>, pg8::StaticOrder, true, true>(C.lds, g, S, E, wave0); }
                else { epi::EpiResid<false> E{XR + row0 * DM, XR + row0 * DM}; pg8::gemm_phase<epi::EpiResid<false>, pg8::StaticOrder, true, true>(C.lds, g, S, E, wave0); }
                if (sub == NCHUNK - 1) SEAM();     }
            TE(7);
        } else {
            TS(8);
            if (PH(0)) { RELOAD(); const float* g = AP->in[12] + L * DM; for (int m = gw; m < NTOK; m += 4 * NGW) rms_rows_bf16_to_bf16<4>(XR, g, H, m, NGW, C.lane); SEAM(); }
            TE(8); TS(9);
            if (PH(1)) { pg8::Gemm g{H, (const bf16*)(ws + WS_WFFI) + (size_t)L * 2 * FFH_ * DM, NTOK, 2 * FFH_, DM}; pg8::StaticOrder S; S.init(NTOK, 2 * FFH_, C.G, C.bid);
                epi::EpiSwiGlu E{FFH}; pg8::gemm_phase<epi::EpiSwiGlu, pg8::StaticOrder, true, true>(C.lds, g, S, E, wave0); SEAM(); }
            TE(9); TS(10);
            if (PH(2)) { pg8::Gemm g{FFH, (const bf16*)(ws + WS_WFFO) + (size_t)L * DM * FFH_, NTOK, DM, FFH_}; pg8::StaticOrder S; S.init(NTOK, DM, C.G, C.bid);
                epi::EpiResid<false> E{XR, XR}; pg8::gemm_phase<epi::EpiResid<false>, pg8::StaticOrder, true, true>(C.lds, g, S, E, wave0); SEAM(); }
            TE(10);
        }
    }
    TS(12);
    if (AP->it_hi > NIT) { RELOAD(); const float* g = AP->in[16]; for (int m = gw; m < NTOK; m += NGW) rms_row_final(XR + (size_t)m * DM, g, AP->out + (size_t)m * DM, C.lane);
    }
    TE(12);
#if TIMED_MASK
    { const int z_ = (wave0 << 6) | lane_now(); if (blockIdx.x == 0 && z_ == 0) { const unsigned long long t0 = __builtin_amdgcn_s_memrealtime(); const unsigned long long want = 4ull * MISC[17]; while (__builtin_amdgcn_s_memrealtime() - t0 < want) __builtin_amdgcn_s_sleep(8); } }
#endif
#undef SEAM
#undef PH
#undef ctl
#undef ws
#undef H
#undef XR
#undef PROJ
#undef FFH
#undef ORET
#undef ON
#undef TMP
#undef MERGED
#undef KCV
#undef GNP
#undef XC
#undef QKR
#undef VR
#undef KVX
#undef rot
#undef t5
}

extern "C" void kernel_launch(void* const* d_in, const int* in_sizes, int n_in, void* d_out, int out_size, void* d_ws, size_t ws_size, hipStream_t stream) {
    static int grid = 0;
    if (grid == 0) {
        if (n_in != 17 || in_sizes[0] != NTOK * DM || out_size != NTOK * DM || ws_size < WS_END) { fprintf(stderr, "kernel_launch: unexpected shapes (n_in %d, in0 %d, out %d, ws %zu); nothing launched\n", n_in, n_in > 0 ? in_sizes[0] : -1, out_size, ws_size); grid = -1; return; }
        int dev = 0, cus = 0, per_cu = 0;
        if (hipGetDevice(&dev) != hipSuccess || hipDeviceGetAttribute(&cus, hipDeviceAttributeMultiprocessorCount, dev) != hipSuccess) { grid = -1; return; }
        if (hipFuncSetAttribute((const void*)fwd, hipFuncAttributeMaxDynamicSharedMemorySize, LDS_BYTES) != hipSuccess) { fprintf(stderr, "kernel_launch: hipFuncSetAttribute failed\n"); grid = -1; return; }
        if (hipOccupancyMaxActiveBlocksPerMultiprocessor(&per_cu, (const void*)fwd, NWAVES * 64, LDS_BYTES) != hipSuccess || per_cu < 1) { fprintf(stderr, "kernel_launch: occupancy query says %d\n", per_cu); }
        (void)hipGetLastError();
        grid = cus;
    }
    if (grid < 0) return;
    (void)hipMemsetAsync((char*)d_ws + WS_CTL, 0, CTL_ZERO_BYTES, stream);
    Args a{};
    for (int i = 0; i < 17; ++i) a.in[i] = (const float*)d_in[i];
    a.out = (float*)d_out; a.ws = (unsigned char*)d_ws;
    a.it_lo = -1; a.it_hi = NIT + 1; a.ph_lo = 0; a.ph_hi = 99; a.flags = 1;
    hipLaunchKernelGGL(fwd, dim3(grid), dim3(NWAVES * 64), LDS_BYTES, stream, a);
}
```

```cpp
#include <hip/hip_runtime.h>
#include <cstdio>
#include <cstdint>
#ifndef TIMED_MASK
#define TIMED_MASK 0
#endif
__device__ __forceinline__ int lane_now() { int z = 0; asm volatile("" : "+v"(z)); return __builtin_amdgcn_mbcnt_hi(-1, __builtin_amdgcn_mbcnt_lo(-1, z)); }
namespace pg8 {
#define PG8_LAS __attribute__((address_space(3)))
typedef unsigned short bf16_t;
typedef short bf16x8 __attribute__((ext_vector_type(8)));
typedef float f32x4 __attribute__((ext_vector_type(4)));
typedef unsigned u32x4 __attribute__((ext_vector_type(4)));
constexpr int BM = 256, BK = 64, HALF = 128, HTB = HALF * BK * 2  , STAGE_BYTES = 8 * HTB, NXCD = 8, WGM = 8;

__host__ __device__ __forceinline__ int lds_byte(int r, int c) { const int st = (r >> 4) * 2 + (c >> 5), rr = r & 15, cc = c & 31, ob = rr * 64 + cc * 2; return st * 1024 + (ob ^ (((ob >> 9) & 1) << 5)); }
__host__ __device__ __forceinline__ void stage_rc(int b, int& R, int& C) { const int st = b / 1024, sb = b % 1024, swz = sb ^ (((sb >> 9) & 1) << 5); R = (st >> 1) * 16 + swz / 64; C = (st & 1) * 32 + (swz % 64) / 2; }
__host__ __device__ __forceinline__ int perm32(int rho) { const int n = rho >> 4, i = rho & 15; return 8 * (i >> 2) + 4 * n + (i & 3); }

struct Unit { int pm, pn; int par = 0; };
struct Gemm { const bf16_t* A; const bf16_t* Bt; int M, N, K; int lda = 0, ldb = 0; };

struct StaticOrder {
    int nM, nN, nwg, G, c;
    __host__ __device__ void init(int M, int N, int G_, int c_) { nM = M / BM; nN = N / BM; nwg = nM * nN; G = G_; c = c_; }
    __host__ __device__ bool next(int i, Unit& u) const {
        const long L = (long)i * G + c; if (L >= nwg) return false;
        int wgid = (int)L; { const int q = nwg / NXCD, r = nwg % NXCD, xcd = wgid % NXCD, off = wgid / NXCD; wgid = (xcd < r ? xcd * (q + 1) : r * (q + 1) + (xcd - r) * q) + off; }
        const int nig = WGM * nN, gid = wgid / nig, fm = gid * WGM, gsz = (nM - fm) < WGM ? (nM - fm) : WGM;
        u.pm = fm + ((wgid % nig) % gsz); u.pn = (wgid % nig) / gsz; return true;
    }
    __device__ __forceinline__ void a_ready(const Unit&) const {}
    __device__ __forceinline__ void done(const Unit&) const {}
};

template <class Epi, class Sched, bool ALIGN_EPI = false, bool SP2 = false>
__device__ __forceinline__ void gemm_phase(PG8_LAS unsigned char* lds, const Gemm g, const Sched& S, const Epi& E, int wave0) {
    int tid_ = (wave0 << 6) | lane_now(); asm volatile("" : "+v"(tid_));
    const int tid = tid_, wid = __builtin_amdgcn_readfirstlane(tid >> 6), lane = tid & 63, wr = wid >> 2, wc = wid & 3, fr = lane & 15, fq = lane >> 4;
    const int K = g.K, nt = K / BK, LDA = g.lda ? g.lda : g.K, LDB = g.ldb ? g.ldb : g.K;
    unsigned voffA[2], voffB[2];
#pragma unroll
    for (int i = 0; i < 2; ++i) { int R, C; stage_rc(tid * 16 + i * 8192, R, C); const int Rb = Epi::PERM ? ((R & ~31) + perm32(R & 31)) : R;
        voffA[i] = (unsigned)(R * LDA + C) * 2u; voffB[i] = (unsigned)(Rb * LDB + C) * 2u; }
    const size_t kstep = (size_t)(BK * 2);
    const size_t hstep = (size_t)HALF * LDB * 2;
    const size_t tstep = 2 * hstep;
    const size_t hstepA = (size_t)HALF * LDA * 2, tstepA = 2 * hstepA;
    const unsigned ldsw = (unsigned)wid * 1024u;
    int aoff = lds_byte(wr * 64 + fr, fq * 8), boff = lds_byte(wc * 32 + fr, fq * 8);
#define PG8_SA(b, h) (((b) * 2 + (h)) * HTB)
#define PG8_SB(b, h) ((4 + (b) * 2 + (h)) * HTB)
#define PG8_STAGE(bufoff, gbase, voff) do { _Pragma("unroll") for (int _i = 0; _i < 2; ++_i) \
        __builtin_amdgcn_global_load_lds((const unsigned*)((const char*)(gbase) + (voff)[_i]), (PG8_LAS unsigned*)(lds + (bufoff) + ldsw + _i * 8192), 16, 0, 0); } while (0)
#define PG8_LDA(dst, b, h) do { _Pragma("unroll") for (int m = 0; m < 4; ++m) _Pragma("unroll") for (int k = 0; k < 2; ++k) dst[m][k] = *(const PG8_LAS bf16x8*)(lds + PG8_SA(b, h) + aoff + m * 2048 + k * 1024); } while (0)
#define PG8_LDB(dst, b, h) do { _Pragma("unroll") for (int n = 0; n < 2; ++n) _Pragma("unroll") for (int k = 0; k < 2; ++k) dst[n][k] = *(const PG8_LAS bf16x8*)(lds + PG8_SB(b, h) + boff + n * 2048 + k * 1024); } while (0)
#define PG8_MMA(ai, bj, At, Bt) do { __builtin_amdgcn_s_setprio(1); _Pragma("unroll") for (int m = 0; m < 4; ++m) _Pragma("unroll") for (int n = 0; n < 2; ++n) _Pragma("unroll") for (int k = 0; k < 2; ++k) \
        acc[ai][bj][m][n] = __builtin_amdgcn_mfma_f32_16x16x32_bf16(Bt[n][k], At[m][k], acc[ai][bj][m][n], 0, 0, 0); __builtin_amdgcn_s_setprio(0); } while (0)
#define PG8_WAIT_V(n) asm volatile("s_waitcnt vmcnt(" #n ")" ::: "memory")
#define PG8_WAIT_L(n) asm volatile("s_waitcnt lgkmcnt(" #n ")" ::: "memory")
#define PG8_BAR __builtin_amdgcn_s_barrier()
#define PG8_SCHED __builtin_amdgcn_sched_barrier(0)
    Unit cur, nxt; int ui = 0;
    if (!S.next(0, cur)) return;
    int rsbuf = 0;
#define PG8_RS_LOAD(pm_, buf_) do { if constexpr (Epi::RS_LDS) { if (wid < 4) { const int ln_ = lane_now(); ((PG8_LAS float*)(lds + 131072))[(buf_) * 256 + wid * 64 + ln_] = E.rstd[(pm_) * 256 + wid * 64 + ln_]; } } } while (0)
    PG8_RS_LOAD(cur.pm, 0);
    f32x4 acc[2][2][4][2];
#pragma unroll
    for (int a = 0; a < 2; ++a)
#pragma unroll
        for (int b = 0; b < 2; ++b)
#pragma unroll
            for (int m = 0; m < 4; ++m)
#pragma unroll
                for (int n = 0; n < 2; ++n) acc[a][b][m][n] = (f32x4){0.f, 0.f, 0.f, 0.f};
    bf16x8 At[4][2], B0[2][2], B1[2][2];
    const char* cA = (const char*)g.A + (size_t)cur.pm * tstepA; const char* cB = (const char*)g.Bt + (size_t)cur.pn * tstep;
    S.a_ready(cur);
    if constexpr (SP2) {
        PG8_STAGE(PG8_SB(0, 0), cB, voffB); PG8_STAGE(PG8_SB(0, 1), cB + hstep, voffB); PG8_STAGE(PG8_SA(0, 0), cA, voffA); PG8_STAGE(PG8_SA(0, 1), cA + hstepA, voffA);
        if (wr == 1) PG8_BAR;
        PG8_WAIT_V(2); PG8_BAR;
        PG8_STAGE(PG8_SB(1, 0), cB + kstep, voffB); PG8_STAGE(PG8_SA(1, 0), cA + kstep, voffA); PG8_STAGE(PG8_SB(1, 1), cB + hstep + kstep, voffB);
        PG8_WAIT_V(6); PG8_BAR;
    } else {
        PG8_STAGE(PG8_SB(0, 0), cB, voffB); PG8_STAGE(PG8_SA(0, 0), cA, voffA); PG8_STAGE(PG8_SB(0, 1), cB + hstep, voffB); PG8_STAGE(PG8_SA(0, 1), cA + hstepA, voffA);
        if (wr == 1) PG8_BAR;
        PG8_WAIT_V(4); PG8_BAR;
        PG8_STAGE(PG8_SB(1, 0), cB + kstep, voffB); PG8_STAGE(PG8_SA(1, 0), cA + kstep, voffA); PG8_STAGE(PG8_SB(1, 1), cB + hstep + kstep, voffB);
        PG8_WAIT_V(6); PG8_BAR;
    }
    for (;;) {
        const bool has_next = S.next(ui + 1, nxt);
        const char* nA = has_next ? (const char*)g.A + (size_t)nxt.pm * tstepA : cA; const char* nB = has_next ? (const char*)g.Bt + (size_t)nxt.pn * tstep : cB;
        for (int t = 0; t < nt; t += 2) {
            const bool last = (t == nt - 2);
            const char* a1 = cA + (size_t)(t + 1) * kstep;
            const char* a2 = last ? nA : cA + (size_t)(t + 2) * kstep; const char* b2 = last ? nB : cB + (size_t)(t + 2) * kstep;
            const char* a3 = a2 + kstep; const char* b3 = b2 + kstep;
            if (last && has_next) S.a_ready(nxt);
            if constexpr (SP2) {
            PG8_LDB(B0, 0, 0); PG8_LDB(B1, 0, 1); PG8_SCHED; PG8_LDA(At, 0, 0); PG8_STAGE(PG8_SA(1, 1), a1 + hstepA, voffA);
            PG8_WAIT_V(8); PG8_WAIT_L(0); PG8_BAR; PG8_MMA(0, 0, At, B0); PG8_MMA(0, 1, At, B1); PG8_BAR; PG8_SCHED;
            PG8_LDA(At, 0, 1); PG8_STAGE(PG8_SB(0, 0), b2, voffB); PG8_STAGE(PG8_SB(0, 1), b2 + hstep, voffB); PG8_STAGE(PG8_SA(0, 0), a2, voffA);
            PG8_WAIT_V(8); PG8_WAIT_L(0); PG8_BAR; PG8_MMA(1, 0, At, B0); PG8_MMA(1, 1, At, B1); PG8_BAR; PG8_SCHED;
            PG8_LDB(B0, 1, 0); PG8_LDB(B1, 1, 1); PG8_SCHED; PG8_LDA(At, 1, 0); PG8_STAGE(PG8_SA(0, 1), a2 + hstepA, voffA);
            PG8_WAIT_V(8); PG8_WAIT_L(0); PG8_BAR; PG8_MMA(0, 0, At, B0); PG8_MMA(0, 1, At, B1); PG8_BAR; PG8_SCHED;
            PG8_LDA(At, 1, 1); PG8_STAGE(PG8_SB(1, 0), b3, voffB); PG8_STAGE(PG8_SB(1, 1), b3 + hstep, voffB); PG8_STAGE(PG8_SA(1, 0), a3, voffA);
            PG8_WAIT_V(8); PG8_WAIT_L(0); PG8_BAR; PG8_MMA(1, 0, At, B0); PG8_MMA(1, 1, At, B1); PG8_BAR; PG8_SCHED;
            } else {
            PG8_LDB(B0, 0, 0); PG8_SCHED; PG8_LDA(At, 0, 0); PG8_STAGE(PG8_SA(1, 1), a1 + hstepA, voffA);
            PG8_WAIT_L(8); PG8_BAR; PG8_WAIT_L(0); PG8_MMA(0, 0, At, B0); PG8_BAR; PG8_SCHED;
            PG8_LDB(B1, 0, 1); PG8_STAGE(PG8_SB(0, 0), b2, voffB);
            PG8_BAR; PG8_WAIT_L(0); PG8_MMA(0, 1, At, B1); PG8_BAR;
            PG8_LDA(At, 0, 1); PG8_STAGE(PG8_SA(0, 0), a2, voffA);
            PG8_BAR; PG8_WAIT_L(0); PG8_MMA(1, 0, At, B0); PG8_BAR; PG8_SCHED;
            PG8_STAGE(PG8_SB(0, 1), b2 + hstep, voffB);
            PG8_WAIT_V(6); PG8_BAR; PG8_MMA(1, 1, At, B1); PG8_BAR;
            PG8_LDB(B0, 1, 0); PG8_SCHED; PG8_LDA(At, 1, 0); PG8_STAGE(PG8_SA(0, 1), a2 + hstepA, voffA);
            PG8_WAIT_L(8); PG8_BAR; PG8_WAIT_L(0); PG8_MMA(0, 0, At, B0); PG8_BAR; PG8_SCHED;
            PG8_LDB(B1, 1, 1); PG8_STAGE(PG8_SB(1, 0), b3, voffB);
            PG8_BAR; PG8_WAIT_L(0); PG8_MMA(0, 1, At, B1); PG8_BAR;
            PG8_LDA(At, 1, 1); PG8_STAGE(PG8_SA(1, 0), a3, voffA);
            PG8_BAR; PG8_WAIT_L(0); PG8_MMA(1, 0, At, B0); PG8_BAR; PG8_SCHED;
            PG8_STAGE(PG8_SB(1, 1), b3 + hstep, voffB);
            PG8_WAIT_V(6); PG8_BAR; PG8_MMA(1, 1, At, B1); PG8_BAR;
            }
        }
        if constexpr (ALIGN_EPI) { if (wr == 0) PG8_BAR; }
        if constexpr (Epi::RS_LDS) cur.par = rsbuf;
        if constexpr (!Epi::AFTER_DRAIN) { E(acc, cur, wr, wc, fr, fq); S.done(cur); }
        if (!has_next) break;
        { const int l2_ = lane_now(); aoff = lds_byte(wr * 64 + (l2_ & 15), (l2_ >> 4) * 8); boff = lds_byte(wc * 32 + (l2_ & 15), (l2_ >> 4) * 8); }
        if constexpr (Epi::RS_LDS) { if (nxt.pm != cur.pm) { rsbuf ^= 1; PG8_RS_LOAD(nxt.pm, rsbuf); } }
#pragma unroll
        for (int a = 0; a < 2; ++a)
#pragma unroll
            for (int b = 0; b < 2; ++b)
#pragma unroll
                for (int m = 0; m < 4; ++m)
#pragma unroll
                    for (int n = 0; n < 2; ++n) acc[a][b][m][n] = (f32x4){0.f, 0.f, 0.f, 0.f};
        cur = nxt; cA = nA; cB = nB; ++ui;
        if constexpr (ALIGN_EPI) { if (wr == 1) PG8_BAR; }
    }
    PG8_WAIT_V(0);
    if constexpr (!ALIGN_EPI) { if (wr == 0) PG8_BAR; }
    PG8_BAR;
    if constexpr (Epi::AFTER_DRAIN) { E.fused(acc, cur, wr, wc, fr, fq, lds, wid, lane); S.done(cur); }
#undef PG8_RS_LOAD
#undef PG8_SA
#undef PG8_SB
#undef PG8_STAGE
#undef PG8_LDA
#undef PG8_LDB
#undef PG8_MMA
#undef PG8_WAIT_V
#undef PG8_WAIT_L
#undef PG8_BAR
#undef PG8_SCHED
}
}

constexpr int NB = 32, T_ = 2048, DM = 1024, NTOK = NB * T_;
constexpr int NLAYER = 2;
constexpr int CIN = 10032, CPAD = 10240;
constexpr int FFH_ = 2816;
constexpr int NBC = 16, MC = NBC * T_, NCHUNK = NB / NBC, NSUB = NCHUNK + 1, NIT = NLAYER * NSUB;
constexpr int PPITCH = 6144;
static_assert(NBC == 16, "unit decodes below assume 16-batch chunks");
constexpr int PC_QR = 0, PC_KR = 1024, PC_VR = 2048, PC_GR = 4096, PC_QN = 6144, PC_KV = 7168, PC_MA = 7936, PC_MB = 8960, PC_GATE = 9984;
constexpr int NCMP = 127, NCMP_PAD = 128;
constexpr float LOG2E = 1.4426950408889634f;
constexpr float QSCALE = 0.125f * LOG2E;

constexpr size_t MiB = 1u << 20;
constexpr size_t WS_CTL = 0, CTL_ZERO_BYTES = 1 * MiB;
constexpr size_t WS_ROT = 1 * MiB;
constexpr size_t WS_RSTD = 1 * MiB + 256 * 1024;
constexpr size_t WS_ONES = 1 * MiB + 512 * 1024;
constexpr size_t WS_T5 = 3 * MiB;
constexpr size_t WS_CB = 3 * MiB + 64 * 1024;
constexpr size_t WS_WIN = 4 * MiB;
constexpr size_t WS_WORET = 44 * MiB;
constexpr size_t WS_WONSA = 52 * MiB;
constexpr size_t WS_WOUT = 56 * MiB;
constexpr size_t WS_WFFI = 60 * MiB;
constexpr size_t WS_WFFO = 82 * MiB;
constexpr size_t WS_WC1 = 93 * MiB;
constexpr size_t WS_WC2 = 97 * MiB;
constexpr size_t WS_H = 100 * MiB;
constexpr size_t WS_BIG = 228 * MiB;
constexpr size_t WS_QKR = 612 * MiB;
constexpr size_t WS_ON = 612 * MiB;
constexpr size_t WS_TMP = 676 * MiB;
constexpr size_t WS_VR = 740 * MiB;
constexpr size_t WS_MERGED = 868 * MiB;
constexpr size_t WS_HIDP = 868 * MiB;
constexpr size_t WS_KC = 932 * MiB;
constexpr size_t WS_GNS = 934 * MiB;
constexpr size_t WS_XC = 942 * MiB;
constexpr size_t WS_PART = 960 * MiB;
constexpr size_t WS_KVX = 966 * MiB;
constexpr size_t WS_END = 998 * MiB;
constexpr int CW_TMO = 0, CW_BAR = 4096, CW_Q = 16384;

constexpr int NWAVES = 8;
constexpr int RING_BYTES = 131072, LDS_BYTES = 147456, LDSCTL_OFF = LDS_BYTES - 1024, MISC_OFF = LDSCTL_OFF + 320;

typedef pg8::bf16_t bf16;
typedef float f32x4 __attribute__((ext_vector_type(4)));
typedef float f32x2 __attribute__((ext_vector_type(2)));
typedef unsigned u32x4 __attribute__((ext_vector_type(4)));
typedef unsigned u32x2 __attribute__((ext_vector_type(2)));
#define LAS __attribute__((address_space(3)))
#define GAS __attribute__((address_space(1)))
#define RLX_AGENT __ATOMIC_RELAXED, __HIP_MEMORY_SCOPE_AGENT
#define LDS_WAIT() asm volatile("s_waitcnt lgkmcnt(0)" ::: "memory")
#define VM_WAIT() asm volatile("s_waitcnt vmcnt(0)" ::: "memory")
typedef GAS unsigned gu32;

__device__ __forceinline__ unsigned f2bf(float f) { unsigned u = __builtin_bit_cast(unsigned, f); return (u + 0x7fffu + ((u >> 16) & 1u)) >> 16; }
typedef __bf16 hbf16x2 __attribute__((ext_vector_type(2)));
__device__ __forceinline__ unsigned pk2(float lo, float hi) { const f32x2 v = {lo, hi}; return __builtin_bit_cast(unsigned, __builtin_convertvector(v, hbf16x2)); }
__device__ __forceinline__ float bf2f(unsigned short h) { return __builtin_bit_cast(float, (unsigned)h << 16); }
__device__ __forceinline__ float bflo(unsigned w) { return __builtin_bit_cast(float, w << 16); }
__device__ __forceinline__ float bfhi(unsigned w) { return __builtin_bit_cast(float, w & 0xffff0000u); }
__device__ __forceinline__ float sigm(float x) { return __builtin_amdgcn_rcpf(1.f + __builtin_amdgcn_exp2f(-LOG2E * x)); }
__device__ __forceinline__ float silu(float x) { return x * __builtin_amdgcn_rcpf(1.f + __builtin_amdgcn_exp2f(-LOG2E * x)); }
__device__ __forceinline__ float shx(float v, int m, int lane) { return __builtin_bit_cast(float, __builtin_amdgcn_ds_bpermute((lane ^ m) << 2, __builtin_bit_cast(int, v))); }
__device__ __forceinline__ float wave_sum(float v, int lane) {
#pragma unroll
    for (int o = 1; o < 64; o <<= 1) v += shx(v, o, lane);
    return v;
}
__device__ __forceinline__ float wave_max(float v, int lane) {
#pragma unroll
    for (int o = 1; o < 64; o <<= 1) v = fmaxf(v, shx(v, o, lane));
    return v;
}

__device__ __forceinline__ float gelu_tanh_f(float x) { const float u = 0.7978845608028654f * (x + 0.044715f * x * x * x); const float e = __builtin_amdgcn_exp2f(2.f * 1.4426950408889634f * u); return x * (1.f - __builtin_amdgcn_rcpf(e + 1.f)); }
__device__ __forceinline__ float xsum4e(float x) {
    float a = x, b = x;
    asm volatile("s_nop 1\n\tv_permlane16_swap_b32 %0, %1" : "+v"(a), "+v"(b));
    a = a + b; b = a;
    asm volatile("s_nop 1\n\tv_permlane32_swap_b32 %0, %1" : "+v"(a), "+v"(b));
    return a + b;
}
namespace epi {
using pg8::Unit;
__device__ __forceinline__ u32x4 pack8(const f32x4 a, const f32x4 b) { u32x4 w; w.x = pk2(a[0], a[1]); w.y = pk2(a[2], a[3]); w.z = pk2(b[0], b[1]); w.w = pk2(b[2], b[3]); return w; }
__device__ __forceinline__ void unpack8(const u32x4 w, f32x4& a, f32x4& b) { a = (f32x4){bflo(w.x), bfhi(w.x), bflo(w.y), bfhi(w.y)}; b = (f32x4){bflo(w.z), bfhi(w.z), bflo(w.w), bfhi(w.w)}; }

struct EpiInProj {
    static constexpr bool PERM = true, AFTER_DRAIN = false;
    static constexpr bool RS_LDS = true;
    bf16* O; const float* rot; bf16* XC; bf16* QKR; bf16* VR; bf16* KVX; const float* rstd; const PG8_LAS float* rsl;
    __device__ __forceinline__ void operator()(const f32x4 (&acc_)[2][2][4][2], const Unit& u, int wr, int wc, int fr, int fq) const {
        const int pn = u.pn, row0 = u.pm * 256 + wr * 64 + fr, colw = wc * 32 + 8 * fq;
        const PG8_LAS float* rsb_ = rsl + u.par * 256 + wr * 64 + fr;
#define acc(ai, bj, m, n) (acc_[ai][bj][m][n] * rsb_[(ai) * 128 + (m) * 16])
        bf16* base = O + (size_t)row0 * PPITCH + pn * 256 + colw;
        if (pn < 8) {
            const float sc = pn >= 4 ? 0.0625f : 1.f;
            const f32x4 fq8[2] = {*(const f32x4*)(rot + colw), *(const f32x4*)(rot + colw + 4)};
#pragma unroll
            for (int ai = 0; ai < 2; ++ai)
#pragma unroll
                for (int m = 0; m < 4; ++m) {
                    const int row = row0 + ai * 128 + m * 16, pos = row & (T_ - 1);
                    f32x4 y1[2], y2[2];
#pragma unroll
                    for (int n = 0; n < 2; ++n) { const f32x4 rev = fq8[n] * (float)pos; f32x4 c, s;
#pragma unroll
                        for (int i = 0; i < 4; ++i) { const float r_ = __builtin_amdgcn_fractf(rev[i]); c[i] = __builtin_amdgcn_cosf(r_); s[i] = __builtin_amdgcn_sinf(r_); }
                        const f32x4 x1 = acc(ai, 0, m, n), x2 = acc(ai, 1, m, n);
                        y1[n] = (x1 * c - x2 * s) * sc; y2[n] = (x1 * s + x2 * c) * sc; }
                    bf16* rp = QKR + ((size_t)(((pn >> 2) * NBC + (row >> 11)) * 4 + (pn & 3)) * T_ + pos) * 256 + colw;
                    *(u32x4*)(rp) = pack8(y1[0], y1[1]); *(u32x4*)(rp + 128) = pack8(y2[0], y2[1]);
                }
        } else if (pn < 16) {
            const int h2 = (pn - 8) >> 1, d0 = (wc & 1) * 32 + 8 * fq;
#pragma unroll
            for (int ai = 0; ai < 2; ++ai)
#pragma unroll
                for (int m = 0; m < 4; ++m) { const int row = row0 + ai * 128 + m * 16, bb = row >> 11, t = row & (T_ - 1);
#pragma unroll
                    for (int bj = 0; bj < 2; ++bj) { const int es = ((pn - 8) & 1) * 4 + 2 * bj + (wc >> 1);
                        *(u32x4*)(VR + ((size_t)((bb * 4 + h2) * 8 + es) * T_ + t) * 64 + d0) = pack8(acc(ai, bj, m, 0), acc(ai, bj, m, 1)); } }
        } else if (pn == 29 || pn == 30) {
            const int g2 = wc >> 1, d0 = (wc & 1) * 32 + 8 * fq;
#pragma unroll
            for (int ai = 0; ai < 2; ++ai)
#pragma unroll
                for (int m = 0; m < 4; ++m) { const int row = row0 + ai * 128 + m * 16, bb = row >> 11, t = row & (T_ - 1);
#pragma unroll
                    for (int bj = 0; bj < 2; ++bj) *(u32x4*)(KVX + ((size_t)((((pn - 29) * 2 + bj) * NBC + bb) * 2 + g2) * T_ + t) * 64 + d0) = pack8(acc(ai, bj, m, 0), acc(ai, bj, m, 1)); }
        } else if (pn == 28) {
            const int g2 = wc >> 1, d0 = (wc & 1) * 32 + 8 * fq;
#pragma unroll
            for (int ai = 0; ai < 2; ++ai)
#pragma unroll
                for (int m = 0; m < 4; ++m) { const int row = row0 + ai * 128 + m * 16, bb = row >> 11, t = row & (T_ - 1);
#pragma unroll
                    for (int bj = 0; bj < 2; ++bj) *(u32x4*)(XC + ((size_t)((bj * NBC + bb) * 2 + g2) * T_ + t) * 64 + d0) = pack8(acc(ai, bj, m, 0), acc(ai, bj, m, 1)); }
        } else {
            const int mode = (pn >= 24 && pn < 28) ? 2 : (pn >= 31) ? 3 : 0;
#pragma unroll
            for (int ai = 0; ai < 2; ++ai)
#pragma unroll
                for (int m = 0; m < 4; ++m) { bf16* rp = base + (size_t)(ai * 128 + m * 16) * PPITCH;
#pragma unroll
                    for (int bj = 0; bj < 2; ++bj) { f32x4 v0 = acc(ai, bj, m, 0), v1 = acc(ai, bj, m, 1);
                        if (mode == 1) {
#pragma unroll
                            for (int i = 0; i < 4; ++i) { v0[i] = silu(v0[i]); v1[i] = silu(v1[i]); } }
                        else if (mode == 2) { v0 = v0 * QSCALE; v1 = v1 * QSCALE; }
                        else if (mode == 3) {
#pragma unroll
                            for (int i = 0; i < 4; ++i) { v0[i] = sigm(v0[i]); v1[i] = sigm(v1[i]); } }
                        *(u32x4*)(rp + bj * 128) = pack8(v0, v1); } }
        }
    }
};
#undef acc
template <bool ADD> struct EpiGate {
    static constexpr bool RS_LDS = false;
    static constexpr bool PERM = true, AFTER_DRAIN = false;
    bf16* O; const bf16* P; const bf16* G; int ldo, ldg;
    __device__ __forceinline__ void operator()(const f32x4 (&acc)[2][2][4][2], const Unit& u, int wr, int wc, int fr, int fq) const {
        const int row0 = u.pm * 256 + wr * 64 + fr, col0 = u.pn * 256 + wc * 32 + 8 * fq;
        constexpr int NB_ = ADD ? 2 : 1, AI_ = ADD ? 1 : 2;
#pragma unroll
        for (int b_ = 0; b_ < NB_; ++b_) {
            u32x4 gv[AI_][4][2], pv[ADD ? AI_ : 1][4][2];
#pragma unroll
            for (int a_ = 0; a_ < AI_; ++a_)
#pragma unroll
                for (int m = 0; m < 4; ++m) { const size_t r = (size_t)(row0 + (b_ * AI_ + a_) * 128 + m * 16);
#pragma unroll
                    for (int bj = 0; bj < 2; ++bj) { const int c = col0 + bj * 128; gv[a_][m][bj] = *(const u32x4*)(G + r * ldg + c); if (ADD) pv[a_][m][bj] = *(const u32x4*)(P + r * ldo + c); } }
            __builtin_amdgcn_sched_barrier(0);
#pragma unroll
            for (int a_ = 0; a_ < AI_; ++a_)
#pragma unroll
                for (int m = 0; m < 4; ++m) { const int ai = b_ * AI_ + a_; const size_t r = (size_t)(row0 + ai * 128 + m * 16);
#pragma unroll
                    for (int bj = 0; bj < 2; ++bj) { const int c = col0 + bj * 128;
                        f32x4 g0, g1; unpack8(gv[a_][m][bj], g0, g1);
                        f32x4 v0 = acc[ai][bj][m][0] * g0, v1 = acc[ai][bj][m][1] * g1;
                        if (ADD) { f32x4 p0, p1; unpack8(pv[a_][m][bj], p0, p1); v0 += p0; v1 += p1; }
                        *(u32x4*)(O + r * ldo + c) = pack8(v0, v1); } }
        }
    }
};
template <bool SRC_F32> struct EpiResid {
    static constexpr bool RS_LDS = false;
    static constexpr bool PERM = true, AFTER_DRAIN = false;
    const void* src; bf16* out; float* part;
    __device__ __forceinline__ void operator()(const f32x4 (&acc)[2][2][4][2], const Unit& u, int wr, int wc, int fr, int fq) const {
        const int row0 = u.pm * 256 + wr * 64 + fr, col0 = u.pn * 256 + wc * 32 + 8 * fq;
        constexpr int NB_ = 2, AI_ = 1;
#pragma unroll
        for (int b_ = 0; b_ < NB_; ++b_) {
            f32x4 sv[1][4][2][SRC_F32 ? 2 : 1]; u32x4 sb[1][4][2];
#pragma unroll
            for (int a_ = 0; a_ < AI_; ++a_)
#pragma unroll
                for (int m = 0; m < 4; ++m) { const size_t off = (size_t)(row0 + (b_ * AI_ + a_) * 128 + m * 16) * DM + col0;
#pragma unroll
                    for (int bj = 0; bj < 2; ++bj) {
                        if (SRC_F32) { sv[0][m][bj][0] = *(const f32x4*)((const float*)src + off + bj * 128); sv[0][m][bj][SRC_F32 ? 1 : 0] = *(const f32x4*)((const float*)src + off + bj * 128 + 4); }
                        else sb[a_][m][bj] = *(const u32x4*)((const bf16*)src + off + bj * 128); } }
            __builtin_amdgcn_sched_barrier(0);
#pragma unroll
            for (int a_ = 0; a_ < AI_; ++a_)
#pragma unroll
                for (int m = 0; m < 4; ++m) { const int ai = b_ * AI_ + a_; const size_t off = (size_t)(row0 + ai * 128 + m * 16) * DM + col0; float ss = 0.f;
#pragma unroll
                    for (int bj = 0; bj < 2; ++bj) { f32x4 s0, s1;
                        if (SRC_F32) { s0 = sv[0][m][bj][0]; s1 = sv[0][m][bj][SRC_F32 ? 1 : 0]; }
                        else unpack8(sb[a_][m][bj], s0, s1);
                        s0 += acc[ai][bj][m][0]; s1 += acc[ai][bj][m][1];
                        ss += ((s0[0] * s0[0] + s0[1] * s0[1]) + (s0[2] * s0[2] + s0[3] * s0[3])) + ((s1[0] * s1[0] + s1[1] * s1[1]) + (s1[2] * s1[2] + s1[3] * s1[3]));
                        *(u32x4*)(out + off + bj * 128) = pack8(s0, s1); }
                    ss = xsum4e(ss);
                    if (fq == 0) part[(size_t)(row0 + ai * 128 + m * 16) * 16 + u.pn * 4 + wc] = ss; }
        }
    }
};
struct EpiSwiGlu {
    static constexpr bool PERM = true, AFTER_DRAIN = false;
    static constexpr bool RS_LDS = true;
    bf16* O; const float* rstd; const PG8_LAS float* rsl;
    __device__ __forceinline__ void operator()(const f32x4 (&acc)[2][2][4][2], const Unit& u, int wr, int wc, int fr, int fq) const {
        const int row0 = u.pm * 256 + wr * 64 + fr, col0 = u.pn * 128 + wc * 32 + 8 * fq;
        const PG8_LAS float* rsb_ = rsl + u.par * 256 + wr * 64 + fr;
#pragma unroll
        for (int ai = 0; ai < 2; ++ai)
#pragma unroll
            for (int m = 0; m < 4; ++m) { f32x4 v[2]; const float rs_ = rsb_[ai * 128 + m * 16];
#pragma unroll
                for (int n = 0; n < 2; ++n) { const f32x4 a = acc[ai][0][m][n] * rs_, b = acc[ai][1][m][n] * rs_;
#pragma unroll
                    for (int i = 0; i < 4; ++i) v[n][i] = silu(a[i]) * b[i]; }
                *(u32x4*)(O + (size_t)(row0 + ai * 128 + m * 16) * FFH_ + col0) = pack8(v[0], v[1]); }
    }
};
struct CmpOrder {
    int c, G;
    __device__ __forceinline__ bool next(int i, Unit& u) const { const int id = i * G + c; if (id >= 16 * NBC) return false; const int rt = (id >> 3) & (NBC - 1), kv = id / (8 * NBC); u.pm = kv * NBC + rt; u.pn = kv; return true; }
    __device__ __forceinline__ void a_ready(const Unit&) const {}
    __device__ __forceinline__ void done(const Unit&) const {}
};
struct EpiCmpPart {
    static constexpr bool RS_LDS = false;
    static constexpr bool PERM = false, AFTER_DRAIN = false;
    float* HIDP; int ks;
    __device__ __forceinline__ void operator()(const f32x4 (&acc)[2][2][4][2], const Unit& u, int wr, int wc, int fr, int fq) const {
        const int row0 = u.pm * 256 + wr * 64 + fr, col0 = wc * 32 + 4 * fq;
        float* base = HIDP + ((size_t)ks * (NBC * 512) + row0) * 256 + col0;
#pragma unroll
        for (int ai = 0; ai < 2; ++ai)
#pragma unroll
            for (int m = 0; m < 4; ++m)
#pragma unroll
                for (int bj = 0; bj < 2; ++bj)
#pragma unroll
                    for (int n = 0; n < 2; ++n) *(f32x4*)(base + (size_t)(ai * 128 + m * 16) * 256 + bj * 128 + n * 16) = acc[ai][bj][m][n];
    }
};
}
#define XB_TMO      128
#define XB_XCNT(j)  (256  + 64 * (j))
#define XB_XSUB(j)  (1280 + 64 * (j))
#define XB_XGEN(j)  (2304 + 64 * (j))
#define XB_TOP      3328
#define XB_TOPGEN   3392
#define XCD_BAR_WORDS 3456
#define XB_SPIN_CAP (1u << 18)

__device__ __forceinline__ unsigned xb_ld(unsigned* p)              { return __hip_atomic_load(p, __ATOMIC_RELAXED, __HIP_MEMORY_SCOPE_AGENT); }
__device__ __forceinline__ unsigned xb_add(unsigned* p, unsigned v) { return __hip_atomic_fetch_add(p, v, __ATOMIC_RELAXED, __HIP_MEMORY_SCOPE_AGENT); }
__device__ __forceinline__ unsigned xb_xcc_id() { return (unsigned)__builtin_amdgcn_s_getreg((3 << 11) | 20) & 0xFu; }
#define XB_SPIN(cond, bar) do { unsigned _sp = 0; while (cond) { __builtin_amdgcn_s_sleep(1); \
    if ((++_sp & 255u) == 0u) { if (xb_ld(&(bar)[XB_TMO])) break; if (_sp > XB_SPIN_CAP) { atomicAdd(&(bar)[XB_TMO], 1u); break; } } } } while (0)

struct XcdBarrier {
    unsigned* bar; unsigned x;
    volatile LAS unsigned* st;
};

__device__ __forceinline__ XcdBarrier xcd_barrier_post(unsigned* bar, volatile LAS unsigned* st) {
    XcdBarrier b; b.bar = bar; b.x = xb_xcc_id(); b.st = st;
    if (threadIdx.x == 0) (void)xb_add(&bar[XB_XCNT(b.x)], 1u);
    return b;
}
__device__ __forceinline__ void xcd_barrier_complete(unsigned* bar, unsigned x, unsigned& nloc, unsigned& nx) {
    const unsigned G = gridDim.x * gridDim.y * gridDim.z;
    unsigned sum, cnt, mine, sp = 0u;
    for (;;) {
        sum = 0u; cnt = 0u; mine = 0u;
#pragma unroll
        for (unsigned j = 0; j < 16; ++j) { const unsigned c = xb_ld(&bar[XB_XCNT(j)]); sum += c; cnt += (c > 0u) ? 1u : 0u; mine = (j == x) ? c : mine; }
        if (sum == G) break;
        __builtin_amdgcn_s_sleep(1);
        if ((++sp & 255u) == 0u) { if (xb_ld(&bar[XB_TMO])) break; if (sp > XB_SPIN_CAP) { atomicAdd(&bar[XB_TMO], 1u); break; } }
    }
    nloc = mine > 0u ? mine : 1u; nx = cnt > 0u ? cnt : 1u;
}

__device__ __forceinline__ void xcd_barrier(const XcdBarrier& b, const bool tid0) {
    asm volatile("s_waitcnt vmcnt(0)" ::: "memory");
    __syncthreads();
    if (tid0) {
        unsigned* bar = b.bar;
        __builtin_amdgcn_s_waitcnt(0);
        unsigned nloc = b.st[0], nx = b.st[1];
        if (nloc == 0u) { xcd_barrier_complete(bar, b.x, nloc, nx); b.st[0] = nloc; b.st[1] = nx; }
        const unsigned old = xb_add(&bar[XB_XSUB(b.x)], 1u);
        const unsigned gen = old / nloc;
        if (old + 1u == (gen + 1u) * nloc) {
            __builtin_amdgcn_fence(__ATOMIC_RELEASE, "agent");
            asm volatile("s_waitcnt vmcnt(0)" ::: "memory");
            const unsigned og = xb_add(&bar[XB_TOP], 1u);
            const unsigned tg = og / nx;
            if (og + 1u == (tg + 1u) * nx) xb_add(&bar[XB_TOPGEN], 1u);
            else XB_SPIN(xb_ld(&bar[XB_TOPGEN]) == tg, bar);
            __builtin_amdgcn_fence(__ATOMIC_ACQUIRE, "agent");
            xb_add(&bar[XB_XGEN(b.x)], 1u);
            asm volatile("s_waitcnt vmcnt(0)" ::: "memory");
        } else {
            XB_SPIN(xb_ld(&bar[XB_XGEN(b.x)]) == gen, bar);
            __builtin_amdgcn_fence(__ATOMIC_ACQUIRE, "agent");
            asm volatile("s_waitcnt vmcnt(0)" ::: "memory");
        }
    }
    __syncthreads();
}

struct Args { const float* in[17]; float* out; unsigned char* ws; int it_lo, it_hi, ph_lo, ph_hi, flags, pad; };

struct Ctx { LAS unsigned char* lds; int tid, lane, wave, G, bid; };
typedef const __attribute__((address_space(4))) Args* KArgs;
__device__ __forceinline__ KArgs kargs() { unsigned long long p = (unsigned long long)__builtin_amdgcn_kernarg_segment_ptr(); asm volatile("" : "+s"(p)); return (KArgs)p; }
#define AP (kargs())

template <class Map>
__device__ __forceinline__ void p0_transpose_item(const float* W, int K, int Nsrc, bf16* WT, int ngrp, LAS float* scr, int item, int lane, const Map& map, const float* gk = nullptr) {
    const int kb = item / ngrp, nb = item % ngrp, k0 = 64 * kb, n0 = 32 * nb;
    const int sc = map(n0 + (lane & 31));
#pragma unroll
    for (int i = 0; i < 32; ++i) { const int kk = 2 * i + (lane >> 5); scr[kk * 33 + (lane & 31)] = sc >= 0 ? W[(size_t)(k0 + kk) * Nsrc + sc] * (gk ? gk[k0 + kk] : 1.f) : 0.f; }
    LDS_WAIT(); asm volatile("" ::: "memory");
    const int c = lane & 7;
#pragma unroll
    for (int j = 0; j < 4; ++j) { const int n = (lane >> 3) + 8 * j; const LAS float* s = scr + (8 * c) * 33 + n;
        u32x4 o; o.x = pk2(s[0 * 33], s[1 * 33]); o.y = pk2(s[2 * 33], s[3 * 33]); o.z = pk2(s[4 * 33], s[5 * 33]); o.w = pk2(s[6 * 33], s[7 * 33]);
        *(u32x4*)(WT + (size_t)(n0 + n) * K + k0 + 8 * c) = o; }
    LDS_WAIT(); asm volatile("" ::: "memory");
}
struct MapId { __device__ __forceinline__ int operator()(int n) const { return n; } };
struct MapWin { __device__ __forceinline__ int operator()(int n) const { return n < 7936 ? n : (n < 9984 ? n + 48 : (n < 10032 ? n - 2048 : -1)); } };
struct MapFfi { __device__ __forceinline__ int operator()(int n) const { const int pn = n >> 8, j = n & 255; return j < 128 ? 128 * pn + j : FFH_ + 128 * pn + (j - 128); } };

__device__ __forceinline__ void p0_prologue(const Ctx& C) {
    unsigned char* ws = AP->ws;
    LAS float* scr = (LAS float*)(C.lds + C.wave * 16384);
    const int gw = C.bid * NWAVES + C.wave, NGW = C.G * NWAVES;
    constexpr int I_IN = 16 * 320, I_OR = 32 * 32, I_ON = 16 * 32, I_OUT = 16 * 32, I_FI = 16 * 176, I_FO = 44 * 32, I_C1 = 32 * 8, I_L = I_IN + I_OR + I_ON + I_OUT + I_FI + I_FO + 2 * I_C1;
    for (int it = gw; it < NLAYER * I_L; it += NGW) {
        const int L = it / I_L; int r = it % I_L;
        if (r < I_IN) { p0_transpose_item(AP->in[2] + (size_t)L * DM * CIN, DM, CIN, (bf16*)(ws + WS_WIN) + (size_t)L * CPAD * DM, 320, scr, r, C.lane, MapWin(), L > 0 ? AP->in[1] + L * DM : nullptr); continue; } r -= I_IN;
        if (r < I_OR) { p0_transpose_item(AP->in[9] + (size_t)L * 2048 * DM, 2048, DM, (bf16*)(ws + WS_WORET) + (size_t)L * DM * 2048, 32, scr, r, C.lane, MapId()); continue; } r -= I_OR;
        if (r < I_ON) { p0_transpose_item(AP->in[10] + (size_t)L * DM * DM, DM, DM, (bf16*)(ws + WS_WONSA) + (size_t)L * DM * DM, 32, scr, r, C.lane, MapId()); continue; } r -= I_ON;
        if (r < I_OUT) { p0_transpose_item(AP->in[11] + (size_t)L * DM * DM, DM, DM, (bf16*)(ws + WS_WOUT) + (size_t)L * DM * DM, 32, scr, r, C.lane, MapId()); continue; } r -= I_OUT;
        if (r < I_FI) { p0_transpose_item(AP->in[13] + (size_t)L * DM * 2 * FFH_, DM, 2 * FFH_, (bf16*)(ws + WS_WFFI) + (size_t)L * 2 * FFH_ * DM, 176, scr, r, C.lane, MapFfi(), AP->in[12] + L * DM); continue; } r -= I_FI;
        if (r < I_FO) { p0_transpose_item(AP->in[14] + (size_t)L * FFH_ * DM, FFH_, DM, (bf16*)(ws + WS_WFFO) + (size_t)L * DM * FFH_, 32, scr, r, C.lane, MapId()); continue; } r -= I_FO;
        if (r < I_C1) { p0_transpose_item(AP->in[5] + (size_t)L * 2048 * 256, 2048, 256, (bf16*)(ws + WS_WC1) + (size_t)(L * 2 + 0) * 256 * 2048, 8, scr, r, C.lane, MapId()); continue; } r -= I_C1;
        p0_transpose_item(AP->in[7] + (size_t)L * 2048 * 256, 2048, 256, (bf16*)(ws + WS_WC1) + (size_t)(L * 2 + 1) * 256 * 2048, 8, scr, r, C.lane, MapId());
    }
    const int gt = C.bid * 512 + C.tid, NGT = C.G * 512;
    float* rot = (float*)(ws + WS_ROT);
    for (int i = gt; i < 128; i += NGT) rot[i] = (float)(pow(10000.0, -(double)i / 128.0) / 6.283185307179586476925);
    { float* cpart = (float*)(ws + WS_ROT + 65536);
      for (int item = gw; item < 512; item += NGW) { const int sl = item & 31, grp = item >> 5, L = grp >> 3, kv = (grp >> 2) & 1, hid = (grp & 3) * 64 + C.lane;
          const float* pe = (kv ? AP->in[4] : AP->in[3]) + L * 2048 + sl * 64; const float* w1 = (kv ? AP->in[7] : AP->in[5]) + (size_t)L * 2048 * 256 + (size_t)sl * 64 * 256 + hid;
          float s0_ = 0.f, s1_ = 0.f, s2_ = 0.f, s3_ = 0.f;
#pragma unroll 4
          for (int k = 0; k < 64; k += 4) { s0_ += pe[k] * w1[(size_t)k * 256]; s1_ += pe[k + 1] * w1[(size_t)(k + 1) * 256]; s2_ += pe[k + 2] * w1[(size_t)(k + 2) * 256]; s3_ += pe[k + 3] * w1[(size_t)(k + 3) * 256]; }
          cpart[sl * 1024 + ((L * 2 + kv) << 8) + hid] = (s0_ + s1_) + (s2_ + s3_); } }
    { float* ones = (float*)(ws + WS_ONES); for (int i = gt; i < NTOK; i += NGT) ones[i] = 1.f; }
    float* t5 = (float*)(ws + WS_T5);
    for (int i = gt; i < 16 * 128; i += NGT) { const int hd = i >> 7, dist = i & 127; int bk = dist;
        if (dist >= 16) { bk = 16 + (int)(log((double)dist / 16.0) / log(8.0) * 16.0); if (bk > 31) bk = 31; }
        t5[i] = AP->in[15][bk * 16 + hd] * LOG2E; }
}

template <int NR>
__device__ __forceinline__ void rms_rows_to_bf16(const float* x, const float* g, bf16* o, int m, int stride, int lane) {
    f32x4 v[NR][4];
#pragma unroll
    for (int r = 0; r < NR; ++r) { const f32x4* xr = (const f32x4*)(x + (size_t)(m + r * stride) * DM) + lane;
#pragma unroll
        for (int j = 0; j < 4; ++j) v[r][j] = xr[64 * j]; }
    f32x4 gg[4];
#pragma unroll
    for (int j = 0; j < 4; ++j) gg[j] = ((const f32x4*)g + lane)[64 * j];
#pragma unroll
    for (int r = 0; r < NR; ++r) { float s = 0.f;
#pragma unroll
        for (int j = 0; j < 4; ++j) s += (v[r][j].x * v[r][j].x + v[r][j].y * v[r][j].y) + (v[r][j].z * v[r][j].z + v[r][j].w * v[r][j].w);
        const float rs = 1.f / sqrtf(wave_sum(s, lane) * (1.f / DM) + 1e-6f);
        u32x2* o8 = (u32x2*)(o + (size_t)(m + r * stride) * DM) + lane;
#pragma unroll
        for (int j = 0; j < 4; ++j) { u32x2 w; w.x = pk2(v[r][j].x * rs * gg[j].x, v[r][j].y * rs * gg[j].y); w.y = pk2(v[r][j].z * rs * gg[j].z, v[r][j].w * rs * gg[j].w); o8[64 * j] = w; } }
}
template <int NR>
__device__ __forceinline__ void rms_rows_bf16_to_bf16(const bf16* x, const float* g, bf16* o, int m, int stride, int lane) {
    u32x4 v[NR][2];
#pragma unroll
    for (int r = 0; r < NR; ++r) { const u32x4* xr = (const u32x4*)(x + (size_t)(m + r * stride) * DM) + 2 * lane; v[r][0] = xr[0]; v[r][1] = xr[1]; }
    f32x4 gg[4];
#pragma unroll
    for (int j = 0; j < 4; ++j) gg[j] = ((const f32x4*)g + 4 * lane)[j];
#pragma unroll
    for (int r = 0; r < NR; ++r) { f32x4 a[4]; epi::unpack8(v[r][0], a[0], a[1]); epi::unpack8(v[r][1], a[2], a[3]); float s = 0.f;
#pragma unroll
        for (int j = 0; j < 4; ++j) s += (a[j].x * a[j].x + a[j].y * a[j].y) + (a[j].z * a[j].z + a[j].w * a[j].w);
        const float rs = 1.f / sqrtf(wave_sum(s, lane) * (1.f / DM) + 1e-6f);
        u32x4* o8 = (u32x4*)(o + (size_t)(m + r * stride) * DM) + 2 * lane;
        o8[0] = epi::pack8(a[0] * rs * gg[0], a[1] * rs * gg[1]); o8[1] = epi::pack8(a[2] * rs * gg[2], a[3] * rs * gg[3]); }
}
__device__ __forceinline__ void rms_row_final(const bf16* xrow, const float* g, float* orow, int lane) {
    const u32x4* xr = (const u32x4*)xrow + 2 * lane; const u32x4 v0 = xr[0], v1 = xr[1]; f32x4 a[4]; epi::unpack8(v0, a[0], a[1]); epi::unpack8(v1, a[2], a[3]); float s = 0.f;
#pragma unroll
    for (int j = 0; j < 4; ++j) s += (a[j].x * a[j].x + a[j].y * a[j].y) + (a[j].z * a[j].z + a[j].w * a[j].w);
    const float rs = 1.f / sqrtf(wave_sum(s, lane) * (1.f / DM) + 1e-6f);
#pragma unroll
    for (int j = 0; j < 4; ++j) ((f32x4*)orow + 4 * lane)[j] = a[j] * rs * ((const f32x4*)g + 4 * lane)[j];
}
typedef short s16x4 __attribute__((ext_vector_type(4)));
typedef short bf16x8 __attribute__((ext_vector_type(8)));
#define MFMA16(a, b, c) __builtin_amdgcn_mfma_f32_16x16x32_bf16((a), (b), (c), 0, 0, 0)
constexpr int RK_PITCH = 528, RV_PITCH = 144, RR_PITCH = 528;
constexpr int RL_K = 0, RL_V = 128 * RK_PITCH, RL_R = RL_V + 128 * RV_PITCH, RL_END = RL_R + 64 * RR_PITCH;
static_assert(RL_END <= RING_BYTES, "retention LDS map");
__device__ __forceinline__ bf16x8 tr_frag(LAS unsigned char* tile, int pitch, int rowA, int rowB, int col0, int lane) {
    const int q = (lane & 15) >> 2, p = lane & 3;
    const s16x4 a = __builtin_amdgcn_ds_read_tr16_b64_v4i16((LAS s16x4*)(tile + (rowA + q) * pitch + (col0 + 4 * p) * 2));
    const s16x4 b = __builtin_amdgcn_ds_read_tr16_b64_v4i16((LAS s16x4*)(tile + (rowB + q) * pitch + (col0 + 4 * p) * 2));
    return __builtin_shufflevector(a, b, 0, 1, 2, 3, 4, 5, 6, 7);
}
__device__ __forceinline__ bf16x8 tr_frag2(LAS unsigned char* lb, int offA, int offB) {
    const s16x4 a = __builtin_amdgcn_ds_read_tr16_b64_v4i16((LAS s16x4*)(lb + offA));
    const s16x4 b = __builtin_amdgcn_ds_read_tr16_b64_v4i16((LAS s16x4*)(lb + offB));
    return __builtin_shufflevector(a, b, 0, 1, 2, 3, 4, 5, 6, 7);
}
__device__ __forceinline__ void tr_read16(unsigned a0, unsigned a1, unsigned a2, unsigned a3, s16x4 (&r)[16]) {
    asm volatile("ds_read_b64_tr_b16 %0, %16\n\tds_read_b64_tr_b16 %1, %16 offset:2048\n\tds_read_b64_tr_b16 %2, %16 offset:4096\n\tds_read_b64_tr_b16 %3, %16 offset:6144\n\t"
                 "ds_read_b64_tr_b16 %4, %17\n\tds_read_b64_tr_b16 %5, %17 offset:2048\n\tds_read_b64_tr_b16 %6, %17 offset:4096\n\tds_read_b64_tr_b16 %7, %17 offset:6144\n\t"
                 "ds_read_b64_tr_b16 %8, %18\n\tds_read_b64_tr_b16 %9, %18 offset:2048\n\tds_read_b64_tr_b16 %10, %18 offset:4096\n\tds_read_b64_tr_b16 %11, %18 offset:6144\n\t"
                 "ds_read_b64_tr_b16 %12, %19\n\tds_read_b64_tr_b16 %13, %19 offset:2048\n\tds_read_b64_tr_b16 %14, %19 offset:4096\n\tds_read_b64_tr_b16 %15, %19 offset:6144\n\t"
                 "s_waitcnt lgkmcnt(0)"
                 : "=&v"(r[0]), "=&v"(r[1]), "=&v"(r[2]), "=&v"(r[3]), "=&v"(r[4]), "=&v"(r[5]), "=&v"(r[6]), "=&v"(r[7]),
                   "=&v"(r[8]), "=&v"(r[9]), "=&v"(r[10]), "=&v"(r[11]), "=&v"(r[12]), "=&v"(r[13]), "=&v"(r[14]), "=&v"(r[15])
                 : "v"(a0), "v"(a1), "v"(a2), "v"(a3) : "memory");
}
__device__ __forceinline__ bf16x8 pack_bf8(const f32x4 a, const f32x4 b) { u32x4 w; w.x = pk2(a[0], a[1]); w.y = pk2(a[2], a[3]); w.z = pk2(b[0], b[1]); w.w = pk2(b[2], b[3]); return __builtin_bit_cast(bf16x8, w); }

__device__ __forceinline__ void ret_unit(const Ctx& C, int u, const bf16* QKR, const bf16* VR, bf16* ORET, float* GNP) {
    const int es = u & 7, h = (u >> 3) & 3, b = u >> 5;
    const int lane = C.lane, w = C.wave, i16 = lane & 15, g = lane >> 4, tid = C.tid;
    LAS unsigned char* lds = C.lds;
    const size_t tok0 = (size_t)b * T_;
    const float l2g = log2f(1.f - exp2f(-5.f - (float)h));
    const float xi = exp2f(l2g * (float)(w * 16 + i16 + 1));
    const float gchunk = exp2f(l2g * 128.f);
    float dbase[4];
#pragma unroll
    for (int r = 0; r < 4; ++r) dbase[r] = exp2f(l2g * (float)(i16 - 4 * g - r));
    f32x4 racc[2][4];
#pragma unroll
    for (int dt = 0; dt < 2; ++dt)
#pragma unroll
        for (int et = 0; et < 4; ++et) racc[dt][et] = (f32x4){0.f, 0.f, 0.f, 0.f};
    u32x4 stK[8], stV[2]; bf16x8 qfrag[8];
    const unsigned kvo = (unsigned)(tid >> 5) * 512u + (unsigned)(tid & 31) * 16u, vvo = (unsigned)(tid >> 3) * 128u + (unsigned)(tid & 7) * 16u;
    const unsigned qvo = (unsigned)(w * 16 + i16) * 512u + (unsigned)g * 16u;
    const int klo = RL_K + (tid >> 5) * RK_PITCH + (tid & 31) * 16, vlo = RL_V + (tid >> 3) * RV_PITCH + (tid & 7) * 16;
    const char* kch = (const char*)(QKR + ((size_t)((1 * NBC + b) * 4 + h) * T_) * 256);
    const char* vch = (const char*)(VR + ((size_t)((b * 4 + h) * 8 + es) * T_) * 64);
    const char* qch = (const char*)(QKR + ((size_t)((0 * NBC + b) * 4 + h) * T_) * 256);
#pragma unroll
    for (int i = 0; i < 8; ++i) stK[i] = *(const u32x4*)(kch + (size_t)i * 16 * 512 + kvo);
#pragma unroll
    for (int i = 0; i < 2; ++i) stV[i] = *(const u32x4*)(vch + (size_t)i * 64 * 128 + vvo);
#pragma unroll
    for (int kb = 0; kb < 8; ++kb) qfrag[kb] = *(const bf16x8*)(qch + kb * 64 + qvo);
#pragma unroll
    for (int i = 0; i < 8; ++i) *(LAS u32x4*)(lds + klo + i * 16 * RK_PITCH) = stK[i];
#pragma unroll
    for (int i = 0; i < 2; ++i) *(LAS u32x4*)(lds + vlo + i * 64 * RV_PITCH) = stV[i];
    __syncthreads();
    for (int c = 0; c < 16; ++c) {
        const bool more = c + 1 < 16;
        int lane_c = lane; float l2c = l2g; asm volatile("" : "+v"(lane_c), "+v"(l2c));
        const int i16 = lane_c & 15, g = lane_c >> 4;
        const char* kn = kch + (size_t)(c + 1) * 128 * 512; const char* vn = vch + (size_t)(c + 1) * 128 * 128; const char* qn = qch + (size_t)(c + 1) * 128 * 512;
        if (more) {
#pragma unroll
            for (int i = 0; i < 8; ++i) stK[i] = *(const u32x4*)(kn + (size_t)i * 16 * 512 + kvo);
#pragma unroll
            for (int i = 0; i < 2; ++i) stV[i] = *(const u32x4*)(vn + (size_t)i * 64 * 128 + vvo);
        }
        f32x4 oacc[4];
#pragma unroll
        for (int et = 0; et < 4; ++et) oacc[et] = (f32x4){0.f, 0.f, 0.f, 0.f};
        if (c > 0) {
            LAS unsigned char* rl_ = lds + RL_R + i16 * RR_PITCH + g * 16;
#pragma unroll
            for (int hf = 0; hf < 2; ++hf) { bf16x8 rf[4][4];
#pragma unroll
                for (int k = 0; k < 4; ++k)
#pragma unroll
                    for (int et = 0; et < 4; ++et) rf[et][k] = *(const LAS bf16x8*)(rl_ + et * 16 * RR_PITCH + (hf * 4 + k) * 64);
                __builtin_amdgcn_sched_barrier(0);
#pragma unroll
                for (int k = 0; k < 4; ++k)
#pragma unroll
                    for (int et = 0; et < 4; ++et) oacc[et] = MFMA16(rf[et][k], qfrag[hf * 4 + k], oacc[et]); }
#pragma unroll
            for (int et = 0; et < 4; ++et) oacc[et] = oacc[et] * xi;
        }
        for (int i = 0; i <= (w >> 1); ++i) {
            const int mb0 = 2 * i, mb1 = 2 * i + 1;
            f32x4 sa0 = (f32x4){0.f, 0.f, 0.f, 0.f}, sa1 = sa0, sb0 = sa0, sb1 = sa0;
            LAS unsigned char* kl_ = lds + RL_K + (mb0 * 16 + i16) * RK_PITCH + g * 16;
            { bf16x8 kf[8];
#pragma unroll
              for (int kb = 0; kb < 8; ++kb) kf[kb] = *(const LAS bf16x8*)(kl_ + kb * 64);
              __builtin_amdgcn_sched_barrier(0);
#pragma unroll
              for (int kb = 0; kb < 8; kb += 2) { sa0 = MFMA16(kf[kb], qfrag[kb], sa0); sa1 = MFMA16(kf[kb + 1], qfrag[kb + 1], sa1); } }
            if (mb1 <= w) { bf16x8 kf[8];
#pragma unroll
                for (int kb = 0; kb < 8; ++kb) kf[kb] = *(const LAS bf16x8*)(kl_ + 16 * RK_PITCH + kb * 64);
                __builtin_amdgcn_sched_barrier(0);
#pragma unroll
                for (int kb = 0; kb < 8; kb += 2) { sb0 = MFMA16(kf[kb], qfrag[kb], sb0); sb1 = MFMA16(kf[kb + 1], qfrag[kb + 1], sb1); } }
            f32x4 sa = sa0 + sa1, sb = sb0 + sb1;
            const float ga = exp2f(l2c * (float)(16 * (w - mb0))), gb = exp2f(l2c * (float)(16 * (w - mb1)));
#pragma unroll
            for (int r = 0; r < 4; ++r) { const bool da = (mb0 < w) || (i16 - 4 * g - r >= 0), db = (mb1 < w) || (i16 - 4 * g - r >= 0);
                sa[r] = da ? sa[r] * (dbase[r] * ga) : 0.f; sb[r] = (mb1 <= w && db) ? sb[r] * (dbase[r] * gb) : 0.f; }
            const bf16x8 sf = pack_bf8(sa, sb);
            bf16x8 vf[4];
#pragma unroll
            for (int et = 0; et < 4; ++et) vf[et] = tr_frag(lds + RL_V, RV_PITCH, mb0 * 16 + 4 * g, mb1 * 16 + 4 * g, et * 16, lane_c);
            __builtin_amdgcn_sched_barrier(0);
#pragma unroll
            for (int et = 0; et < 4; ++et) oacc[et] = MFMA16(vf[et], sf, oacc[et]);
        }
        { const size_t tok = tok0 + (size_t)c * 128 + w * 16 + i16; float s1 = 0.f, s2 = 0.f;
#pragma unroll
          for (int et = 0; et < 4; ++et) { const f32x4 o = oacc[et]; s1 += (o[0] + o[1]) + (o[2] + o[3]); s2 += (o[0] * o[0] + o[1] * o[1]) + (o[2] * o[2] + o[3] * o[3]);
              u32x2 wv; wv.x = pk2(o[0], o[1]); wv.y = pk2(o[2], o[3]); *(u32x2*)(ORET + tok * 2048 + h * 512 + es * 64 + et * 16 + 4 * g) = wv; }
          s1 += shx(s1, 16, lane_c); s1 += shx(s1, 32, lane_c); s2 += shx(s2, 16, lane_c); s2 += shx(s2, 32, lane_c);
          if (g == 0) *(f32x2*)(GNP + ((tok * 4 + h) * 8 + es) * 2) = (f32x2){s1, s2}; }
        if (more) {
#pragma unroll
            for (int kb = 0; kb < 8; ++kb) qfrag[kb] = *(const bf16x8*)(qn + kb * 64 + qvo);
        }
#pragma unroll
        for (int dt = 0; dt < 2; ++dt)
#pragma unroll
            for (int et = 0; et < 4; ++et) racc[dt][et] = racc[dt][et] * gchunk;
#pragma unroll
        for (int kb = 0; kb < 4; ++kb) {
            float zl[8];
#pragma unroll
            for (int j = 0; j < 8; ++j) zl[j] = __builtin_amdgcn_exp2f(l2c * (float)(127 - 32 * kb - 8 * g - j));
            bf16x8 raw[2], vf[4];
#pragma unroll
            for (int dt = 0; dt < 2; ++dt) raw[dt] = tr_frag(lds + RL_K, RK_PITCH, kb * 32 + 8 * g, kb * 32 + 8 * g + 4, (2 * w + dt) * 16, lane_c);
#pragma unroll
            for (int et = 0; et < 4; ++et) vf[et] = tr_frag(lds + RL_V, RV_PITCH, kb * 32 + 8 * g, kb * 32 + 8 * g + 4, et * 16, lane_c);
            __builtin_amdgcn_sched_barrier(0);
            bf16x8 af[2];
#pragma unroll
            for (int dt = 0; dt < 2; ++dt) { const u32x4 rw = __builtin_bit_cast(u32x4, raw[dt]); u32x4 o;
                o.x = pk2(bflo(rw.x) * zl[0], bfhi(rw.x) * zl[1]); o.y = pk2(bflo(rw.y) * zl[2], bfhi(rw.y) * zl[3]);
                o.z = pk2(bflo(rw.z) * zl[4], bfhi(rw.z) * zl[5]); o.w = pk2(bflo(rw.w) * zl[6], bfhi(rw.w) * zl[7]);
                af[dt] = __builtin_bit_cast(bf16x8, o); }
#pragma unroll
            for (int et = 0; et < 4; ++et)
#pragma unroll
                for (int dt = 0; dt < 2; ++dt) racc[dt][et] = MFMA16(af[dt], vf[et], racc[dt][et]);
        }
        __syncthreads();
        if (more) {
#pragma unroll
            for (int dt = 0; dt < 2; ++dt)
#pragma unroll
                for (int et = 0; et < 4; ++et) { const f32x4 rv = racc[dt][et]; u32x2 wv; wv.x = pk2(rv[0], rv[1]); wv.y = pk2(rv[2], rv[3]);
                    *(LAS u32x2*)(lds + RL_R + (et * 16 + i16) * RR_PITCH + ((2 * w + dt) * 16 + 4 * g) * 2) = wv; }
#pragma unroll
            for (int i = 0; i < 8; ++i) *(LAS u32x4*)(lds + klo + i * 16 * RK_PITCH) = stK[i];
#pragma unroll
            for (int i = 0; i < 2; ++i) *(LAS u32x4*)(lds + vlo + i * 64 * RV_PITCH) = stV[i];
        }
        __syncthreads();
    }
}
template <int NR>
__device__ __forceinline__ void gn_gate_rows(const bf16* PROJ, bf16* ORET, const float* GNP, int m, int stride, int lane) {
    u32x4 ow[NR][4], gw[NR][4]; f32x4 st[NR][4];
#pragma unroll
    for (int r = 0; r < NR; ++r) { const size_t tok = (size_t)(m + r * stride);
#pragma unroll
        for (int h = 0; h < 4; ++h) { ow[r][h] = *(const u32x4*)(ORET + tok * 2048 + h * 512 + lane * 8); gw[r][h] = *(const u32x4*)(PROJ + tok * PPITCH + PC_GR + h * 512 + lane * 8);
            st[r][h] = *((const f32x4*)(GNP + (tok * 4 + h) * 16) + (lane & 3)); } }
#pragma unroll
    for (int r = 0; r < NR; ++r) { const size_t tok = (size_t)(m + r * stride);
#pragma unroll
        for (int h = 0; h < 4; ++h) { float s1 = st[r][h][0] + st[r][h][2], s2 = st[r][h][1] + st[r][h][3];
            s1 += shx(s1, 1, lane); s2 += shx(s2, 1, lane); s1 += shx(s1, 2, lane); s2 += shx(s2, 2, lane);
            const float mean = s1 * (1.f / 512.f), var = fmaxf(s2 * (1.f / 512.f) - mean * mean, 0.f), rstd = 1.f / sqrtf(var + 1e-5f);
            const u32x4 a = ow[r][h], g = gw[r][h]; u32x4 o;
            o.x = pk2((bflo(a.x) - mean) * rstd * silu(bflo(g.x)), (bfhi(a.x) - mean) * rstd * silu(bfhi(g.x))); o.y = pk2((bflo(a.y) - mean) * rstd * silu(bflo(g.y)), (bfhi(a.y) - mean) * rstd * silu(bfhi(g.y)));
            o.z = pk2((bflo(a.z) - mean) * rstd * silu(bflo(g.z)), (bfhi(a.z) - mean) * rstd * silu(bfhi(g.z))); o.w = pk2((bflo(a.w) - mean) * rstd * silu(bflo(g.w)), (bfhi(a.w) - mean) * rstd * silu(bfhi(g.w)));
            *(u32x4*)(ORET + tok * 2048 + h * 512 + lane * 8) = o; } }
}


constexpr int NL_T5 = 0, NL_T5H = 384, NL_TILE = 64 * 144, NL_K0 = 8 * NL_T5H * 4, NL_V0 = NL_K0 + 2 * NL_TILE, NL_IMP = NL_K0 + 4 * NL_TILE, NL_XCH = NL_IMP + 8 * 64 * 33 * 4, NL_SEL = NL_XCH + 8 * 512 * 4, NL_GATE = NL_SEL + 512, NL_END = NL_GATE + 3 * 8 * 64 * 4;
constexpr int NL_RING = NL_K0, NL_SLOT = 16384, NL_Q = NL_RING + 3 * NL_SLOT;
static_assert(NL_Q + 8 * 8192 <= NL_SEL && NL_END <= LDSCTL_OFF, "NSA LDS map");
__device__ __forceinline__ float xmax4(float x) {
    float a = x, b = x;
    asm volatile("s_nop 1\n\tv_permlane16_swap_b32 %0, %1" : "+v"(a), "+v"(b));
    a = fmaxf(a, b); b = a;
    asm volatile("s_nop 1\n\tv_permlane32_swap_b32 %0, %1" : "+v"(a), "+v"(b));
    return fmaxf(a, b);
}
__device__ __forceinline__ float xsum4(float x) {
    float a = x, b = x;
    asm volatile("s_nop 1\n\tv_permlane16_swap_b32 %0, %1" : "+v"(a), "+v"(b));
    a = a + b; b = a;
    asm volatile("s_nop 1\n\tv_permlane32_swap_b32 %0, %1" : "+v"(a), "+v"(b));
    return a + b;
}
__device__ __forceinline__ int ishx(int v, int m, int lane) { return __builtin_amdgcn_ds_bpermute((lane ^ m) << 2, v); }

__device__ __forceinline__ void nsa_unit(const Ctx& C, int u, const bf16* PROJ, const bf16* KVX, const bf16* KCV, const float* t5, bf16* ON, bool stage_t5) {
    const int j_ = u >> 5, k_ = j_ & 7, r_ = j_ >> 3, qb = r_ == 0 ? 31 - k_ : r_ == 1 ? (int)((0xd17a58u >> (3 * k_)) & 7u) : r_ == 2 ? 16 + (int)((0x5d83acu >> (3 * k_)) & 7u) : 8 + (int)((0x6b894eu >> (3 * k_)) & 7u), bg = u & 31, g_ = bg & 1, b = bg >> 1;
    int tid_u = C.tid; asm volatile("" : "+v"(tid_u));
    const int w = C.wave, tid = tid_u, lane = tid & 63, head = g_ * 8 + w, s0 = qb * 64, i16 = lane & 15, g = lane >> 4;
    LAS unsigned char* lds = C.lds;
    const size_t tok0 = (size_t)b * T_;
    LAS float* T5L = (LAS float*)(lds + NL_T5) + w * NL_T5H;
    LAS float* impH = (LAS float*)(lds + NL_IMP);
    LAS unsigned* selm = (LAS unsigned*)(lds + NL_SEL);
    { float tv[6]; unsigned short gv[3];
      if (stage_t5) {
#pragma unroll
      for (int q = 0; q < 6; ++q) { const int i = tid + 512 * q, hh = i / NL_T5H, k = i - hh * NL_T5H; const float* th_ = t5 + (g_ * 8 + hh) * 128;
          const int d = k < 256 ? k - 64 : 127; tv[q] = th_[d < 0 ? 0 : (d > 127 ? 127 : d)]; } }
#pragma unroll
      for (int q = 0; q < 3; ++q) { const int i = tid + 512 * q, tk = i / 24, c = i - tk * 24;
          gv[q] = *(const unsigned short*)(PROJ + (tok0 + s0 + tk) * PPITCH + PC_GATE + g_ * 24 + c); }
      if (stage_t5) {
#pragma unroll
      for (int q = 0; q < 6; ++q) { const int i = tid + 512 * q, hh = i / NL_T5H, k = i - hh * NL_T5H;
          const bool ok = k < 256 ? (k - 64 >= 0) : (k - 256 < 64);
          ((LAS float*)(lds + NL_T5))[i] = ok ? tv[q] : -1e30f; } }
#pragma unroll
      for (int q = 0; q < 3; ++q) { const int i = tid + 512 * q, tk = i / 24, c = i - tk * 24, hh = c / 3, br = c - hh * 3;
          ((LAS float*)(lds + NL_GATE))[(br * 8 + hh) * 64 + tk] = bf2f(gv[q]); } }
    { const bf16* kc = KCV + ((size_t)((0 * NBC + b) * 2 + g_) * NCMP_PAD) * 64; const bf16* vc = KCV + ((size_t)((1 * NBC + b) * 2 + g_) * NCMP_PAD) * 64;
#pragma unroll
      for (int i = 0; i < 2; ++i) { const int p = tid + 512 * i, row = p >> 3, c16 = p & 7;
          *(LAS u32x4*)(lds + NL_K0 + row * 144 + c16 * 16) = *(const u32x4*)(kc + row * 64 + c16 * 8);
          *(LAS u32x4*)(lds + NL_V0 + row * 144 + c16 * 16) = *(const u32x4*)(vc + row * 64 + c16 * 8); } }
    bf16x8 qf[4][2];
#pragma unroll
    for (int tt = 0; tt < 4; ++tt)
#pragma unroll
        for (int kb = 0; kb < 2; ++kb) qf[tt][kb] = *(const bf16x8*)(PROJ + (tok0 + s0 + tt * 16 + i16) * PPITCH + PC_QN + head * 64 + kb * 32 + 8 * g);
    __syncthreads();
    u32x2 fpk[4][4];
    const int ktmax = (4 * qb + 2) >> 4;
#pragma unroll
    for (int tt = 0; tt < 4; ++tt) {
        int lane_b = lane; asm volatile("" : "+v"(lane_b));
        const int i16 = lane_b & 15, g = lane_b >> 4;
        LAS unsigned char* kl = lds + NL_K0 + i16 * 144 + g * 16; LAS unsigned char* vl = lds + NL_V0 + (4 * g + ((lane_b & 15) >> 2)) * 144 + (lane_b & 3) * 8;
        const int pos = s0 + tt * 16 + i16;
        f32x4 st[8];
#pragma unroll
        for (int hf = 0; hf < 2; ++hf) {
            if (4 * hf <= ktmax) { bf16x8 kf[4][2];
#pragma unroll
                for (int k = 0; k < 4; ++k) { kf[k][0] = *(const LAS bf16x8*)(kl + (4 * hf + k) * 16 * 144); kf[k][1] = *(const LAS bf16x8*)(kl + (4 * hf + k) * 16 * 144 + 64); }
                __builtin_amdgcn_sched_barrier(0);
#pragma unroll
                for (int k = 0; k < 4; ++k) { st[4 * hf + k] = MFMA16(kf[k][0], qf[tt][0], ((f32x4){0.f, 0.f, 0.f, 0.f})); st[4 * hf + k] = MFMA16(kf[k][1], qf[tt][1], st[4 * hf + k]); }
            } else {
#pragma unroll
                for (int k = 0; k < 4; ++k) st[4 * hf + k] = (f32x4){-1e30f, -1e30f, -1e30f, -1e30f};
            } }
        float mx = -1e30f;
#pragma unroll
        for (int hf = 0; hf < 2; ++hf)
            if (4 * hf <= ktmax) { float tbv[4][4];
#pragma unroll
                for (int k = 0; k < 4; ++k)
#pragma unroll
                    for (int r = 0; r < 4; ++r) { const int dk = pos - 16 * ((4 * hf + k) * 16 + 4 * g + r) - 31 + 64; tbv[k][r] = T5L[dk < 0 ? 0 : (dk > 255 ? 255 : dk)]; }
#pragma unroll
                for (int k = 0; k < 4; ++k) { asm volatile("" : "+v"(tbv[k][0]), "+v"(tbv[k][1]), "+v"(tbv[k][2]), "+v"(tbv[k][3]));
#pragma unroll
                    for (int r = 0; r < 4; ++r) { const float l = fmaxf(st[4 * hf + k][r] + tbv[k][r], -1e30f); st[4 * hf + k][r] = l; mx = fmaxf(mx, l); } } }
        mx = xmax4(mx);
        float sum = 0.f;
#pragma unroll
        for (int kt = 0; kt < 8; ++kt)
#pragma unroll
            for (int r = 0; r < 4; ++r) { const float p = st[kt][r] > -1e29f ? __builtin_amdgcn_exp2f(st[kt][r] - mx) : 0.f; st[kt][r] = p; sum += p; }
        sum = xsum4(sum);
        const float inv = __builtin_amdgcn_rcpf(fmaxf(sum, 1e-30f));
        float rv[8];
#pragma unroll
        for (int kt = 0; kt < 8; ++kt) st[kt] = st[kt] * inv;
        { LAS float* xs = (LAS float*)(lds + NL_XCH) + w * 512;
#pragma unroll
          for (int kt = 0; kt < 8; ++kt) xs[kt * 64 + lane_b] = st[kt][3];
#pragma unroll
          for (int kt = 0; kt < 8; ++kt) rv[kt] = xs[kt * 64 + ((lane_b - 16) & 63)]; }
#pragma unroll
        for (int kt = 0; kt < 8; ++kt) { const float prev = g > 0 ? rv[kt] : (kt > 0 ? rv[kt > 0 ? kt - 1 : 0] : 0.f);
            impH[(w * 64 + tt * 16 + i16) * 33 + 4 * kt + g] = (st[kt][0] + st[kt][1]) + (st[kt][2] + st[kt][3]) + prev; }
        f32x4 o[4];
#pragma unroll
        for (int dt = 0; dt < 4; ++dt) o[dt] = (f32x4){0.f, 0.f, 0.f, 0.f};
#pragma unroll
        for (int i = 0; i < 4; ++i)
            if (2 * i <= ktmax) { const bf16x8 pf = pack_bf8(st[2 * i], st[2 * i + 1]); bf16x8 vf[4];
#pragma unroll
                for (int dt = 0; dt < 4; ++dt) vf[dt] = tr_frag2(vl, (2 * i) * 16 * 144 + dt * 32, (2 * i + 1) * 16 * 144 + dt * 32);
                __builtin_amdgcn_sched_barrier(0);
#pragma unroll
                for (int dt = 0; dt < 4; ++dt) o[dt] = MFMA16(vf[dt], pf, o[dt]); }
        const float g0 = ((LAS float*)(lds + NL_GATE))[(0 * 8 + w) * 64 + tt * 16 + i16];
#pragma unroll
        for (int dt = 0; dt < 4; ++dt) { const f32x4 v = o[dt] * g0; fpk[dt][tt].x = pk2(v[0], v[1]); fpk[dt][tt].y = pk2(v[2], v[3]); }
        __builtin_amdgcn_sched_barrier(0);
    }
    __syncthreads();
    const int nw = (qb < 8 ? qb : 8) + 1;
    const char* kvb = (const char*)(KVX + ((size_t)(b * 2 + g_) * T_) * 64);
#define NSA_DMA(blk_, br_, slot_) do { const char* sp_ = kvb + (size_t)((br_) ? 0 : 2) * (NBC * 2 * T_ * 64 * 2) + (size_t)(blk_) * 64 * 128 + dvo; \
        __builtin_amdgcn_global_load_lds((const unsigned*)sp_, (LAS unsigned*)(lds + NL_RING + (slot_) * NL_SLOT + w * 1024), 16, 0, 0); \
        __builtin_amdgcn_global_load_lds((const unsigned*)(sp_ + (size_t)NBC * 2 * T_ * 64 * 2), (LAS unsigned*)(lds + NL_RING + (slot_) * NL_SLOT + 8192 + w * 1024), 16, 0, 0); } while (0)
    { int tid_e = C.tid; asm volatile("" : "+v"(tid_e)); const int le_ = tid_e & 63;
      const unsigned dvo = (unsigned)(w * 8 + (le_ >> 3)) * 128u + (unsigned)((le_ & 7) ^ ((w * 4 + (le_ >> 4)) & 7)) * 16u;
      NSA_DMA(qb, 0, 0); if (nw > 1) NSA_DMA(qb - 1, 0, 1); }
    int tid_s = C.tid; asm volatile("" : "+v"(tid_s));
    if (tid_s < 256) {
        const int tk = tid_s >> 2, part = tid_s & 3, lane = tid_s & 63;
        float im[8];
#pragma unroll
        for (int jj = 0; jj < 8; ++jj) { const int j = part * 8 + jj; float v = impH[tk * 33 + j];
#pragma unroll
            for (int hh = 1; hh < 8; ++hh) v += impH[(hh * 64 + tk) * 33 + j];
            im[jj] = v; }
        unsigned m = 1u | (1u << qb) | (qb > 0 ? (1u << (qb - 1)) : 0u);
        int cnt = __builtin_popcount(m);
        const int want = (qb + 1) < 8 ? (qb + 1) : 8;
        for (; cnt < want; ++cnt) {
            int best = 64; float bv = -1.f;
#pragma unroll
            for (int jj = 0; jj < 8; ++jj) { const int j = part * 8 + jj; const bool cand = j <= qb && !((m >> j) & 1u); if (cand && im[jj] > bv) { bv = im[jj]; best = j; } }
#pragma unroll
            for (int o = 1; o < 4; o <<= 1) { const float ov = shx(bv, o, lane); const int oi = ishx(best, o, lane); if (ov > bv || (ov == bv && oi < best)) { bv = ov; best = oi; } }
            if (best < 32) m |= 1u << best; }
        if (part == 0) selm[tk] = m;
        unsigned um = m;
#pragma unroll
        for (int o = 4; o < 64; o <<= 1) um |= (unsigned)ishx((int)um, o, lane);
        if (lane == 0) selm[64 + (tid_s >> 6)] = um;
    }
    __syncthreads();
    int tid_t = C.tid; asm volatile("" : "+v"(tid_t));
    const int lane2 = tid_t & 63;
    const unsigned umask = selm[64] | selm[65] | selm[66] | selm[67];
    unsigned selw[4];
#pragma unroll
    for (int tt = 0; tt < 4; ++tt) selw[tt] = selm[tt * 16 + (lane2 & 15)];
    const int ntile = nw + __builtin_popcount(umask);
    const float bfar = T5L[64 + 127];
    LAS unsigned char* qls = lds + NL_Q + w * 8192 + lane2 * 16;
#pragma unroll
    for (int tt = 0; tt < 4; ++tt)
#pragma unroll
        for (int kb = 0; kb < 2; ++kb) *(LAS bf16x8*)(qls + (tt * 2 + kb) * 1024) = qf[tt][kb];
    float mrun[4], lrun[4]; f32x4 oacc[4][4];
#pragma unroll
    for (int tt = 0; tt < 4; ++tt) { mrun[tt] = 0.f; lrun[tt] = 0.f;
#pragma unroll
        for (int dt = 0; dt < 4; ++dt) oacc[dt][tt] = (f32x4){0.f, 0.f, 0.f, 0.f}; }
    const unsigned dvo = (unsigned)(w * 8 + (lane2 >> 3)) * 128u + (unsigned)((lane2 & 7) ^ ((w * 4 + (lane2 >> 4)) & 7)) * 16u;
    unsigned remg = umask; int kgen = 0;
#define NSA_GEN(blk_, br_) do { if (kgen < nw) { blk_ = qb - kgen; br_ = 0; } else { br_ = 1; blk_ = remg ? __builtin_ctz(remg) : 0; remg &= remg - 1; } ++kgen; } while (0)
    int cur_blk, cur_br, n1_blk = 0, n1_br = 0, n2_blk = 0, n2_br = 0;
    NSA_GEN(cur_blk, cur_br);
    if (ntile > 1) { NSA_GEN(n1_blk, n1_br); if (nw == 1) NSA_DMA(n1_blk, n1_br, 1); }
    bool fresh = true;
    for (int it = 0; it < ntile; ++it) {
        int lane_c = lane2; asm volatile("" : "+v"(lane_c));
        const int i16c = lane_c & 15, gc = lane_c >> 4;
        const int slot = it % 3;
        if (it + 1 < ntile) asm volatile("s_waitcnt vmcnt(2)" ::: "memory"); else asm volatile("s_waitcnt vmcnt(0)" ::: "memory");
        __builtin_amdgcn_s_barrier(); asm volatile("" ::: "memory");
        if (it + 2 < ntile) { NSA_GEN(n2_blk, n2_br); NSA_DMA(n2_blk, n2_br, (it + 2) % 3); }
        LAS unsigned char* kt_ = lds + NL_RING + slot * NL_SLOT + i16c * 128; LAS unsigned char* vt_ = kt_ - i16c * 128 + 8192 + (4 * gc + (i16c >> 2)) * 128 + (lane_c & 1) * 8;
        const int kx0 = ((gc ^ ((i16c >> 1) & 7)) << 4), kx1 = kx0 ^ 64;
        const int vx = (2 * gc + ((i16c >> 3) & 1)) & 7, vph = (lane_c >> 1) & 1;
        const int dl = qb - cur_blk;
#pragma unroll
        for (int th = 0; th < 2; ++th) {
            bf16x8 kfr[4][2], qh[2][2];
            { LAS unsigned char* ql_ = lds + NL_Q + w * 8192 + lane_c * 16;
#pragma unroll
              for (int tx = 0; tx < 2; ++tx)
#pragma unroll
                  for (int kb = 0; kb < 2; ++kb) qh[tx][kb] = *(const LAS bf16x8*)(ql_ + ((2 * th + tx) * 2 + kb) * 1024); }
#pragma unroll
            for (int kt = 0; kt < 4; ++kt) { kfr[kt][0] = *(const LAS bf16x8*)(kt_ + kt * 2048 + kx0); kfr[kt][1] = *(const LAS bf16x8*)(kt_ + kt * 2048 + kx1); }
            __builtin_amdgcn_sched_barrier(0);
            f32x4 st[4][2];
            if (dl >= 3 && !(cur_br == 0 && dl == 8)) {
#pragma unroll
                for (int tx = 0; tx < 2; ++tx) { const float off = ((cur_br == 0 || ((selw[2 * th + tx] >> cur_blk) & 1u)) ? bfar : -1e30f) - mrun[2 * th + tx];
#pragma unroll
                    for (int kt = 0; kt < 4; ++kt) { st[kt][tx] = MFMA16(kfr[kt][0], qh[tx][0], ((f32x4){off, off, off, off})); st[kt][tx] = MFMA16(kfr[kt][1], qh[tx][1], st[kt][tx]); } }
            } else {
#pragma unroll
                for (int kt = 0; kt < 4; ++kt)
#pragma unroll
                    for (int tx = 0; tx < 2; ++tx) { st[kt][tx] = MFMA16(kfr[kt][0], qh[tx][0], ((f32x4){0.f, 0.f, 0.f, 0.f})); st[kt][tx] = MFMA16(kfr[kt][1], qh[tx][1], st[kt][tx]); }
                const bool wedge = cur_br == 0 && dl == 8;
#pragma unroll
                for (int tx = 0; tx < 2; ++tx) { const bool sel = cur_br == 0 || ((selw[2 * th + tx] >> cur_blk) & 1u);
                    LAS float* tb_ = T5L + (wedge ? 256 : 64 * dl) + 13 + (2 * th + tx) * 16 + i16c - 4 * gc;
                    float tbv[4][4];
#pragma unroll
                    for (int kt = 0; kt < 4; ++kt)
#pragma unroll
                        for (int r = 0; r < 4; ++r) tbv[kt][r] = tb_[51 - 16 * kt - r];
                    const float ad = sel ? -mrun[2 * th + tx] : -1e30f;
#pragma unroll
                    for (int kt = 0; kt < 4; ++kt) { asm volatile("" : "+v"(tbv[kt][0]), "+v"(tbv[kt][1]), "+v"(tbv[kt][2]), "+v"(tbv[kt][3]));
                        st[kt][tx] = (st[kt][tx] + (f32x4){tbv[kt][0], tbv[kt][1], tbv[kt][2], tbv[kt][3]}) + ad; } }
            }
            bf16x8 pf[2][2];
#pragma unroll
            for (int tx = 0; tx < 2; ++tx) { const int tt = 2 * th + tx;
                float mx = fmaxf(fmaxf(fmaxf(st[0][tx][0], st[0][tx][1]), fmaxf(st[0][tx][2], st[0][tx][3])), fmaxf(fmaxf(st[1][tx][0], st[1][tx][1]), fmaxf(st[1][tx][2], st[1][tx][3])));
                mx = fmaxf(mx, fmaxf(fmaxf(fmaxf(st[2][tx][0], st[2][tx][1]), fmaxf(st[2][tx][2], st[2][tx][3])), fmaxf(fmaxf(st[3][tx][0], st[3][tx][1]), fmaxf(st[3][tx][2], st[3][tx][3]))));
                mx = xmax4(mx);
                if (fresh || __builtin_amdgcn_ballot_w64(mx > 10.f) != 0ull) {
                    const float d = fresh ? mx : (mx > 10.f ? mx : 0.f), al = fresh ? 0.f : __builtin_amdgcn_exp2f(-d);
                    mrun[tt] += d; lrun[tt] *= al;
#pragma unroll
                    for (int dt = 0; dt < 4; ++dt) oacc[dt][tt] = oacc[dt][tt] * al;
#pragma unroll
                    for (int kt = 0; kt < 4; ++kt) st[kt][tx] = st[kt][tx] - d;
                }
#pragma unroll
                for (int kt = 0; kt < 4; ++kt)
#pragma unroll
                    for (int r = 0; r < 4; ++r) st[kt][tx][r] = __builtin_amdgcn_exp2f(st[kt][tx][r]);
                const f32x4 s4 = (st[0][tx] + st[1][tx]) + (st[2][tx] + st[3][tx]);
                lrun[tt] += (s4[0] + s4[1]) + (s4[2] + s4[3]);
                pf[0][tx] = pack_bf8(st[0][tx], st[1][tx]); pf[1][tx] = pack_bf8(st[2][tx], st[3][tx]);
            }
            { s16x4 vr[16]; const unsigned vb_ = (unsigned)(size_t)vt_;
              tr_read16(vb_ + (((0 + vph) ^ vx) << 4), vb_ + (((2 + vph) ^ vx) << 4), vb_ + (((4 + vph) ^ vx) << 4), vb_ + (((6 + vph) ^ vx) << 4), vr);
#pragma unroll
              for (int i = 0; i < 2; ++i)
#pragma unroll
                  for (int dt = 0; dt < 4; ++dt) { const bf16x8 vf = __builtin_shufflevector(vr[4 * dt + 2 * i], vr[4 * dt + 2 * i + 1], 0, 1, 2, 3, 4, 5, 6, 7);
#pragma unroll
                      for (int tx = 0; tx < 2; ++tx) oacc[dt][2 * th + tx] = MFMA16(vf, pf[i][tx], oacc[dt][2 * th + tx]); } }
        }
        fresh = false;
        const bool last = it + 1 >= ntile;
        if (last || (cur_br == 0 && n1_br == 1)) {
#pragma unroll
            for (int tt = 0; tt < 4; ++tt) { float l = lrun[tt]; l += shx(l, 16, lane_c); l += shx(l, 32, lane_c);
                const size_t tok = tok0 + s0 + tt * 16 + i16c;
                const float gt = ((LAS float*)(lds + NL_GATE))[((cur_br == 0 ? 2 : 1) * 8 + w) * 64 + tt * 16 + i16c] / fmaxf(l, 1e-30f);
#pragma unroll
                for (int dt = 0; dt < 4; ++dt) { const f32x4 v = (f32x4){bflo(fpk[dt][tt].x), bfhi(fpk[dt][tt].x), bflo(fpk[dt][tt].y), bfhi(fpk[dt][tt].y)} + oacc[dt][tt] * gt;
                    u32x2 wv; wv.x = pk2(v[0], v[1]); wv.y = pk2(v[2], v[3]);
                    if (last) *(u32x2*)(ON + tok * DM + head * 64 + dt * 16 + 4 * gc) = wv; else fpk[dt][tt] = wv;
                    oacc[dt][tt] = (f32x4){0.f, 0.f, 0.f, 0.f}; }
                mrun[tt] = 0.f; lrun[tt] = 0.f; }
            fresh = true;
        }
        cur_blk = n1_blk; cur_br = n1_br; n1_blk = n2_blk; n1_br = n2_br;
    }
    asm volatile("s_waitcnt vmcnt(0)" ::: "memory"); __syncthreads();
#undef NSA_DMA
#undef NSA_GEN
}

__global__ void __launch_bounds__(NWAVES * 64, 2) fwd(Args a_unused) {
    extern __shared__ __attribute__((aligned(16))) unsigned char lds_raw[];
    Ctx C; C.lds = (LAS unsigned char*)lds_raw; C.tid = threadIdx.x; C.lane = C.tid & 63; C.wave = __builtin_amdgcn_readfirstlane(C.tid >> 6); C.G = gridDim.x; C.bid = blockIdx.x;
    const int wave0 = C.wave;
#define ws (AP->ws)
#define ctl ((gu32*)(ws + WS_CTL))
    volatile LAS unsigned* MISC = (volatile LAS unsigned*)(C.lds + MISC_OFF);
    for (int u = C.tid; u < (LDS_BYTES - LDSCTL_OFF) / 4; u += NWAVES * 64) ((LAS unsigned*)(C.lds + LDSCTL_OFF))[u] = 0u;
    __syncthreads();
    const bool one = (AP->flags & 1) != 0;
    XcdBarrier bar; bar.bar = (unsigned*)(ctl + CW_BAR); bar.x = 0; bar.st = nullptr;
    if (one) bar = xcd_barrier_post((unsigned*)(ctl + CW_BAR), MISC + 8);
#define SEAM() do { if (AP->flags & 1) { XcdBarrier bl_ = bar; bl_.bar = (unsigned*)(ws + WS_CTL) + CW_BAR; xcd_barrier(bl_, wave0 == 0 && lane_now() == 0); } } while (0)
#define PH(k) (plo_ <= (k) && (k) < phi_)
#if TIMED_MASK
#define TS(id) do { const int z_ = (wave0 << 6) | lane_now(); if (((TIMED_MASK >> (id)) & 1) && blockIdx.x == 0 && z_ == 0) MISC[16] = (unsigned)__builtin_amdgcn_s_memrealtime(); } while (0)
#define TE(id) do { const int z_ = (wave0 << 6) | lane_now(); if (((TIMED_MASK >> (id)) & 1) && blockIdx.x == 0 && z_ == 0) MISC[17] += (unsigned)__builtin_amdgcn_s_memrealtime() - MISC[16]; } while (0)
#else
#define TS(id) do {} while (0)
#define TE(id) do {} while (0)
#endif
#define RELOAD() do { int t_ = (wave0 << 6) | lane_now(); asm volatile("" : "+v"(t_)); C.tid = t_; C.lane = t_ & 63; C.wave = __builtin_amdgcn_readfirstlane(t_ >> 6); gw = C.bid * NWAVES + C.wave; } while (0)
    int gw = C.bid * NWAVES + C.wave; const int NGW = C.G * NWAVES;
#define H ((bf16*)AP->out)
#define XR ((bf16*)(ws + WS_H))
#define PROJ ((bf16*)(ws + WS_BIG) - 4096)
#define FFH ((bf16*)(ws + WS_BIG))
#define ORET ((bf16*)AP->out + (size_t)NTOK * DM)
#define ON ((bf16*)(ws + WS_ON))
#define TMP ((bf16*)(ws + WS_TMP))
#define MERGED ((bf16*)(ws + WS_MERGED))
#define KCV ((bf16*)(ws + WS_KC))
#define GNP ((float*)(ws + WS_GNS))
#define XC ((bf16*)(ws + WS_XC))
#define QKR ((bf16*)(ws + WS_QKR))
#define VR ((bf16*)(ws + WS_VR))
#define KVX ((bf16*)(ws + WS_KVX))
#define rot ((const float*)(ws + WS_ROT))
#define RSTD ((float*)(ws + WS_RSTD))
#define PART ((float*)(ws + WS_PART))
#define RSL ((const PG8_LAS float*)(C.lds + 131072))
#define RSTD_PASS() do { for (int r_ = C.bid * 512 + C.tid; r_ < NTOK; r_ += C.G * 512) { const f32x4* p_ = (const f32x4*)(PART + (size_t)r_ * 16); const f32x4 a_ = (p_[0] + p_[1]) + (p_[2] + p_[3]); \
        RSTD[r_] = 1.f / sqrtf(((a_[0] + a_[1]) + (a_[2] + a_[3])) * (1.f / DM) + 1e-6f); } } while (0)
#define t5 ((const float*)(ws + WS_T5))
    TS(11);
    if (AP->it_lo < 0) { RELOAD(); p0_prologue(C); SEAM(); }
    TE(11);
    const int it0 = AP->it_lo < 0 ? 0 : AP->it_lo, it1 = AP->it_hi > NIT ? NIT : AP->it_hi;
    for (int it = it0; it < it1; ++it) {
        int itv = it, plo_ = AP->ph_lo, phi_ = AP->ph_hi; asm volatile("" : "+s"(itv), "+s"(plo_), "+s"(phi_)); const int L = itv / NSUB, sub = itv % NSUB;
        if (sub < NCHUNK) {
            const size_t row0 = (size_t)sub * MC;
            TS(0);
            if (PH(0) && sub == 0) { RELOAD(); const float* g = AP->in[1] + L * DM;
                if (L == 0) { { const float* cpart = (const float*)(ws + WS_ROT + 65536); float* cbp = (float*)(ws + WS_CB);
                                for (int i = C.bid * 512 + C.tid; i < NLAYER * 2 * 256; i += C.G * 512) { float s_ = 0.f; for (int sl = 0; sl < 32; ++sl) s_ += cpart[sl * 1024 + i]; cbp[i] = s_; } }
                              for (int m = gw; m < NTOK; m += 4 * NGW) rms_rows_to_bf16<4>(AP->in[0], g, H, m, NGW, C.lane); }
                else RSTD_PASS();
                SEAM(); }
            TE(0);
            TS(1);
            if (PH(1)) { pg8::Gemm g{(L == 0 ? H : XR) + row0 * DM, (const bf16*)(ws + WS_WIN) + (size_t)L * CPAD * DM, MC, CPAD, DM}; pg8::StaticOrder S; S.init(MC, CPAD, C.G, C.bid);
                epi::EpiInProj E{PROJ, rot, XC, QKR, VR, KVX, (L == 0 ? (const float*)(ws + WS_ONES) : (const float*)RSTD) + row0, RSL}; pg8::gemm_phase<epi::EpiInProj, pg8::StaticOrder, true, true>(C.lds, g, S, E, wave0); SEAM(); }
            TE(1);
            TS(2);
            if (PH(2)) {
                TS(13); RELOAD(); for (int u = C.bid; u < NBC * 4 * 8; u += C.G) ret_unit(C, (C.G == 256) ? ((u & ~255) + (u & 7) * 32 + ((u >> 3) & 31)) : u, QKR, VR, ORET, GNP); TE(13);
                { const int ks = C.bid & 7; int kc = 256; asm volatile("" : "+s"(kc));
                  pg8::Gemm g{XC + ks * 256, (const bf16*)(ws + WS_WC1) + (size_t)L * 2 * 256 * 2048 + ks * 256, NBC * 512, 512, kc, 1024, 2048}; epi::CmpOrder S{C.bid, C.G};
                  epi::EpiCmpPart E{(float*)(ws + WS_HIDP), ks}; pg8::gemm_phase<epi::EpiCmpPart, epi::CmpOrder, true, true>(C.lds, g, S, E, wave0); }
                SEAM(); }
            TE(2);
            TS(3);
            if (PH(3)) {
                RELOAD(); LAS float* hs = (LAS float*)C.lds + C.wave * 256; const float* cb = (const float*)(ws + WS_CB) + L * 512; const float* hp = (const float*)(ws + WS_HIDP);
                if (NGW == 2048) {
                  LAS float* w2s = (LAS float*)(C.lds + 8192);
                  { const f32x4* wk = (const f32x4*)(AP->in[6] + (size_t)L * 256 * 64); const f32x4* wv = (const f32x4*)(AP->in[8] + (size_t)L * 256 * 64);
#pragma unroll
                    for (int i = 0; i < 8; ++i) { *(LAS f32x4*)(w2s + (C.tid + 512 * i) * 4) = wk[C.tid + 512 * i]; *(LAS f32x4*)(w2s + 16384 + (C.tid + 512 * i) * 4) = wv[C.tid + 512 * i]; } }
                  if (C.tid == 0) MISC[32] = 0u;
                  __syncthreads();
                  if (C.wave < 4) {
                      int lz = C.lane; asm volatile("" : "+v"(lz));
                      const int rbase = C.bid * 4 + C.wave;
                      f32x4 part[8];
#pragma unroll
                      for (int ks = 0; ks < 8; ++ks) part[ks] = *(const f32x4*)(hp + ((size_t)ks * (NBC * 512) + rbase) * 256 + lz * 4);
#pragma unroll 1
                      for (int i = 0; i < NBC / 2; ++i) { const int r = i * 1024 + rbase, kv = r / (NBC * 256);
                          f32x4 h4 = *(const f32x4*)(cb + kv * 256 + lz * 4);
#pragma unroll
                          for (int ks = 0; ks < 8; ++ks) h4 += part[ks];
                          if (i + 1 < NBC / 2) {
#pragma unroll
                              for (int ks = 0; ks < 8; ++ks) part[ks] = *(const f32x4*)(hp + ((size_t)ks * (NBC * 512) + r + 1024) * 256 + lz * 4); }
#pragma unroll
                          for (int j = 0; j < 4; ++j) h4[j] = gelu_tanh_f(h4[j]);
                          *(LAS f32x4*)(hs + lz * 4) = h4;
                          const LAS float* w2 = w2s + kv * 16384;
                          float s_ = 0.f, s1_ = 0.f, s2_ = 0.f, s3_ = 0.f;
#pragma unroll 8
                          for (int k = 0; k < 256; k += 4) { s_ += hs[k] * w2[k * 64 + lz]; s1_ += hs[k + 1] * w2[(k + 1) * 64 + lz]; s2_ += hs[k + 2] * w2[(k + 2) * 64 + lz]; s3_ += hs[k + 3] * w2[(k + 3) * 64 + lz]; }
                          s_ = (s_ + s1_) + (s2_ + s3_);
                          KCV[(size_t)r * 64 + lz] = (r & 127) == 127 ? (bf16)0 : (bf16)f2bf(s_); }
                  }
                  for (;;) { unsigned p_ = 0u; if (C.lane == 0) p_ = __hip_atomic_fetch_add((LAS unsigned*)(C.lds + MISC_OFF) + 32, 1u, __ATOMIC_RELAXED, __HIP_MEMORY_SCOPE_WORKGROUP);
                      p_ = (unsigned)__builtin_amdgcn_readfirstlane((int)p_); if (p_ >= 64u) break;
                      gn_gate_rows<2>(PROJ, ORET, GNP, C.bid * 128 + 2 * (int)p_, 1, C.lane); }
                  __syncthreads();
                } else {
                  for (int r = gw; r < NBC * 512; r += NGW) { const int kv = r / (NBC * 256); f32x4 h4 = *(const f32x4*)(cb + kv * 256 + C.lane * 4);
#pragma unroll
                      for (int ks = 0; ks < 8; ++ks) h4 += *(const f32x4*)(hp + ((size_t)ks * (NBC * 512) + r) * 256 + C.lane * 4);
#pragma unroll
                      for (int i = 0; i < 4; ++i) h4[i] = gelu_tanh_f(h4[i]);
                      *(LAS f32x4*)(hs + C.lane * 4) = h4;
                      const float* w2 = (kv ? AP->in[8] : AP->in[6]) + (size_t)L * 256 * 64 + C.lane; float s_ = 0.f;
                      for (int k = 0; k < 256; ++k) s_ += hs[k] * w2[(size_t)k * 64];
                      KCV[(size_t)r * 64 + C.lane] = (r & 127) == 127 ? (bf16)0 : (bf16)f2bf(s_); }
                  __syncthreads();
                  RELOAD(); for (int m = gw; m < MC; m += 2 * NGW) gn_gate_rows<2>(PROJ, ORET, GNP, m, NGW, C.lane);
                }
                SEAM(); }
            TE(3);
            TS(4);
            if (PH(4)) {
                TS(14); RELOAD(); for (int u = C.bid; u < NBC * 2 * 32; u += C.G) nsa_unit(C, u, PROJ, KVX, KCV, t5, ON, u == C.bid || (C.G & 31) != 0); TE(14);
                  }
            TE(4);
            TS(5);
            if (PH(5)) { pg8::Gemm g{ORET, (const bf16*)(ws + WS_WORET) + (size_t)L * DM * 2048, MC, DM, 2048}; pg8::StaticOrder S; S.init(MC, DM, C.G, C.bid);
                epi::EpiGate<false> E{TMP, nullptr, PROJ + PC_MA, DM, PPITCH}; pg8::gemm_phase<epi::EpiGate<false>, pg8::StaticOrder, true, true>(C.lds, g, S, E, wave0);
                SEAM();     }
            TE(5);
            TS(6);
            if (PH(6)) { pg8::Gemm g{ON, (const bf16*)(ws + WS_WONSA) + (size_t)L * DM * DM, MC, DM, DM}; pg8::StaticOrder S; S.init(MC, DM, C.G, C.bid);
                epi::EpiGate<true> E{MERGED, TMP, PROJ + PC_MB, DM, PPITCH}; pg8::gemm_phase<epi::EpiGate<true>, pg8::StaticOrder, true, true>(C.lds, g, S, E, wave0); SEAM(); }
            TE(6);
            TS(7);
            if (PH(7)) { pg8::Gemm g{MERGED, (const bf16*)(ws + WS_WOUT) + (size_t)L * DM * DM, MC, DM, DM}; pg8::StaticOrder S; S.init(MC, DM, C.G, C.bid);
                if (L == 0) { epi::EpiResid<true> E{AP->in[0] + row0 * DM, XR + row0 * DM, PART + row0 * 16}; pg8::gemm_phase<epi::EpiResid<true>, pg8::StaticOrder, true, true>(C.lds, g, S, E, wave0); }
                else { epi::EpiResid<false> E{XR + row0 * DM, XR + row0 * DM, PART + row0 * 16}; pg8::gemm_phase<epi::EpiResid<false>, pg8::StaticOrder, true, true>(C.lds, g, S, E, wave0); }
                if (sub == NCHUNK - 1) SEAM();     }
            TE(7);
        } else {
            TS(8);
            if (PH(0)) { RELOAD(); RSTD_PASS(); SEAM(); }
            TE(8); TS(9);
            if (PH(1)) { pg8::Gemm g{XR, (const bf16*)(ws + WS_WFFI) + (size_t)L * 2 * FFH_ * DM, NTOK, 2 * FFH_, DM}; pg8::StaticOrder S; S.init(NTOK, 2 * FFH_, C.G, C.bid);
                epi::EpiSwiGlu E{FFH, RSTD, RSL}; pg8::gemm_phase<epi::EpiSwiGlu, pg8::StaticOrder, true, true>(C.lds, g, S, E, wave0); SEAM(); }
            TE(9); TS(10);
            if (PH(2)) { pg8::Gemm g{FFH, (const bf16*)(ws + WS_WFFO) + (size_t)L * DM * FFH_, NTOK, DM, FFH_}; pg8::StaticOrder S; S.init(NTOK, DM, C.G, C.bid);
                epi::EpiResid<false> E{XR, XR, PART}; pg8::gemm_phase<epi::EpiResid<false>, pg8::StaticOrder, true, true>(C.lds, g, S, E, wave0); SEAM(); }
            TE(10);
        }
    }
    TS(12);
    if (AP->it_hi > NIT) { RELOAD(); const float* g = AP->in[16]; for (int m = gw; m < NTOK; m += NGW) rms_row_final(XR + (size_t)m * DM, g, AP->out + (size_t)m * DM, C.lane);
    }
    TE(12);
#if TIMED_MASK
    { const int z_ = (wave0 << 6) | lane_now(); if (blockIdx.x == 0 && z_ == 0) { const unsigned long long t0 = __builtin_amdgcn_s_memrealtime(); const unsigned long long want = 4ull * MISC[17]; while (__builtin_amdgcn_s_memrealtime() - t0 < want) __builtin_amdgcn_s_sleep(8); } }
#endif
#undef SEAM
#undef PH
#undef ctl
#undef ws
#undef H
#undef XR
#undef PROJ
#undef FFH
#undef ORET
#undef ON
#undef TMP
#undef MERGED
#undef KCV
#undef GNP
#undef XC
#undef QKR
#undef VR
#undef KVX
#undef rot
#undef RSTD
#undef PART
#undef RSL
#undef RSTD_PASS
#undef t5
}

extern "C" void kernel_launch(void* const* d_in, const int* in_sizes, int n_in, void* d_out, int out_size, void* d_ws, size_t ws_size, hipStream_t stream) {
    static int grid = 0;
    if (grid == 0) {
        if (n_in != 17 || in_sizes[0] != NTOK * DM || out_size != NTOK * DM || ws_size < WS_END) { fprintf(stderr, "kernel_launch: unexpected shapes (n_in %d, in0 %d, out %d, ws %zu); nothing launched\n", n_in, n_in > 0 ? in_sizes[0] : -1, out_size, ws_size); grid = -1; return; }
        int dev = 0, cus = 0, per_cu = 0;
        if (hipGetDevice(&dev) != hipSuccess || hipDeviceGetAttribute(&cus, hipDeviceAttributeMultiprocessorCount, dev) != hipSuccess) { grid = -1; return; }
        if (hipFuncSetAttribute((const void*)fwd, hipFuncAttributeMaxDynamicSharedMemorySize, LDS_BYTES) != hipSuccess) { fprintf(stderr, "kernel_launch: hipFuncSetAttribute failed\n"); grid = -1; return; }
        if (hipOccupancyMaxActiveBlocksPerMultiprocessor(&per_cu, (const void*)fwd, NWAVES * 64, LDS_BYTES) != hipSuccess || per_cu < 1) { fprintf(stderr, "kernel_launch: occupancy query says %d\n", per_cu); }
        (void)hipGetLastError();
        grid = cus;
    }
    if (grid < 0) return;
    (void)hipMemsetAsync((char*)d_ws + WS_CTL, 0, CTL_ZERO_BYTES, stream);
    Args a{};
    for (int i = 0; i < 17; ++i) a.in[i] = (const float*)d_in[i];
    a.out = (float*)d_out; a.ws = (unsigned char*)d_ws;
    a.it_lo = -1; a.it_hi = NIT + 1; a.ph_lo = 0; a.ph_hi = 99; a.flags = 1;
    hipLaunchKernelGGL(fwd, dim3(grid), dim3(NWAVES * 64), LDS_BYTES, stream, a);
}
```
